# Optimizing an MI355X kernel written in HIP

```python
import jax, jax.numpy as jnp
from jax import lax
import numpy as np

D_MODEL = 2048
BATCH = 2
SEQ = 8192
DEPTH = 4

N_MEM = 256
NUM_MIXERS = 2
N_A = (DEPTH + 1) // 2
N_B = DEPTH // 2
MIX_WIDTH = (3 * D_MODEL) // 4
XA_HEADS = 4
XA_WIDTH = D_MODEL - MIX_WIDTH
XA_DIM = XA_WIDTH // XA_HEADS
HGRN_HEAD_DIM = 128
HGRN_HEADS = MIX_WIDTH // HGRN_HEAD_DIM
GLA_HEADS = 4
GLA_KEY_WIDTH = MIX_WIDTH // 2
GLA_DK = GLA_KEY_WIDTH // GLA_HEADS
GLA_DV = MIX_WIDTH // GLA_HEADS
GLA_GATE_RANK = 16
GLA_GATE_NORMALIZER = 16.0
CHUNK = 64
D_FF = ((8 * D_MODEL // 3 + 255) // 256) * 256
EPS = 1e-6
HGRN_IN = 4 * MIX_WIDTH + XA_WIDTH
GLA_IN = 2 * GLA_KEY_WIDTH + 2 * MIX_WIDTH + GLA_GATE_RANK + XA_WIDTH

kernel_name = "hgrn2_gla_interleaved_memxattn_trunk"


def _rmsnorm(x, gain):
    xf = x.astype(jnp.float32)
    y = xf * lax.rsqrt(jnp.mean(xf * xf, axis=-1, keepdims=True) + EPS)
    return (y * gain.astype(jnp.float32)).astype(x.dtype)


def _split_heads(t, n_heads):
    return t.reshape(t.shape[:-1] + (n_heads, t.shape[-1] // n_heads))


def _chunk_gated_linear_attention(q, k, v, log_a):
    b, t, h, dk = q.shape
    dv = v.shape[-1]
    n = t // CHUNK

    def to_chunks(u):
        return u.reshape(b, n, CHUNK, h, u.shape[-1]).transpose(1, 0, 3, 2, 4)

    mask = jnp.tril(jnp.ones((CHUNK, CHUNK), dtype=bool))

    def step(state, inp):
        qc, kc, vc, gc = inp
        cum = jnp.cumsum(gc, axis=2)
        inter = jnp.einsum('bhtd,bhde->bhte', qc * jnp.exp(cum), state)
        diff = cum[:, :, :, None, :] - cum[:, :, None, :, :]
        decay = jnp.exp(jnp.where(mask[:, :, None], diff, -jnp.inf))
        scores = jnp.einsum('bhtd,bhsd,bhtsd->bhts', qc, kc, decay)
        intra = jnp.einsum('bhts,bhse->bhte', scores, vc)
        last = cum[:, :, -1, :]
        new_state = jnp.exp(last)[..., None] * state + jnp.einsum(
            'bhsd,bhse->bhde', kc * jnp.exp(last[:, :, None, :] - cum), vc)
        return new_state, inter + intra

    s0 = jnp.zeros((b, h, dk, dv), jnp.float32)
    _, out = lax.scan(step, s0, (to_chunks(q), to_chunks(k), to_chunks(v), to_chunks(log_a)))
    return out.transpose(1, 0, 3, 2, 4).reshape(b, t, h, dv)


def _gated_head_norm(o, gain, gate_raw, n_heads):
    of = o * lax.rsqrt(jnp.mean(o * o, axis=-1, keepdims=True) + EPS) * gain.astype(jnp.float32)
    gate = jax.nn.silu(_split_heads(gate_raw.astype(jnp.float32), n_heads))
    y = of * gate
    return y.reshape(y.shape[:2] + (n_heads * y.shape[-1],))


def _hgrn2_mixer(hn, w_in, lb, onorm):
    f32 = jnp.float32
    proj = hn @ w_in
    q, f, i, g, xq = jnp.split(proj, [MIX_WIDTH, 2 * MIX_WIDTH, 3 * MIX_WIDTH, 4 * MIX_WIDTH], axis=-1)
    f = lb + (1.0 - lb) * jax.nn.sigmoid(f.astype(f32))
    log_f = jnp.log(f)
    k = 1.0 - f
    q = jax.nn.silu(q.astype(f32))
    o = _chunk_gated_linear_attention(
        _split_heads(q, HGRN_HEADS), _split_heads(k, HGRN_HEADS),
        _split_heads(i.astype(f32), HGRN_HEADS), _split_heads(log_f, HGRN_HEADS))
    y = _gated_head_norm(o, onorm, g, HGRN_HEADS)
    return y.astype(hn.dtype), xq


def _gla_mixer(hn, w_in, w_gk, b_gk, onorm):
    f32 = jnp.float32
    proj = hn @ w_in
    kw, w, r = GLA_KEY_WIDTH, MIX_WIDTH, GLA_GATE_RANK
    q, k, v, g, gk_low, xq = jnp.split(
        proj, [kw, 2 * kw, 2 * kw + w, 2 * kw + 2 * w, 2 * kw + 2 * w + r], axis=-1)
    log_a = jax.nn.log_sigmoid((gk_low @ w_gk + b_gk).astype(f32)) / GLA_GATE_NORMALIZER
    q = q.astype(f32) * (GLA_DK ** -0.5)
    o = _chunk_gated_linear_attention(
        _split_heads(q, GLA_HEADS), _split_heads(k.astype(f32), GLA_HEADS),
        _split_heads(v.astype(f32), GLA_HEADS), _split_heads(log_a, GLA_HEADS))
    y = _gated_head_norm(o, onorm, g, GLA_HEADS)
    return y.astype(hn.dtype), xq


def _memory_attention(xq, mem_n, w_kv):
    f32 = jnp.float32
    k, v = jnp.split(mem_n @ w_kv, 2, axis=-1)
    q = _split_heads(xq, XA_HEADS).astype(f32)
    k = _split_heads(k, XA_HEADS).astype(f32)
    v = _split_heads(v, XA_HEADS).astype(f32)
    s = jnp.einsum('bthd,bmhd->bhtm', q, k) * (XA_DIM ** -0.5)
    p = jax.nn.softmax(s, axis=-1)
    o = jnp.einsum('bhtm,bmhd->bthd', p, v)
    return o.reshape(o.shape[:2] + (XA_WIDTH,)).astype(xq.dtype)


def setup_inputs(seed: int = 0) -> dict:
    key = jax.random.key(seed)
    ks = jax.random.split(key, 20)
    f32 = jnp.float32

    def nrm(k, shape, scale):
        return jax.random.normal(k, shape, f32) * scale

    def gain(k, shape):
        return 1.0 + 0.02 * jax.random.normal(k, shape, f32)

    return {
        "x": jax.random.normal(ks[0], (BATCH, SEQ, D_MODEL), f32),
        "mem": jax.random.normal(ks[1], (BATCH, N_MEM, D_MODEL), f32),
        "norm_mix": gain(ks[2], (DEPTH, D_MODEL)),
        "norm_ffn": gain(ks[3], (DEPTH, D_MODEL)),
        "norm_mem": gain(ks[4], (D_MODEL,)),
        "norm_final": gain(ks[5], (D_MODEL,)),
        "hgrn_w_in": nrm(ks[6], (N_A, D_MODEL, HGRN_IN), D_MODEL ** -0.5),
        "hgrn_lb_logits": nrm(ks[7], (N_A, MIX_WIDTH), 0.5),
        "hgrn_onorm": gain(ks[8], (N_A, HGRN_HEAD_DIM)),
        "gla_w_in": nrm(ks[9], (N_B, D_MODEL, GLA_IN), D_MODEL ** -0.5),
        "gla_w_gk": nrm(ks[10], (N_B, GLA_GATE_RANK, GLA_KEY_WIDTH), GLA_GATE_RANK ** -0.5),
        "gla_b_gk": nrm(ks[11], (N_B, GLA_KEY_WIDTH), 0.01),
        "gla_onorm": gain(ks[12], (N_B, GLA_DV)),
        "w_mem_kv": nrm(ks[13], (DEPTH, D_MODEL, 2 * XA_WIDTH), D_MODEL ** -0.5),
        "w_out": nrm(ks[14], (DEPTH, D_MODEL, D_MODEL), D_MODEL ** -0.5),
        "w_gate_up": nrm(ks[15], (DEPTH, D_MODEL, 2 * D_FF), D_MODEL ** -0.5),
        "w_down": nrm(ks[16], (DEPTH, D_FF, D_MODEL), D_FF ** -0.5),
    }


def reference(x, mem, norm_mix, norm_ffn, norm_mem, norm_final,
              hgrn_w_in, hgrn_lb_logits, hgrn_onorm,
              gla_w_in, gla_w_gk, gla_b_gk, gla_onorm,
              w_mem_kv, w_out, w_gate_up, w_down):
    mem_n = _rmsnorm(mem, norm_mem)
    cs = jnp.cumsum(jax.nn.softmax(hgrn_lb_logits.astype(jnp.float32), axis=0), axis=0)
    lbs = cs - cs[0:1]

    h = x
    for layer in range(DEPTH):
        hn = _rmsnorm(h, norm_mix[layer])
        j = layer // NUM_MIXERS
        if layer % NUM_MIXERS == 0:
            y, xq = _hgrn2_mixer(hn, hgrn_w_in[j], lbs[j], hgrn_onorm[j])
        else:
            y, xq = _gla_mixer(hn, gla_w_in[j], gla_w_gk[j], gla_b_gk[j], gla_onorm[j])
        xa = _memory_attention(xq, mem_n, w_mem_kv[layer])
        h = h + jnp.concatenate([y, xa], axis=-1) @ w_out[layer]

        hn = _rmsnorm(h, norm_ffn[layer])
        gate, up = jnp.split(hn @ w_gate_up[layer], 2, axis=-1)
        h = h + (jax.nn.silu(gate) * up) @ w_down[layer]
    return _rmsnorm(h, norm_final)
```

```cpp
#include <hip/hip_runtime.h>
#ifndef WGM_G4
#define WGM_G4 4
#endif
#ifndef WGM_G2
#define WGM_G2 4
#endif
#include <hip/hip_cooperative_groups.h>
#include <cstdio>
#include <cstdint>
namespace cg = cooperative_groups;
namespace pg8 {
#define PG8_LAS __attribute__((address_space(3)))
typedef unsigned short bf16_t;
typedef short bf16x8 __attribute__((ext_vector_type(8)));
typedef float f32x4 __attribute__((ext_vector_type(4)));
typedef unsigned u32x4 __attribute__((ext_vector_type(4)));
typedef unsigned u32x2 __attribute__((ext_vector_type(2)));
constexpr int BM = 256, BK = 64, HALF = 128, HTB = HALF * BK * 2  , STAGE_BYTES = 8 * HTB, NXCD = 8, WGM = 8;

__host__ __device__ __forceinline__ int lds_byte(int r, int c) { const int st = (r >> 4) * 2 + (c >> 5), rr = r & 15, cc = c & 31, ob = rr * 64 + cc * 2; return st * 1024 + (ob ^ (((ob >> 9) & 1) << 5)); }
__host__ __device__ __forceinline__ void stage_rc(int b, int& R, int& C) { const int st = b / 1024, sb = b % 1024, swz = sb ^ (((sb >> 9) & 1) << 5); R = (st >> 1) * 16 + swz / 64; C = (st & 1) * 32 + (swz % 64) / 2; }
__host__ __device__ __forceinline__ int perm32(int rho) { const int n = rho >> 4, i = rho & 15; return 8 * (i >> 2) + 4 * n + (i & 3); }

struct Unit { int pm, pn; };
struct Gemm { const bf16_t* A; const bf16_t* Bt; int M, N, K; };

struct StaticOrder {
    int nM, nN, nwg, G, c, wgm;
    __host__ __device__ void init(int M, int N, int G_, int c_, int wgm_ = 4) { nM = M / BM; nN = N / BM; nwg = nM * nN; G = G_; c = c_; wgm = wgm_; }
    __host__ __device__ bool next(int i, Unit& u) const {
        const long L = (long)i * G + c; if (L >= nwg) return false;
        int wgid = (int)L; { const int q = nwg / NXCD, r = nwg % NXCD, xcd = wgid % NXCD, off = wgid / NXCD; wgid = (xcd < r ? xcd * (q + 1) : r * (q + 1) + (xcd - r) * q) + off; }
        const int nig = wgm * nN, gid = wgid / nig, fm = gid * wgm, gsz = (nM - fm) < wgm ? (nM - fm) : wgm;
        u.pm = fm + ((wgid % nig) % gsz); u.pn = (wgid % nig) / gsz; return true;
    }
    __device__ __forceinline__ void a_ready(const Unit&) const {}
    __device__ __forceinline__ void done(const Unit&) const {}
};
__device__ __forceinline__ unsigned cvt_pk_bf16(float lo, float hi) { unsigned r; asm volatile("v_cvt_pk_bf16_f32 %0, %1, %2" : "=v"(r) : "v"(lo), "v"(hi)); return r; }
constexpr float RMS_EPS = 1e-6f;
__device__ __forceinline__ float row_rstd(const float* ssqp, int row, int fq) {
    const float* pr = ssqp + (size_t)row * 32 + 8 * fq; const f32x4 a = *(const f32x4*)pr, b = *(const f32x4*)(pr + 4);
    float s = ((a[0] + a[1]) + (a[2] + a[3])) + ((b[0] + b[1]) + (b[2] + b[3]));
    s += __shfl_xor(s, 16); s += __shfl_xor(s, 32);
    return rsqrtf(s * (1.0f / 2048.0f) + RMS_EPS);
}
__device__ __forceinline__ float fsilu(float g) { return g * __builtin_amdgcn_rcpf(1.0f + __builtin_amdgcn_exp2f(-1.44269504f * g)); }
template <bool SCALE> struct EpiScaleBf16 {
    static constexpr bool PERM = true, AFTER_DRAIN = false;
    bf16_t* O; int ldc; const float* ssq;
    __device__ __forceinline__ void operator()(const f32x4 (&acc)[2][2][4][2], const Unit& u, int wr, int wc, int fr, int fq) const {
        const int row0 = u.pm * BM + wr * 64 + fr, col0 = u.pn * BM + wc * 32 + 8 * fq;
#pragma unroll
        for (int ai = 0; ai < 2; ++ai)
#pragma unroll
            for (int m = 0; m < 4; ++m) {
                const int row = row0 + ai * HALF + m * 16;
                float r = 1.0f; if (SCALE) r = row_rstd(ssq, row, fq);
                bf16_t* rowp = O + (size_t)row * ldc + col0;
#pragma unroll
                for (int bj = 0; bj < 2; ++bj) { const f32x4 v0 = acc[ai][bj][m][0] * r, v1 = acc[ai][bj][m][1] * r;
                    u32x4 w; w.x = cvt_pk_bf16(v0[0], v0[1]); w.y = cvt_pk_bf16(v0[2], v0[3]); w.z = cvt_pk_bf16(v1[0], v1[1]); w.w = cvt_pk_bf16(v1[2], v1[3]);
                    *(u32x4*)(rowp + bj * HALF) = w; }
            }
    }
};
struct EpiSwiglu {
    static constexpr bool PERM = true, AFTER_DRAIN = false;
    bf16_t* O; int ldo; const float* ssq;
    __device__ __forceinline__ void operator()(const f32x4 (&acc)[2][2][4][2], const Unit& u, int wr, int wc, int fr, int fq) const {
        const int row0 = u.pm * BM + wr * 64 + fr, col0 = u.pn * HALF + wc * 32 + 8 * fq;
#pragma unroll
        for (int ai = 0; ai < 2; ++ai)
#pragma unroll
            for (int m = 0; m < 4; ++m) {
                const int row = row0 + ai * HALF + m * 16;
                const float r = row_rstd(ssq, row, fq);
                float y[8];
#pragma unroll
                for (int n = 0; n < 2; ++n)
#pragma unroll
                    for (int j = 0; j < 4; ++j) { const float g = acc[ai][0][m][n][j] * r, up = acc[ai][1][m][n][j] * r; y[n * 4 + j] = fsilu(g) * up; }
                u32x4 w; w.x = cvt_pk_bf16(y[0], y[1]); w.y = cvt_pk_bf16(y[2], y[3]); w.z = cvt_pk_bf16(y[4], y[5]); w.w = cvt_pk_bf16(y[6], y[7]);
                *(u32x4*)(O + (size_t)row * ldo + col0) = w;
            }
    }
};
struct EpiResid {
    static constexpr bool PERM = false, AFTER_DRAIN = false;
    const float* Hin; float* Hout; bf16_t* HB; float* ssq;
    __device__ __forceinline__ void operator()(const f32x4 (&acc)[2][2][4][2], const Unit& u, int wr, int wc, int fr, int fq) const {
        const int row0 = u.pm * BM + wr * 64 + fr, col0 = u.pn * BM + wc * 32 + 4 * fq;
#pragma unroll
        for (int ai = 0; ai < 2; ++ai)
#pragma unroll
            for (int m = 0; m < 4; ++m) {
                const int row = row0 + ai * HALF + m * 16; const size_t off = (size_t)row * 2048 + col0; float ss = 0.f;
#pragma unroll
                for (int bj = 0; bj < 2; ++bj)
#pragma unroll
                    for (int n = 0; n < 2; ++n) { const size_t o = off + bj * HALF + n * 16;
                        const f32x4 h = *(const f32x4*)(Hin + o) + acc[ai][bj][m][n];
                        *(f32x4*)(Hout + o) = h;
                        u32x2 w; w.x = cvt_pk_bf16(h[0], h[1]); w.y = cvt_pk_bf16(h[2], h[3]); *(u32x2*)(HB + o) = w;
                        ss += (h[0] * h[0] + h[1] * h[1]) + (h[2] * h[2] + h[3] * h[3]); }
                ss += __shfl_xor(ss, 16); ss += __shfl_xor(ss, 32);
                if (fq == 0) ssq[(size_t)row * 32 + u.pn * 4 + wc] = ss;
                if ((m & 3) == 3) asm volatile("" ::: "memory");
            }
    }
};
struct EpiResidBf {
    static constexpr bool PERM = false, AFTER_DRAIN = false;
    bf16_t* HB; float* ssq;
    __device__ __forceinline__ void operator()(const f32x4 (&acc)[2][2][4][2], const Unit& u, int wr, int wc, int fr, int fq) const {
        const int row0 = u.pm * BM + wr * 64 + fr, col0 = u.pn * BM + wc * 32 + 4 * fq;
#pragma unroll
        for (int ai = 0; ai < 2; ++ai)
#pragma unroll
            for (int m = 0; m < 4; ++m) {
                const int row = row0 + ai * HALF + m * 16; const size_t off = (size_t)row * 2048 + col0; float ss = 0.f;
#pragma unroll
                for (int bj = 0; bj < 2; ++bj)
#pragma unroll
                    for (int n = 0; n < 2; ++n) { const size_t o = off + bj * HALF + n * 16;
                        const u32x2 hw = *(const u32x2*)(HB + o);
                        const float h0 = __uint_as_float(hw.x << 16) + acc[ai][bj][m][n][0], h1 = __uint_as_float(hw.x & 0xffff0000u) + acc[ai][bj][m][n][1];
                        const float h2 = __uint_as_float(hw.y << 16) + acc[ai][bj][m][n][2], h3 = __uint_as_float(hw.y & 0xffff0000u) + acc[ai][bj][m][n][3];
                        u32x2 w; w.x = cvt_pk_bf16(h0, h1); w.y = cvt_pk_bf16(h2, h3); *(u32x2*)(HB + o) = w;
                        const float r0 = __uint_as_float(w.x << 16), r1 = __uint_as_float(w.x & 0xffff0000u), r2 = __uint_as_float(w.y << 16), r3 = __uint_as_float(w.y & 0xffff0000u);
                        ss += (r0 * r0 + r1 * r1) + (r2 * r2 + r3 * r3); }
                ss += __shfl_xor(ss, 16); ss += __shfl_xor(ss, 32);
                if (fq == 0) ssq[(size_t)row * 32 + u.pn * 4 + wc] = ss;
            }
    }
};
template <class Epi, class Sched, bool ALIGN_EPI = false, bool SP2 = false>
__device__ __forceinline__ void gemm_phase(PG8_LAS unsigned char* lds, const Gemm g, const Sched& S, const Epi& E) {
    int tid_raw = threadIdx.x; asm volatile("" : "+v"(tid_raw));
    const int tid = tid_raw, wid = __builtin_amdgcn_readfirstlane(tid >> 6), lane = tid & 63, wr = wid >> 2, wc = wid & 3, fr = lane & 15, fq = lane >> 4;
    const int K = g.K, nt = K / BK;
    unsigned voffA[2], voffB[2];
#pragma unroll
    for (int i = 0; i < 2; ++i) { int R, C; stage_rc(tid * 16 + i * 8192, R, C); const int Rb = Epi::PERM ? ((R & ~31) + perm32(R & 31)) : R;
        voffA[i] = (unsigned)(R * K + C) * 2u; voffB[i] = (unsigned)(Rb * K + C) * 2u; }
    const size_t kstep = (size_t)(BK * 2);
    const size_t hstep = (size_t)HALF * K * 2;
    const size_t tstep = 2 * hstep;
    const unsigned ldsw = (unsigned)wid * 1024u;
    const int aoff = lds_byte(wr * 64 + fr, fq * 8), boff = lds_byte(wc * 32 + fr, fq * 8);
#define PG8_SA(b, h) (((b) * 2 + (h)) * HTB)
#define PG8_SB(b, h) ((4 + (b) * 2 + (h)) * HTB)
#define PG8_STAGE(bufoff, gbase, voff) do { _Pragma("unroll") for (int _i = 0; _i < 2; ++_i) \
        __builtin_amdgcn_global_load_lds((const unsigned*)((const char*)(gbase) + (voff)[_i]), (PG8_LAS unsigned*)(lds + (bufoff) + ldsw + _i * 8192), 16, 0, 0); } while (0)
#define PG8_LDA(dst, b, h) do { _Pragma("unroll") for (int m = 0; m < 4; ++m) _Pragma("unroll") for (int k = 0; k < 2; ++k) dst[m][k] = *(const PG8_LAS bf16x8*)(lds + PG8_SA(b, h) + aoff + m * 2048 + k * 1024); } while (0)
#define PG8_LDB(dst, b, h) do { _Pragma("unroll") for (int n = 0; n < 2; ++n) _Pragma("unroll") for (int k = 0; k < 2; ++k) dst[n][k] = *(const PG8_LAS bf16x8*)(lds + PG8_SB(b, h) + boff + n * 2048 + k * 1024); } while (0)
#define PG8_MMA(ai, bj, At, Bt) do { __builtin_amdgcn_s_setprio(1); _Pragma("unroll") for (int m = 0; m < 4; ++m) _Pragma("unroll") for (int n = 0; n < 2; ++n) _Pragma("unroll") for (int k = 0; k < 2; ++k) \
        acc[ai][bj][m][n] = __builtin_amdgcn_mfma_f32_16x16x32_bf16(Bt[n][k], At[m][k], acc[ai][bj][m][n], 0, 0, 0); __builtin_amdgcn_s_setprio(0); } while (0)
#define PG8_WAIT_V(n) asm volatile("s_waitcnt vmcnt(" #n ")" ::: "memory")
#define PG8_WAIT_L(n) asm volatile("s_waitcnt lgkmcnt(" #n ")" ::: "memory")
#define PG8_BAR __builtin_amdgcn_s_barrier()
#define PG8_SCHED __builtin_amdgcn_sched_barrier(0)
    Unit cur, nxt; int ui = 0;
    if (!S.next(0, cur)) return;
    f32x4 acc[2][2][4][2];
#pragma unroll
    for (int a = 0; a < 2; ++a)
#pragma unroll
        for (int b = 0; b < 2; ++b)
#pragma unroll
            for (int m = 0; m < 4; ++m)
#pragma unroll
                for (int n = 0; n < 2; ++n) acc[a][b][m][n] = (f32x4){0.f, 0.f, 0.f, 0.f};
    bf16x8 At[4][2], B0[2][2], B1[2][2];
    const char* cA = (const char*)g.A + (size_t)cur.pm * tstep; const char* cB = (const char*)g.Bt + (size_t)cur.pn * tstep;
    S.a_ready(cur);
    if constexpr (SP2) {
        PG8_STAGE(PG8_SB(0, 0), cB, voffB); PG8_STAGE(PG8_SB(0, 1), cB + hstep, voffB); PG8_STAGE(PG8_SA(0, 0), cA, voffA); PG8_STAGE(PG8_SA(0, 1), cA + hstep, voffA);
        if (wr == 1) PG8_BAR;
        PG8_WAIT_V(2); PG8_BAR;
        PG8_STAGE(PG8_SB(1, 0), cB + kstep, voffB); PG8_STAGE(PG8_SA(1, 0), cA + kstep, voffA); PG8_STAGE(PG8_SB(1, 1), cB + hstep + kstep, voffB);
        PG8_WAIT_V(6); PG8_BAR;
    } else {
        PG8_STAGE(PG8_SB(0, 0), cB, voffB); PG8_STAGE(PG8_SA(0, 0), cA, voffA); PG8_STAGE(PG8_SB(0, 1), cB + hstep, voffB); PG8_STAGE(PG8_SA(0, 1), cA + hstep, voffA);
        if (wr == 1) PG8_BAR;
        PG8_WAIT_V(4); PG8_BAR;
        PG8_STAGE(PG8_SB(1, 0), cB + kstep, voffB); PG8_STAGE(PG8_SA(1, 0), cA + kstep, voffA); PG8_STAGE(PG8_SB(1, 1), cB + hstep + kstep, voffB);
        PG8_WAIT_V(6); PG8_BAR;
    }
    for (;;) {
        const bool has_next = S.next(ui + 1, nxt);
        const char* nA = has_next ? (const char*)g.A + (size_t)nxt.pm * tstep : cA; const char* nB = has_next ? (const char*)g.Bt + (size_t)nxt.pn * tstep : cB;
        for (int t = 0; t < nt; t += 2) {
            const bool last = (t == nt - 2);
            const char* a1 = cA + (size_t)(t + 1) * kstep;
            const char* a2 = last ? nA : cA + (size_t)(t + 2) * kstep; const char* b2 = last ? nB : cB + (size_t)(t + 2) * kstep;
            const char* a3 = a2 + kstep; const char* b3 = b2 + kstep;
            if (last && has_next) S.a_ready(nxt);
            if constexpr (SP2) {
            PG8_LDB(B0, 0, 0); PG8_LDB(B1, 0, 1); PG8_SCHED; PG8_LDA(At, 0, 0); PG8_STAGE(PG8_SA(1, 1), a1 + hstep, voffA);
            PG8_WAIT_V(8); PG8_WAIT_L(0); PG8_BAR; PG8_MMA(0, 0, At, B0); PG8_MMA(0, 1, At, B1); PG8_BAR; PG8_SCHED;
            PG8_LDA(At, 0, 1); PG8_STAGE(PG8_SB(0, 0), b2, voffB); PG8_STAGE(PG8_SB(0, 1), b2 + hstep, voffB); PG8_STAGE(PG8_SA(0, 0), a2, voffA);
            PG8_WAIT_V(8); PG8_WAIT_L(0); PG8_BAR; PG8_MMA(1, 0, At, B0); PG8_MMA(1, 1, At, B1); PG8_BAR; PG8_SCHED;
            PG8_LDB(B0, 1, 0); PG8_LDB(B1, 1, 1); PG8_SCHED; PG8_LDA(At, 1, 0); PG8_STAGE(PG8_SA(0, 1), a2 + hstep, voffA);
            PG8_WAIT_V(8); PG8_WAIT_L(0); PG8_BAR; PG8_MMA(0, 0, At, B0); PG8_MMA(0, 1, At, B1); PG8_BAR; PG8_SCHED;
            PG8_LDA(At, 1, 1); PG8_STAGE(PG8_SB(1, 0), b3, voffB); PG8_STAGE(PG8_SB(1, 1), b3 + hstep, voffB); PG8_STAGE(PG8_SA(1, 0), a3, voffA);
            PG8_WAIT_V(8); PG8_WAIT_L(0); PG8_BAR; PG8_MMA(1, 0, At, B0); PG8_MMA(1, 1, At, B1); PG8_BAR; PG8_SCHED;
            } else {
            PG8_LDB(B0, 0, 0); PG8_SCHED; PG8_LDA(At, 0, 0); PG8_STAGE(PG8_SA(1, 1), a1 + hstep, voffA);
            PG8_WAIT_L(8); PG8_BAR; PG8_WAIT_L(0); PG8_MMA(0, 0, At, B0); PG8_BAR; PG8_SCHED;
            PG8_LDB(B1, 0, 1); PG8_STAGE(PG8_SB(0, 0), b2, voffB);
            PG8_BAR; PG8_WAIT_L(0); PG8_MMA(0, 1, At, B1); PG8_BAR;
            PG8_LDA(At, 0, 1); PG8_STAGE(PG8_SA(0, 0), a2, voffA);
            PG8_BAR; PG8_WAIT_L(0); PG8_MMA(1, 0, At, B0); PG8_BAR; PG8_SCHED;
            PG8_STAGE(PG8_SB(0, 1), b2 + hstep, voffB);
            PG8_WAIT_V(6); PG8_BAR; PG8_MMA(1, 1, At, B1); PG8_BAR;
            PG8_LDB(B0, 1, 0); PG8_SCHED; PG8_LDA(At, 1, 0); PG8_STAGE(PG8_SA(0, 1), a2 + hstep, voffA);
            PG8_WAIT_L(8); PG8_BAR; PG8_WAIT_L(0); PG8_MMA(0, 0, At, B0); PG8_BAR; PG8_SCHED;
            PG8_LDB(B1, 1, 1); PG8_STAGE(PG8_SB(1, 0), b3, voffB);
            PG8_BAR; PG8_WAIT_L(0); PG8_MMA(0, 1, At, B1); PG8_BAR;
            PG8_LDA(At, 1, 1); PG8_STAGE(PG8_SA(1, 0), a3, voffA);
            PG8_BAR; PG8_WAIT_L(0); PG8_MMA(1, 0, At, B0); PG8_BAR; PG8_SCHED;
            PG8_STAGE(PG8_SB(1, 1), b3 + hstep, voffB);
            PG8_WAIT_V(6); PG8_BAR; PG8_MMA(1, 1, At, B1); PG8_BAR;
            }
        }
        if constexpr (ALIGN_EPI) { if (wr == 0) PG8_BAR; }
        if constexpr (!Epi::AFTER_DRAIN) { E(acc, cur, wr, wc, fr, fq); S.done(cur); }
        if (!has_next) break;
#pragma unroll
        for (int a = 0; a < 2; ++a)
#pragma unroll
            for (int b = 0; b < 2; ++b)
#pragma unroll
                for (int m = 0; m < 4; ++m)
#pragma unroll
                    for (int n = 0; n < 2; ++n) acc[a][b][m][n] = (f32x4){0.f, 0.f, 0.f, 0.f};
        cur = nxt; cA = nA; cB = nB; ++ui;
        if constexpr (ALIGN_EPI) { if (wr == 1) PG8_BAR; }
    }
    PG8_WAIT_V(0);
    if constexpr (!ALIGN_EPI) { if (wr == 0) PG8_BAR; }
    PG8_BAR;
    if constexpr (Epi::AFTER_DRAIN) { E.fused(acc, cur, wr, wc, fr, fq, lds, wid, lane); S.done(cur); }
#undef PG8_SA
#undef PG8_SB
#undef PG8_STAGE
#undef PG8_LDA
#undef PG8_LDB
#undef PG8_MMA
#undef PG8_WAIT_V
#undef PG8_WAIT_L
#undef PG8_BAR
#undef PG8_SCHED
}
}

#define LAS __attribute__((address_space(3)))
typedef unsigned short bf16;
typedef short bf16x8 __attribute__((ext_vector_type(8)));
typedef float f32x4 __attribute__((ext_vector_type(4)));
typedef unsigned u32x4 __attribute__((ext_vector_type(4)));
typedef unsigned u32x2 __attribute__((ext_vector_type(2)));
constexpr int NWAVES = 8, NTHR = 512;
constexpr int D = 2048, M = 16384, DEPTH = 4, NMEM = 256, MMEM = 512;
constexpr int MIXW = 1536, XAW = 512, DFF = 5632;
constexpr int HG_IN = 6656, GL_IN_SRC = 5136, GL_IN = 5888;
constexpr float EPS = 1e-6f;
constexpr size_t MiB = 1u << 20;
constexpr size_t WS_WT = 0;
constexpr size_t WT_LAYER = 100 * MiB;
constexpr size_t WS_WTK = 400 * MiB, WS_WTV = 408 * MiB, WS_MEMN = 416 * MiB, WS_MEMK = 418 * MiB, WS_MEMVT = 420 * MiB;
constexpr size_t WS_BAR = 422 * MiB, WS_DEC = 423 * MiB, WS_H = 426 * MiB, WS_HB = 554 * MiB, WS_CAT = 618 * MiB, WS_PROJ = 682 * MiB, WS_US = 890 * MiB, WS_SSQ2 = 1034 * MiB, WS_VTG = 1054 * MiB, WS_END = 1102 * MiB;
constexpr int LDS_BYTES = 144 * 1024, LDS_CTL = 143 * 1024;

struct Args {
    const float *x, *mem, *norm_mix, *norm_ffn, *norm_mem, *norm_final, *hgrn_w_in, *hgrn_lb, *hgrn_onorm, *gla_w_in, *gla_w_gk, *gla_b_gk, *gla_onorm, *w_mem_kv, *w_out, *w_gate_up, *w_down;
    float* out; unsigned char* ws;
};

__device__ __forceinline__ float bf2f(unsigned b) { return __uint_as_float(b << 16); }
__device__ __forceinline__ float bflo(unsigned w) { return __uint_as_float(w << 16); }
__device__ __forceinline__ float bfhi(unsigned w) { return __uint_as_float(w & 0xffff0000u); }
__device__ __forceinline__ unsigned pk2(float lo, float hi) { return pg8::cvt_pk_bf16(lo, hi); }
__device__ __forceinline__ float fexp(float x) { return __builtin_amdgcn_exp2f(1.44269504f * x); }
__device__ __forceinline__ float flog(float x) { return 0.69314718f * __builtin_amdgcn_logf(x); }
__device__ __forceinline__ float fsigm(float x) { return __builtin_amdgcn_rcpf(1.0f + fexp(-x)); }
__device__ __forceinline__ float wave_sum(float v) {
#pragma unroll
    for (int o = 1; o < 64; o <<= 1) v += __shfl_xor(v, o);
    return v;
}
#define LDS_WAIT() asm volatile("s_waitcnt lgkmcnt(0)" ::: "memory")

__device__ __forceinline__ int map_col(int mt, int nd) {
    if (mt == 0) return nd;
    if (mt == 1) return nd < 4608 ? nd : (nd < 5120 ? nd + 16 : -1);
    const int pn = nd >> 8, bj = (nd >> 7) & 1, c = nd & 127; return bj * DFF + 128 * pn + c;
}
__device__ __forceinline__ void conv_item(const float* W, int Nsrc, int K, bf16* WT, const float* gain, int mt, const float* wgk, int item, int nblk, LAS float* scr, int lane) {
    const int kb = item / nblk, nb = item % nblk, k0 = 64 * kb, n0 = 32 * nb;
    const int sc = map_col(mt, n0 + (lane & 31));
    float v[32];
    if (mt == 1 && n0 >= 5120) {
        float wz[16];
#pragma unroll
        for (int r = 0; r < 16; ++r) wz[r] = wgk[r * 768 + (n0 - 5120) + (lane & 31)];
#pragma unroll 4
        for (int i = 0; i < 32; ++i) { const int kk = 2 * i + (lane >> 5); const f32x4* wr = (const f32x4*)(W + (size_t)(k0 + kk) * Nsrc + 4608); float z = 0.f;
#pragma unroll
            for (int q = 0; q < 4; ++q) { const f32x4 w4 = wr[q]; z += w4[0] * wz[4 * q] + w4[1] * wz[4 * q + 1] + w4[2] * wz[4 * q + 2] + w4[3] * wz[4 * q + 3]; }
            v[i] = z; }
    } else {
#pragma unroll
        for (int i = 0; i < 32; ++i) { const int kk = 2 * i + (lane >> 5); v[i] = sc >= 0 ? W[(size_t)(k0 + kk) * Nsrc + sc] : 0.f; }
    }
    if (gain) {
#pragma unroll
        for (int i = 0; i < 32; ++i) v[i] *= gain[k0 + 2 * i + (lane >> 5)];
    }
#pragma unroll
    for (int i = 0; i < 32; ++i) scr[(2 * i + (lane >> 5)) * 33 + (lane & 31)] = v[i];
    LDS_WAIT(); asm volatile("" ::: "memory");
    const int c = lane & 7;
#pragma unroll
    for (int j = 0; j < 4; ++j) { const int n = (lane >> 3) + 8 * j; const LAS float* s = scr + (8 * c) * 33 + n;
        u32x4 o; o.x = pk2(s[0 * 33], s[1 * 33]); o.y = pk2(s[2 * 33], s[3 * 33]); o.z = pk2(s[4 * 33], s[5 * 33]); o.w = pk2(s[6 * 33], s[7 * 33]);
        *(u32x4*)(WT + (size_t)(n0 + n) * K + k0 + 8 * c) = o; }
    LDS_WAIT(); asm volatile("" ::: "memory");
}
__device__ __forceinline__ void conv_matrix(const float* W, int Nsrc, int K, int Ndst, bf16* WT, const float* gain, int mt, LAS float* scr, int lane, int& gw, int NGW, const float* wgk = nullptr) {
    const int nblk = Ndst / 32, nitems = (K / 64) * nblk;
    for (int it = gw; it < nitems; it += NGW) conv_item(W, Nsrc, K, WT, gain, mt, wgk, it, nblk, scr, lane);
    gw -= nitems % NGW; if (gw < 0) gw += NGW;
}
__device__ __forceinline__ bf16* wt_in(unsigned char* ws, int l) { return (bf16*)(ws + WS_WT + (size_t)l * WT_LAYER); }
__device__ __forceinline__ int n_in(int l) { return (l & 1) ? GL_IN : HG_IN; }
__device__ __forceinline__ bf16* wt_out(unsigned char* ws, int l) { return wt_in(ws, l) + (size_t)n_in(l) * D; }
__device__ __forceinline__ bf16* wt_gu(unsigned char* ws, int l) { return wt_out(ws, l) + (size_t)D * D; }
__device__ __forceinline__ bf16* wt_down(unsigned char* ws, int l) { return wt_gu(ws, l) + (size_t)2 * DFF * D; }

__device__ __forceinline__ void p0_prologue(const Args& a, LAS unsigned char* lds, int tid, int lane, int wave) {
    LAS float* scr = (LAS float*)(lds + wave * 8704);
    const int G = gridDim.x, gw0 = blockIdx.x * NWAVES + wave, NGW = G * NWAVES; int gw = gw0;
    unsigned char* ws = a.ws;
    for (int m = gw0; m < MMEM; m += NGW) {
        const f32x4* xr = (const f32x4*)(a.mem + (size_t)m * D) + lane; const f32x4* gr = (const f32x4*)a.norm_mem + lane; u32x2* o = (u32x2*)((bf16*)(ws + WS_MEMN) + (size_t)m * D) + lane;
        f32x4 v[8]; float s = 0.f;
#pragma unroll
        for (int j = 0; j < 8; ++j) { v[j] = xr[64 * j]; s += (v[j].x * v[j].x + v[j].y * v[j].y) + (v[j].z * v[j].z + v[j].w * v[j].w); }
        const float r = rsqrtf(wave_sum(s) * (1.0f / D) + EPS);
#pragma unroll
        for (int j = 0; j < 8; ++j) { const f32x4 g = gr[64 * j]; u32x2 w; w.x = pk2(v[j].x * r * g.x, v[j].y * r * g.y); w.y = pk2(v[j].z * r * g.z, v[j].w * r * g.w); o[64 * j] = w; }
    }
    for (int l = DEPTH - 1; l >= 0; --l) {
        const int j = l >> 1;
        if (l & 1) conv_matrix(a.gla_w_in + (size_t)j * D * GL_IN_SRC, GL_IN_SRC, D, GL_IN, wt_in(ws, l), a.norm_mix + l * D, 1, scr, lane, gw, NGW, a.gla_w_gk + (size_t)j * 16 * 768);
        else       conv_matrix(a.hgrn_w_in + (size_t)j * D * HG_IN, HG_IN, D, HG_IN, wt_in(ws, l), a.norm_mix + l * D, 0, scr, lane, gw, NGW);
        conv_matrix(a.w_out + (size_t)l * D * D, D, D, D, wt_out(ws, l), nullptr, 0, scr, lane, gw, NGW);
        conv_matrix(a.w_gate_up + (size_t)l * D * 2 * DFF, 2 * DFF, D, 2 * DFF, wt_gu(ws, l), a.norm_ffn + l * D, 2, scr, lane, gw, NGW);
        conv_matrix(a.w_down + (size_t)l * DFF * D, D, DFF, D, wt_down(ws, l), nullptr, 0, scr, lane, gw, NGW);
        conv_matrix(a.w_mem_kv + (size_t)l * D * 2 * XAW, 2 * XAW, D, XAW, (bf16*)(ws + WS_WTK) + (size_t)l * XAW * D, nullptr, 0, scr, lane, gw, NGW);
        conv_matrix(a.w_mem_kv + (size_t)l * D * 2 * XAW + XAW, 2 * XAW, D, XAW, (bf16*)(ws + WS_WTV) + (size_t)l * XAW * D, nullptr, 0, scr, lane, gw, NGW);
    }
    for (int m = gw0; m < M; m += NGW) {
        const f32x4* xr = (const f32x4*)(a.x + (size_t)m * D) + lane; u32x2* hb = (u32x2*)((bf16*)(ws + WS_HB) + (size_t)m * D) + lane;
        f32x4 v[8]; float s = 0.f;
#pragma unroll
        for (int j = 0; j < 8; ++j) v[j] = xr[64 * j];
#pragma unroll
        for (int j = 0; j < 8; ++j) { s += (v[j].x * v[j].x + v[j].y * v[j].y) + (v[j].z * v[j].z + v[j].w * v[j].w); u32x2 w; w.x = pk2(v[j].x, v[j].y); w.y = pk2(v[j].z, v[j].w); hb[64 * j] = w; }
        s = wave_sum(s); if (lane < 32) ((float*)(ws + WS_SSQ2))[(size_t)m * 32 + lane] = lane == 0 ? s : 0.f;
    }
}
template <bool HG> struct MC {
    static constexpr int DK = HG ? 128 : 192, DV = HG ? 128 : 384, NH = HG ? 12 : 4, NS = DV / 128, LD = HG ? HG_IN : GL_IN;
    static constexpr int QOFF = 0, KOFF = HG ? 1536 : 768, VOFF = HG ? 3072 : 1536, GOFF = HG ? 4608 : 3072, XQOFF = HG ? 6144 : 4608, ZOFF = 5120;
    static constexpr int RS = DK * 2 + 16;
    static constexpr int TS = 144;
};
struct MixP { const bf16* proj; bf16* vtg; bf16* us; float* dec; bf16* cat; const float* lb; const float* wgk; const float* bgk; const float* onorm; int j; };

__device__ __forceinline__ float hgrn_lb(const MixP& p, int col) {
    if (p.j == 0) return 0.f;
    return fsigm(p.lb[MIXW + col] - p.lb[col]);
}
__device__ __forceinline__ float gla_la(const LAS float* g, const float (&w)[16], float bb) {
    float z = bb;
#pragma unroll
    for (int r = 0; r < 16; ++r) z += g[r] * w[r];
    return (fminf(z, 0.f) - flog(1.0f + fexp(-fabsf(z)))) * (1.0f / 16.0f);
}
__device__ __forceinline__ float gla_lz(float z) { return flog(1.0f + fexp(-fmaxf(z, -60.f))) * (-1.0f / 16.0f); }
__device__ __forceinline__ void hg_gate(float x, float lb, float omlb, bool haslb, float& la, float& k) {
    const float e = fexp(-fmaxf(x, -60.f)), s1 = 1.0f + e; la = -flog(s1); if (haslb) la += flog(1.0f + lb * e); k = omlb * e * __builtin_amdgcn_rcpf(s1);
}
template <bool HG> __device__ __forceinline__ void load_gkl(const MixP& p, LAS float* gkl, int row0, int tid) {
    if (!HG) { const int idx = tid * 2, t = idx >> 4, r = idx & 15; const unsigned w = *(const unsigned*)(p.proj + (size_t)(row0 + t) * MC<HG>::LD + MC<HG>::GKOFF + r); gkl[idx] = bflo(w); gkl[idx + 1] = bfhi(w); }
}


template <bool HG> __device__ __forceinline__ void gate8(const LAS bf16* src, int stride, float bb, float lb, float omlb, bool haslb, float (&la)[8], float (&k)[8]) {
    float x[8], e[8], s1[8], l1[8];
#pragma unroll
    for (int j = 0; j < 8; ++j) x[j] = bf2f(src[j * stride]);
#pragma unroll
    for (int j = 0; j < 8; ++j) x[j] = -1.44269504f * fmaxf(x[j] + bb, -60.f);
#pragma unroll
    for (int j = 0; j < 8; ++j) e[j] = __builtin_amdgcn_exp2f(x[j]);
#pragma unroll
    for (int j = 0; j < 8; ++j) s1[j] = 1.0f + e[j];
#pragma unroll
    for (int j = 0; j < 8; ++j) l1[j] = __builtin_amdgcn_logf(s1[j]);
    if (HG) {
        float r[8], l2[8];
#pragma unroll
        for (int j = 0; j < 8; ++j) r[j] = __builtin_amdgcn_rcpf(s1[j]);
        if (haslb) {
#pragma unroll
            for (int j = 0; j < 8; ++j) l2[j] = __builtin_amdgcn_logf(1.0f + lb * e[j]);
        } else {
#pragma unroll
            for (int j = 0; j < 8; ++j) l2[j] = 0.f;
        }
#pragma unroll
        for (int j = 0; j < 8; ++j) { la[j] = 0.69314718f * (l2[j] - l1[j]); k[j] = omlb * e[j] * r[j]; }
    } else {
#pragma unroll
        for (int j = 0; j < 8; ++j) { la[j] = (-0.69314718f / 16.0f) * l1[j]; k[j] = 0.f; }
    }
}
template <bool HG> struct MixPar { float w[2]; };
template <bool HG> __device__ __forceinline__ void par_load(const MixP& p, int h, int tid, MixPar<HG>& q) {
    if (HG) { const int col = h * 128 + (tid & 127); q.w[0] = p.lb[col]; q.w[1] = p.lb[MIXW + col]; }
    else { q.w[0] = p.bgk[h * 192 + (tid % 192)]; q.w[1] = 0.f; }
}
template <bool HG> struct M1Raw { u32x4 k[HG ? 2 : 3]; u32x4 z[HG ? 1 : 3]; u32x4 v[2]; MixPar<HG> par; };
template <bool HG> __device__ __forceinline__ void m1_load(const MixP& p, int item, int tid, M1Raw<HG>& r) {
    typedef MC<HG> C; constexpr int DK = C::DK, LD = C::LD, CK = DK / 8;
    const int c = item / 12, hs = item % 12, h = hs / C::NS, s = hs % C::NS, row0 = c * 64;
    par_load<HG>(p, h, tid, r.par);
#pragma unroll
    for (int i = 0; i < (HG ? 2 : 3); ++i) { const int ci = tid + NTHR * i, row = ci / CK, cj = ci % CK; r.k[i] = *(const u32x4*)(p.proj + (size_t)(row0 + row) * LD + C::KOFF + h * DK + cj * 8);
        if (!HG) r.z[i] = *(const u32x4*)(p.proj + (size_t)(row0 + row) * LD + C::ZOFF + h * DK + cj * 8); }
#pragma unroll
    for (int i = 0; i < 2; ++i) { const int ci = tid + NTHR * i, row = ci >> 4, cj = ci & 15; r.v[i] = *(const u32x4*)(p.proj + (size_t)(row0 + row) * LD + C::VOFF + h * C::DV + s * 128 + cj * 8); }
}
__device__ __forceinline__ void gkl_store(LAS float* gkl, int tid, const u32x4& g) {
    if (tid < 128) { LAS f32x4* o = (LAS f32x4*)(gkl + (tid >> 1) * 16 + (tid & 1) * 8);
        o[0] = (f32x4){bflo(g.x), bfhi(g.x), bflo(g.y), bfhi(g.y)}; o[1] = (f32x4){bflo(g.z), bfhi(g.z), bflo(g.w), bfhi(g.w)}; }
}
template <bool HG> __device__ __forceinline__ void m1_item(const MixP& p, LAS unsigned char* lds, int item, int nxt, M1Raw<HG>& r, int tid, int lane, int wave) {
    typedef MC<HG> C; constexpr int DK = C::DK, TS = C::TS, CK = DK / 8, RKS = DK * 2 + 16, RVS = 272, NSEG = HG ? 4 : 2, NT = 64 / NSEG;
    const int c = item / 12, hs = item % 12, h = hs / C::NS, s = hs % C::NS;
    constexpr int KDT_OFF = 0, VT_OFF = DK * TS, RAWK_OFF = VT_OFF + 128 * TS, RAWV_OFF = RAWK_OFF + 64 * RKS, RAWZ_OFF = RAWV_OFF + 64 * RVS, TOT_OFF = RAWZ_OFF + (HG ? 0 : 64 * RKS);
    static_assert(TOT_OFF + 4 * 4 * DK <= 140 * 1024, "M1 LDS");
    LAS unsigned char* KDT = lds + KDT_OFF; LAS unsigned char* VT = lds + VT_OFF; LAS float* tot = (LAS float*)(lds + TOT_OFF);
#pragma unroll
    for (int i = 0; i < (HG ? 2 : 3); ++i) { const int ci = tid + NTHR * i, row = ci / CK, cj = ci % CK; *(LAS u32x4*)(lds + RAWK_OFF + row * RKS + cj * 16) = r.k[i]; if (!HG) *(LAS u32x4*)(lds + RAWZ_OFF + row * RKS + cj * 16) = r.z[i]; }
#pragma unroll
    for (int i = 0; i < 2; ++i) { const int ci = tid + NTHR * i, row = ci >> 4, cj = ci & 15; *(LAS u32x4*)(lds + RAWV_OFF + row * RVS + cj * 16) = r.v[i]; }
    float lb = 0.f, omlb = 1.f, bb = 0.f;
    if (HG) { lb = p.j == 0 ? 0.f : fsigm(r.par.w[1] - r.par.w[0]); omlb = 1.0f - lb; } else bb = r.par.w[0];
    __syncthreads();
    if (nxt >= 0) m1_load<HG>(p, nxt, tid, r);
    const int d = HG ? (tid & 127) : (tid % 192), seg = HG ? (tid >> 7) : (tid / 192), t0 = seg * NT;
    const bool act = seg < NSEG;
    const LAS bf16* rk = (const LAS bf16*)(lds + RAWK_OFF) + d; const LAS bf16* rz = (const LAS bf16*)(lds + RAWZ_OFF) + d;
    float la_[NT / 8][8], k_[NT / 8][8]; const bool haslb = p.j != 0;
    if (act) { float tsum = 0.f;
#pragma unroll
        for (int i8 = 0; i8 < NT / 8; ++i8) { gate8<HG>((HG ? rk : rz) + (t0 + i8 * 8) * (RKS / 2), RKS / 2, bb, lb, omlb, haslb, la_[i8], k_[i8]);
#pragma unroll
            for (int j = 0; j < 8; ++j) tsum += la_[i8][j]; }
        tot[seg * DK + d] = tsum; }
    __syncthreads();
    if (act) { float rc = 0.f;
#pragma unroll
        for (int q = 0; q < NSEG; ++q) if (q > seg) rc += tot[q * DK + d];
#pragma unroll
        for (int i8 = NT / 8 - 1; i8 >= 0; --i8) { float kd[8], rcv[8], kk[8];
#pragma unroll
            for (int j = 0; j < 8; ++j) kk[j] = HG ? k_[i8][j] : bf2f(rk[(t0 + i8 * 8 + j) * (RKS / 2)]);
#pragma unroll
            for (int j = 7; j >= 0; --j) { rcv[j] = 1.44269504f * rc; rc += la_[i8][j]; }
#pragma unroll
            for (int j = 0; j < 8; ++j) rcv[j] = __builtin_amdgcn_exp2f(rcv[j]);
#pragma unroll
            for (int j = 0; j < 8; ++j) kd[j] = kk[j] * rcv[j];
            u32x4 w; w.x = pk2(kd[0], kd[1]); w.y = pk2(kd[2], kd[3]); w.z = pk2(kd[4], kd[5]); w.w = pk2(kd[6], kd[7]);
            *(LAS u32x4*)(KDT + d * TS + (t0 + i8 * 8) * 2) = w; }
        if (seg == 0 && s == 0) p.dec[((size_t)c * C::NH + h) * DK + d] = fexp(rc); }
    {
        const int e = tid & 127, tv = (tid >> 7) * 16; const LAS bf16* rv = (const LAS bf16*)(lds + RAWV_OFF) + e; unsigned xs[16];
#pragma unroll
        for (int i = 0; i < 16; ++i) xs[i] = rv[(tv + i) * (RVS / 2)];
#pragma unroll
        for (int q = 0; q < 2; ++q) { u32x4 w; w.x = xs[q * 8] | (xs[q * 8 + 1] << 16); w.y = xs[q * 8 + 2] | (xs[q * 8 + 3] << 16); w.z = xs[q * 8 + 4] | (xs[q * 8 + 5] << 16); w.w = xs[q * 8 + 6] | (xs[q * 8 + 7] << 16);
            *(LAS u32x4*)(VT + e * TS + (tv + q * 8) * 2) = w; }
    }
    __syncthreads();
    {
        const int fr = lane & 15, g = lane >> 4, eb = wave;
        f32x4 acc[DK / 16];
#pragma unroll
        for (int db = 0; db < DK / 16; ++db) acc[db] = (f32x4){0.f, 0.f, 0.f, 0.f};
#pragma unroll
        for (int ks = 0; ks < 2; ++ks) {
            const bf16x8 bfr = *(const LAS bf16x8*)(VT + (16 * eb + fr) * TS + ks * 64 + g * 16);
#pragma unroll
            for (int db = 0; db < DK / 16; ++db) { const bf16x8 afr = *(const LAS bf16x8*)(KDT + (16 * db + fr) * TS + ks * 64 + g * 16);
                acc[db] = __builtin_amdgcn_mfma_f32_16x16x32_bf16(afr, bfr, acc[db], 0, 0, 0); }
        }
        bf16* dst = p.us + (((size_t)c * 12 + hs) * 128 + 16 * eb + fr) * DK + 4 * g;
#pragma unroll
        for (int db = 0; db < DK / 16; ++db) { u32x2 w; w.x = pk2(acc[db][0], acc[db][1]); w.y = pk2(acc[db][2], acc[db][3]); *(u32x2*)(dst + 16 * db) = w; }
        bf16* vt = p.vtg + ((size_t)c * 12 + hs) * 128 * 64;
#pragma unroll
        for (int i = 0; i < 2; ++i) { const int ci = tid + NTHR * i, e = ci >> 3, part = ci & 7; *(u32x4*)(vt + e * 64 + part * 8) = *(const LAS u32x4*)(VT + e * TS + part * 16); }
    }
}

template <bool HG> __device__ __forceinline__ void m2_scan(const MixP& p, int gtid, int gthreads) {
    typedef MC<HG> C; constexpr int DK = C::DK, D8 = DK / 8, NIT = 2 * 12 * 128 * D8;
    const int nblk = gthreads / NTHR, per = ((NIT + nblk - 1) / nblk + 63) & ~63, bidx = gtid / NTHR, lt = gtid % NTHR;
    for (int it = bidx * per + lt; lt < per && it < NIT; it += NIT) {
        const int d8 = it % D8, e = (it / D8) % 128, hs = (it / (D8 * 128)) % 12, b = it / (D8 * 128 * 12), h = hs / C::NS;
        bf16* up = p.us + (((size_t)(b * 128) * 12 + hs) * 128 + e) * DK + d8 * 8; const size_t ustr = (size_t)12 * 128 * DK;
        const float* dp = p.dec + ((size_t)(b * 128) * C::NH + h) * DK + d8 * 8; const size_t dstr = (size_t)C::NH * DK;
        float S[8];
#pragma unroll
        for (int i = 0; i < 8; ++i) S[i] = 0.f;
        for (int n0 = 0; n0 < 128; n0 += 8) {
            u32x4 u[8]; f32x4 d0[8], d1[8];
#pragma unroll
            for (int k = 0; k < 8; ++k) { u[k] = *(const u32x4*)(up + (size_t)(n0 + k) * ustr); d0[k] = *(const f32x4*)(dp + (size_t)(n0 + k) * dstr); d1[k] = *(const f32x4*)(dp + (size_t)(n0 + k) * dstr + 4); }
#pragma unroll
            for (int k = 0; k < 8; ++k) {
                u32x4 w; w.x = pk2(S[0], S[1]); w.y = pk2(S[2], S[3]); w.z = pk2(S[4], S[5]); w.w = pk2(S[6], S[7]);
                *(u32x4*)(up + (size_t)(n0 + k) * ustr) = w;
                S[0] = d0[k].x * S[0] + bflo(u[k].x); S[1] = d0[k].y * S[1] + bfhi(u[k].x); S[2] = d0[k].z * S[2] + bflo(u[k].y); S[3] = d0[k].w * S[3] + bfhi(u[k].y);
                S[4] = d1[k].x * S[4] + bflo(u[k].z); S[5] = d1[k].y * S[5] + bfhi(u[k].z); S[6] = d1[k].z * S[6] + bflo(u[k].w); S[7] = d1[k].w * S[7] + bfhi(u[k].w);
            }
        }
    }
}

template <bool HG> struct M3Raw { u32x4 q[HG ? 2 : 3]; u32x4 k[HG ? 2 : 3]; u32x4 z[HG ? 1 : 3]; MixPar<HG> par; };
template <bool HG> __device__ __forceinline__ void m3_load(const MixP& p, int item, int tid, M3Raw<HG>& r) {
    typedef MC<HG> C; constexpr int DK = C::DK, LD = C::LD, CK = DK / 8;
    const int c = item / C::NH, h = item % C::NH, row0 = c * 64;
    par_load<HG>(p, h, tid, r.par);
#pragma unroll
    for (int i = 0; i < (HG ? 2 : 3); ++i) { const int ci = tid + NTHR * i, row = ci / CK, cj = ci % CK; const bf16* b = p.proj + (size_t)(row0 + row) * LD + h * DK + cj * 8;
        r.q[i] = *(const u32x4*)(b + C::QOFF); r.k[i] = *(const u32x4*)(b + C::KOFF); if (!HG) r.z[i] = *(const u32x4*)(b + C::ZOFF); }
}
template <bool HG> __device__ __forceinline__ void m3_item(const MixP& p, LAS unsigned char* lds, int item, int nxt, M3Raw<HG>& r, int tid, int lane, int wave) {
    typedef MC<HG> C; constexpr int DK = C::DK, DV = C::DV, LD = C::LD, TS = C::TS, RS = C::RS, NS = C::NS, CK = DK / 8, NSEG = HG ? 4 : 2, NT = 64 / NSEG;
    const int c = item / C::NH, h = item % C::NH, row0 = c * 64;
    constexpr int QI_OFF = 0, KP_OFF = 64 * RS, QP_OFF = HG ? 2 * 64 * RS : 0, P_OFF = (HG ? 3 : 2) * 64 * RS, RED_OFF = P_OFF + 64 * TS, ZR_OFF = RED_OFF + 2048, TOT_OFF = ZR_OFF + (HG ? 0 : 64 * RS);
    static_assert(TOT_OFF + 4 * 4 * DK <= 140 * 1024, "M3 LDS");
    LAS float* tot = (LAS float*)(lds + TOT_OFF);
#pragma unroll
    for (int i = 0; i < (HG ? 2 : 3); ++i) { const int ci = tid + NTHR * i, row = ci / CK, cj = ci % CK; *(LAS u32x4*)(lds + QI_OFF + row * RS + cj * 16) = r.q[i]; *(LAS u32x4*)(lds + KP_OFF + row * RS + cj * 16) = r.k[i]; if (!HG) *(LAS u32x4*)(lds + ZR_OFF + row * RS + cj * 16) = r.z[i]; }
    float lb = 0.f, omlb = 1.f, bb = 0.f;
    if (HG) { lb = p.j == 0 ? 0.f : fsigm(r.par.w[1] - r.par.w[0]); omlb = 1.0f - lb; } else bb = r.par.w[0];
    __syncthreads();
    const int fr = lane & 15, g = lane >> 4;
    bf16x8 sfr[NS][DK / 32], vfr[NS][2];
    if (HG)
#pragma unroll
    for (int x = 0; x < NS; ++x) { const int ea = 16 * (wave * NS + x) + fr, sl = ea >> 7, ei = ea & 127;
#pragma unroll
        for (int ks = 0; ks < DK / 32; ++ks) sfr[x][ks] = *(const bf16x8*)(p.us + (((size_t)c * 12 + h * NS + sl) * 128 + ei) * DK + ks * 32 + g * 8);
#pragma unroll
        for (int ks = 0; ks < 2; ++ks) vfr[x][ks] = *(const bf16x8*)(p.vtg + (((size_t)c * 12 + h * NS + sl) * 128 + ei) * 64 + ks * 32 + g * 8); }
    if (nxt >= 0) m3_load<HG>(p, nxt, tid, r);
    u32x2 gpre[NS][4];
#pragma unroll
    for (int x = 0; x < NS; ++x)
#pragma unroll
        for (int tb = 0; tb < 4; ++tb) gpre[x][tb] = *(const u32x2*)(p.proj + (size_t)(row0 + 16 * tb + fr) * LD + C::GOFF + h * DV + 16 * (wave * NS + x) + 4 * g);
    {
        const int d = HG ? (tid & 127) : (tid % 192), seg = HG ? (tid >> 7) : (tid / 192), t0 = seg * NT;
        const bool act = seg < NSEG;
        LAS bf16* qi = (LAS bf16*)(lds + QI_OFF) + d; LAS bf16* kp = (LAS bf16*)(lds + KP_OFF) + d; LAS bf16* qp = (LAS bf16*)(lds + QP_OFF) + d; const LAS bf16* zr = (const LAS bf16*)(lds + ZR_OFF) + d;
        float la_[NT / 8][8], k_[NT / 8][8]; const bool haslb = p.j != 0;
        if (act) { float tsum = 0.f;
#pragma unroll
            for (int i8 = 0; i8 < NT / 8; ++i8) { gate8<HG>((HG ? (const LAS bf16*)kp : zr) + (t0 + i8 * 8) * (RS / 2), RS / 2, bb, lb, omlb, haslb, la_[i8], k_[i8]);
#pragma unroll
                for (int j = 0; j < 8; ++j) tsum += la_[i8][j]; }
            tot[seg * DK + d] = tsum; }
        __syncthreads();
        if (act) { float cum = 0.f;
#pragma unroll
            for (int q = 0; q < NSEG; ++q) if (q < seg) cum += tot[q * DK + d];
            const float cm = HG ? tot[d] + tot[DK + d] : 0.f, ecm = HG ? fexp(cm) : 1.0f;
#pragma unroll
            for (int i8 = 0; i8 < NT / 8; ++i8) { const int tb0 = (t0 + i8 * 8) * (RS / 2);
                float qx[8], kx[8], cv[8], e1[8], e2[8];
#pragma unroll
                for (int j = 0; j < 8; ++j) qx[j] = bf2f(qi[tb0 + j * (RS / 2)]);
#pragma unroll
                for (int j = 0; j < 8; ++j) kx[j] = HG ? k_[i8][j] : bf2f(kp[tb0 + j * (RS / 2)]);
#pragma unroll
                for (int j = 0; j < 8; ++j) { cum += la_[i8][j]; cv[j] = 1.44269504f * (cum - cm); }
#pragma unroll
                for (int j = 0; j < 8; ++j) e1[j] = __builtin_amdgcn_exp2f(cv[j]);
#pragma unroll
                for (int j = 0; j < 8; ++j) e2[j] = __builtin_amdgcn_exp2f(-cv[j]);
                if (HG) { float sg[8];
#pragma unroll
                    for (int j = 0; j < 8; ++j) sg[j] = __builtin_amdgcn_exp2f(-1.44269504f * qx[j]);
#pragma unroll
                    for (int j = 0; j < 8; ++j) sg[j] = __builtin_amdgcn_rcpf(1.0f + sg[j]);
#pragma unroll
                    for (int j = 0; j < 8; ++j) { const float qpv = qx[j] * sg[j] * e1[j];
                        qi[tb0 + j * (RS / 2)] = (bf16)(pk2(qpv * ecm, 0.f) & 0xffffu); qp[tb0 + j * (RS / 2)] = (bf16)(pk2(qpv, 0.f) & 0xffffu); kp[tb0 + j * (RS / 2)] = (bf16)(pk2(kx[j] * e2[j], 0.f) & 0xffffu); }
                } else {
#pragma unroll
                    for (int j = 0; j < 8; ++j) { qi[tb0 + j * (RS / 2)] = (bf16)(pk2(qx[j] * 0.07216878364870322f * e1[j], 0.f) & 0xffffu); kp[tb0 + j * (RS / 2)] = (bf16)(pk2(kx[j] * e2[j], 0.f) & 0xffffu); }
                }
            }
        }
    }
    __syncthreads();
#pragma unroll
    for (int x = 0; x < 2; ++x) {
        const int ti = 2 * wave + x, tb = ti >> 2, sb = ti & 3;
        f32x4 acc = (f32x4){0.f, 0.f, 0.f, 0.f};
        if (sb <= tb) {
#pragma unroll
            for (int ks = 0; ks < DK / 32; ++ks) {
                const bf16x8 afr = *(const LAS bf16x8*)(lds + KP_OFF + (16 * sb + fr) * RS + ks * 64 + g * 16);
                const bf16x8 bfr = *(const LAS bf16x8*)(lds + QP_OFF + (16 * tb + fr) * RS + ks * 64 + g * 16);
                acc = __builtin_amdgcn_mfma_f32_16x16x32_bf16(afr, bfr, acc, 0, 0, 0);
            }
            const int tt = 16 * tb + fr, s0 = 16 * sb + 4 * g;
#pragma unroll
            for (int q = 0; q < 4; ++q) if (s0 + q > tt) acc[q] = 0.f;
        }
        u32x2 w; w.x = pk2(acc[0], acc[1]); w.y = pk2(acc[2], acc[3]);
        *(LAS u32x2*)(lds + P_OFF + (16 * tb + fr) * TS + (16 * sb + 4 * g) * 2) = w;
    }
    __syncthreads();
    f32x4 acc[NS][4];
#pragma unroll
    for (int x = 0; x < NS; ++x)
#pragma unroll
        for (int tb = 0; tb < 4; ++tb) acc[x][tb] = (f32x4){0.f, 0.f, 0.f, 0.f};
#pragma unroll
    for (int ks = 0; ks < DK / 32; ++ks) {
        bf16x8 bq[4];
#pragma unroll
        for (int tb = 0; tb < 4; ++tb) bq[tb] = *(const LAS bf16x8*)(lds + QI_OFF + (16 * tb + fr) * RS + ks * 64 + g * 16);
#pragma unroll
        for (int x = 0; x < NS; ++x) {
            const int ea = 16 * (wave * NS + x) + fr, sl = ea >> 7, ei = ea & 127;
            bf16x8 afr; if (HG) afr = sfr[x][ks]; else afr = *(const bf16x8*)(p.us + (((size_t)c * 12 + h * NS + sl) * 128 + ei) * DK + ks * 32 + g * 8);
#pragma unroll
            for (int tb = 0; tb < 4; ++tb) acc[x][tb] = __builtin_amdgcn_mfma_f32_16x16x32_bf16(afr, bq[tb], acc[x][tb], 0, 0, 0);
        }
    }
#pragma unroll
    for (int ks = 0; ks < 2; ++ks) {
        bf16x8 bp[4];
#pragma unroll
        for (int tb = 0; tb < 4; ++tb) bp[tb] = *(const LAS bf16x8*)(lds + P_OFF + (16 * tb + fr) * TS + ks * 64 + g * 16);
#pragma unroll
        for (int x = 0; x < NS; ++x) {
            const int ea = 16 * (wave * NS + x) + fr, sl = ea >> 7, ei = ea & 127;
            bf16x8 afr; if (HG) afr = vfr[x][ks]; else afr = *(const bf16x8*)(p.vtg + (((size_t)c * 12 + h * NS + sl) * 128 + ei) * 64 + ks * 32 + g * 8);
#pragma unroll
            for (int tb = 0; tb < 4; ++tb) acc[x][tb] = __builtin_amdgcn_mfma_f32_16x16x32_bf16(afr, bp[tb], acc[x][tb], 0, 0, 0);
        }
    }
    LAS float* red = (LAS float*)(lds + RED_OFF);
#pragma unroll
    for (int tb = 0; tb < 4; ++tb) { float ss = 0.f;
#pragma unroll
        for (int x = 0; x < NS; ++x) ss += (acc[x][tb][0] * acc[x][tb][0] + acc[x][tb][1] * acc[x][tb][1]) + (acc[x][tb][2] * acc[x][tb][2] + acc[x][tb][3] * acc[x][tb][3]);
        ss += __shfl_xor(ss, 16); ss += __shfl_xor(ss, 32);
        if (g == 0) red[wave * 64 + 16 * tb + fr] = ss; }
    __syncthreads();
#pragma unroll
    for (int tb = 0; tb < 4; ++tb) { float tsum = 0.f;
#pragma unroll
        for (int w = 0; w < 8; ++w) tsum += red[w * 64 + 16 * tb + fr];
        const float rstd = rsqrtf(tsum * (1.0f / DV) + EPS); const int row = row0 + 16 * tb + fr;
#pragma unroll
        for (int x = 0; x < NS; ++x) { const int e0 = 16 * (wave * NS + x) + 4 * g;
            const u32x2 gw2 = gpre[x][tb]; const f32x4 gn = *(const f32x4*)(p.onorm + e0);
            const float g0 = bflo(gw2.x), g1 = bfhi(gw2.x), g2 = bflo(gw2.y), g3 = bfhi(gw2.y);
            const float y0 = acc[x][tb][0] * rstd * gn.x * pg8::fsilu(g0), y1 = acc[x][tb][1] * rstd * gn.y * pg8::fsilu(g1), y2 = acc[x][tb][2] * rstd * gn.z * pg8::fsilu(g2), y3 = acc[x][tb][3] * rstd * gn.w * pg8::fsilu(g3);
            u32x2 w; w.x = pk2(y0, y1); w.y = pk2(y2, y3); *(u32x2*)(p.cat + (size_t)row * D + h * DV + e0) = w; }
    }
}
template <bool HG> __device__ __forceinline__ void xa_item(const bf16* proj, const bf16* memk, const bf16* memvt, bf16* cat, int l, int wi, int lane) {
    typedef MC<HG> C; constexpr int LD = C::LD;
    const int tblk = wi >> 2, hd = wi & 3, fr = lane & 15, g = lane >> 4, b = tblk >> 9;
    bf16x8 qf[4];
#pragma unroll
    for (int ks = 0; ks < 4; ++ks) qf[ks] = *(const bf16x8*)(proj + (size_t)(16 * tblk + fr) * LD + C::XQOFF + hd * 128 + ks * 32 + g * 8);
    f32x4 st[16];
    const bf16* kb = memk + (size_t)(b * 256 + fr) * 2048 + l * 512 + hd * 128 + g * 8;
#pragma unroll
    for (int mb = 0; mb < 16; ++mb) { f32x4 a = (f32x4){0.f, 0.f, 0.f, 0.f};
#pragma unroll
        for (int ks = 0; ks < 4; ++ks) { const bf16x8 kf = *(const bf16x8*)(kb + (size_t)(16 * mb) * 2048 + ks * 32); a = __builtin_amdgcn_mfma_f32_16x16x32_bf16(kf, qf[ks], a, 0, 0, 0); }
        st[mb] = a; }
    float mx = -3.0e38f;
#pragma unroll
    for (int mb = 0; mb < 16; ++mb) mx = fmaxf(fmaxf(fmaxf(st[mb][0], st[mb][1]), fmaxf(st[mb][2], st[mb][3])), mx);
    mx = fmaxf(mx, __shfl_xor(mx, 16)); mx = fmaxf(mx, __shfl_xor(mx, 32));
    constexpr float SC = 0.08838834764831845f * 1.44269504f; float sum = 0.f;
#pragma unroll
    for (int mb = 0; mb < 16; ++mb)
#pragma unroll
        for (int r = 0; r < 4; ++r) { const float pz = __builtin_amdgcn_exp2f((st[mb][r] - mx) * SC); st[mb][r] = pz; sum += pz; }
    sum += __shfl_xor(sum, 16); sum += __shfl_xor(sum, 32);
    const float inv = __builtin_amdgcn_rcpf(sum);
    bf16x8 pf[8];
#pragma unroll
    for (int kk = 0; kk < 8; ++kk) { u32x4 w; w.x = pk2(st[2 * kk][0], st[2 * kk][1]); w.y = pk2(st[2 * kk][2], st[2 * kk][3]); w.z = pk2(st[2 * kk + 1][0], st[2 * kk + 1][1]); w.w = pk2(st[2 * kk + 1][2], st[2 * kk + 1][3]);
        pf[kk] = __builtin_bit_cast(bf16x8, w); }
    const bf16* vb = memvt + (size_t)(l * 512 + hd * 128 + fr) * 512 + b * 256 + 4 * g;
#pragma unroll
    for (int eb = 0; eb < 8; ++eb) { f32x4 o = (f32x4){0.f, 0.f, 0.f, 0.f};
#pragma unroll
        for (int kk = 0; kk < 8; ++kk) { const u32x2 v0 = *(const u32x2*)(vb + (size_t)(16 * eb) * 512 + 32 * kk), v1 = *(const u32x2*)(vb + (size_t)(16 * eb) * 512 + 32 * kk + 16);
            u32x4 w; w.x = v0.x; w.y = v0.y; w.z = v1.x; w.w = v1.y;
            o = __builtin_amdgcn_mfma_f32_16x16x32_bf16(__builtin_bit_cast(bf16x8, w), pf[kk], o, 0, 0, 0); }
        u32x2 w; w.x = pk2(o[0] * inv, o[1] * inv); w.y = pk2(o[2] * inv, o[3] * inv);
        *(u32x2*)(cat + (size_t)(16 * tblk + fr) * D + MIXW + hd * 128 + 16 * eb + 4 * g) = w; }
}

template <bool HG, class F> __device__ __forceinline__ void xa_phase(const bf16* proj, const bf16* memk, const bf16* memvt, bf16* cat, int l, LAS unsigned char* lds, int tid, int lane, int wave, int w0, const F& other) {
    typedef MC<HG> C; constexpr int LD = C::LD, KS = 272, VS = 528, K_OFF = 0, V_OFF = 256 * KS;
    static_assert(V_OFF + 128 * VS <= 140 * 1024, "XA LDS");
    const int bx = blockIdx.x, bh = bx & 7, b = bh >> 2, hd = bh & 3, part = bx >> 3;
#pragma unroll
    for (int i = 0; i < 8; ++i) { const int ci = tid + NTHR * i, m = ci >> 4, cj = ci & 15;
        *(LAS u32x4*)(lds + K_OFF + m * KS + cj * 16) = *(const u32x4*)(memk + (size_t)(b * 256 + m) * 2048 + l * 512 + hd * 128 + cj * 8); }
#pragma unroll
    for (int i = 0; i < 8; ++i) { const int ci = tid + NTHR * i, e = ci >> 5, cj = ci & 31;
        *(LAS u32x4*)(lds + V_OFF + e * VS + cj * 16) = *(const u32x4*)(memvt + (size_t)(l * 512 + hd * 128 + e) * 512 + b * 256 + cj * 8); }
    __syncthreads();
    const int fr = lane & 15, g = lane >> 4;
    if (wave < w0) other();
    else
    for (int j = wave - w0; j < 16; j += NWAVES - w0) {
        const int tblk = b * 512 + part * 16 + j;
        bf16x8 qf[4];
#pragma unroll
        for (int ks = 0; ks < 4; ++ks) qf[ks] = *(const bf16x8*)(proj + (size_t)(16 * tblk + fr) * LD + C::XQOFF + hd * 128 + ks * 32 + g * 8);
        f32x4 st[16];
#pragma unroll
        for (int mb = 0; mb < 16; ++mb) { f32x4 a = (f32x4){0.f, 0.f, 0.f, 0.f};
#pragma unroll
            for (int ks = 0; ks < 4; ++ks) { const bf16x8 kf = *(const LAS bf16x8*)(lds + K_OFF + (16 * mb + fr) * KS + ks * 64 + g * 16); a = __builtin_amdgcn_mfma_f32_16x16x32_bf16(kf, qf[ks], a, 0, 0, 0); }
            st[mb] = a; }
        float mx = -3.0e38f;
#pragma unroll
        for (int mb = 0; mb < 16; ++mb) mx = fmaxf(fmaxf(fmaxf(st[mb][0], st[mb][1]), fmaxf(st[mb][2], st[mb][3])), mx);
        mx = fmaxf(mx, __shfl_xor(mx, 16)); mx = fmaxf(mx, __shfl_xor(mx, 32));
        constexpr float SC = 0.08838834764831845f * 1.44269504f; float sum = 0.f;
#pragma unroll
        for (int mb = 0; mb < 16; ++mb)
#pragma unroll
            for (int q = 0; q < 4; ++q) { const float pz = __builtin_amdgcn_exp2f((st[mb][q] - mx) * SC); st[mb][q] = pz; sum += pz; }
        sum += __shfl_xor(sum, 16); sum += __shfl_xor(sum, 32);
        const float inv = __builtin_amdgcn_rcpf(sum);
        bf16x8 pf[8];
#pragma unroll
        for (int kk = 0; kk < 8; ++kk) { u32x4 w; w.x = pk2(st[2 * kk][0], st[2 * kk][1]); w.y = pk2(st[2 * kk][2], st[2 * kk][3]); w.z = pk2(st[2 * kk + 1][0], st[2 * kk + 1][1]); w.w = pk2(st[2 * kk + 1][2], st[2 * kk + 1][3]);
            pf[kk] = __builtin_bit_cast(bf16x8, w); }
#pragma unroll
        for (int eb = 0; eb < 8; ++eb) { f32x4 o = (f32x4){0.f, 0.f, 0.f, 0.f};
#pragma unroll
            for (int kk = 0; kk < 8; ++kk) { const LAS unsigned char* vp = lds + V_OFF + (16 * eb + fr) * VS + (32 * kk + 4 * g) * 2;
                const u32x2 v0 = *(const LAS u32x2*)vp, v1 = *(const LAS u32x2*)(vp + 32);
                u32x4 w; w.x = v0.x; w.y = v0.y; w.z = v1.x; w.w = v1.y;
                o = __builtin_amdgcn_mfma_f32_16x16x32_bf16(__builtin_bit_cast(bf16x8, w), pf[kk], o, 0, 0, 0); }
            u32x2 w; w.x = pk2(o[0] * inv, o[1] * inv); w.y = pk2(o[2] * inv, o[3] * inv);
            *(u32x2*)(cat + (size_t)(16 * tblk + fr) * D + MIXW + hd * 128 + 16 * eb + 4 * g) = w; }
    }
    __syncthreads();
}
#define RLX_AGENT __ATOMIC_RELAXED, __HIP_MEMORY_SCOPE_AGENT
#define XB_TMO      128
#define XB_XCNT(j)  (256  + 64 * (j))
#define XB_XSUB(j)  (1280 + 64 * (j))
#define XB_XGEN(j)  (2304 + 64 * (j))
#define XB_TOP      3328
#define XB_TOPGEN   3392
#define XCD_BAR_WORDS 3456
#define XB_SPIN_CAP (1u << 18)

__device__ __forceinline__ unsigned xb_ld(unsigned* p)              { return __hip_atomic_load(p, __ATOMIC_RELAXED, __HIP_MEMORY_SCOPE_AGENT); }
__device__ __forceinline__ unsigned xb_add(unsigned* p, unsigned v) { return __hip_atomic_fetch_add(p, v, __ATOMIC_RELAXED, __HIP_MEMORY_SCOPE_AGENT); }
__device__ __forceinline__ unsigned xb_xcc_id() { return (unsigned)__builtin_amdgcn_s_getreg((3 << 11) | 20) & 0xFu; }
#define XB_SPIN(cond, bar) do { unsigned _sp = 0; while (cond) { __builtin_amdgcn_s_sleep(1); \
    if ((++_sp & 255u) == 0u) { if (xb_ld(&(bar)[XB_TMO])) break; if (_sp > XB_SPIN_CAP) { atomicAdd(&(bar)[XB_TMO], 1u); break; } } } } while (0)

struct XcdBarrier {
    unsigned* bar; unsigned x;
    volatile LAS unsigned* st;
};

__device__ __forceinline__ XcdBarrier xcd_barrier_post(unsigned* bar, volatile LAS unsigned* st) {
    XcdBarrier b; b.bar = bar; b.x = xb_xcc_id(); b.st = st;
    if (threadIdx.x == 0) (void)xb_add(&bar[XB_XCNT(b.x)], 1u);
    return b;
}
__device__ __forceinline__ void xcd_barrier_complete(unsigned* bar, unsigned x, unsigned& nloc, unsigned& nx) {
    const unsigned G = gridDim.x * gridDim.y * gridDim.z;
    unsigned sum, cnt, mine, sp = 0u;
    for (;;) {
        sum = 0u; cnt = 0u; mine = 0u;
#pragma unroll
        for (unsigned j = 0; j < 16; ++j) { const unsigned c = xb_ld(&bar[XB_XCNT(j)]); sum += c; cnt += (c > 0u) ? 1u : 0u; mine = (j == x) ? c : mine; }
        if (sum == G) break;
        __builtin_amdgcn_s_sleep(1);
        if ((++sp & 255u) == 0u) { if (xb_ld(&bar[XB_TMO])) break; if (sp > XB_SPIN_CAP) { atomicAdd(&bar[XB_TMO], 1u); break; } }
    }
    nloc = mine > 0u ? mine : 1u; nx = cnt > 0u ? cnt : 1u;
}

__device__ __forceinline__ void xcd_barrier(const XcdBarrier& b) {
    asm volatile("s_waitcnt vmcnt(0)" ::: "memory");
    __syncthreads();
    if (threadIdx.x == 0) {
        unsigned* bar = b.bar;
        __builtin_amdgcn_s_waitcnt(0);
        unsigned nloc = b.st[0], nx = b.st[1];
        if (nloc == 0u) { xcd_barrier_complete(bar, b.x, nloc, nx); b.st[0] = nloc; b.st[1] = nx; }
        const unsigned old = xb_add(&bar[XB_XSUB(b.x)], 1u);
        const unsigned gen = old / nloc;
        if (old + 1u == (gen + 1u) * nloc) {
            __builtin_amdgcn_fence(__ATOMIC_RELEASE, "agent");
            asm volatile("s_waitcnt vmcnt(0)" ::: "memory");
            const unsigned og = xb_add(&bar[XB_TOP], 1u);
            const unsigned tg = og / nx;
            if (og + 1u == (tg + 1u) * nx) xb_add(&bar[XB_TOPGEN], 1u);
            else XB_SPIN(xb_ld(&bar[XB_TOPGEN]) == tg, bar);
            __builtin_amdgcn_fence(__ATOMIC_ACQUIRE, "agent");
            xb_add(&bar[XB_XGEN(b.x)], 1u);
            asm volatile("s_waitcnt vmcnt(0)" ::: "memory");
        } else {
            XB_SPIN(xb_ld(&bar[XB_XGEN(b.x)]) == gen, bar);
            __builtin_amdgcn_fence(__ATOMIC_ACQUIRE, "agent");
            asm volatile("s_waitcnt vmcnt(0)" ::: "memory");
        }
    }
    __syncthreads();
}

#ifndef REP_P0
#define REP_P0 1
#endif
#ifndef REP_SYNC
#define REP_SYNC 0
#endif
#ifndef H_BF16
#define H_BF16 1
#endif
#ifndef REP_M2
#define REP_M2 1
#endif
#ifndef REP_M1
#define REP_M1 1
#endif
#ifndef REP_XA
#define REP_XA 1
#endif
#ifndef REP_M3
#define REP_M3 1
#endif
#ifndef REP_G13
#define REP_G13 1
#endif
#ifndef MK_SKELETON
#define MK_SKELETON 0
#endif
template <class Epi> __device__ __forceinline__ void run_gemm(LAS unsigned char* lds, const bf16* A, const bf16* Bt, int Mr, int N, int K, int G, int c, const Epi& E, int wgm = 4) {
    pg8::Gemm g{A, Bt, Mr, N, K}; pg8::StaticOrder S; S.init(Mr, N, G, c, wgm);
    pg8::gemm_phase<Epi, pg8::StaticOrder, true, true>(lds, g, S, E);
}
template <bool HG> __device__ __forceinline__ void mixer_phases(const Args& a, const XcdBarrier& xbar, LAS unsigned char* lds, int l, int tid_, int lane_, int wave_) {
#define OPAQUE_TID() int tid = threadIdx.x; asm volatile("" : "+v"(tid)); const int lane = tid & 63, wave = __builtin_amdgcn_readfirstlane(tid >> 6);
    unsigned char* ws = a.ws; const int j = l >> 1, G = gridDim.x;
    MixP p; p.proj = (const bf16*)(ws + WS_PROJ); p.us = (bf16*)(ws + WS_US); p.vtg = (bf16*)(ws + WS_VTG); p.dec = (float*)(ws + WS_DEC); p.cat = (bf16*)(ws + WS_CAT);
    p.lb = a.hgrn_lb; p.wgk = a.gla_w_gk + (size_t)j * 16 * 768; p.bgk = a.gla_b_gk + j * 768; p.onorm = HG ? a.hgrn_onorm + j * 128 : a.gla_onorm + j * 384; p.j = j;
    const bool split = HG && G == 256;
#ifndef NO_M1
    if (split && blockIdx.x < 128) { pg8::EpiScaleBf16<true> E{(bf16*)(ws + WS_PROJ) + 6144, HG_IN, (const float*)(ws + WS_SSQ2) + (size_t)(2 * l) * M * 32};
        run_gemm(lds, (const bf16*)(ws + WS_HB), wt_in(ws, l) + (size_t)6144 * D, M, 512, D, 128, (int)blockIdx.x, E); }
    for (int rep = 0; rep < REP_M1; ++rep) { OPAQUE_TID(); M1Raw<HG> r;
        int it, step, end;
        if (split) { step = 1; if (blockIdx.x < 128) { it = blockIdx.x * 8; end = it + 8; } else { it = 1024 + (blockIdx.x - 128) * 16; end = it + 16; } }
        else { it = blockIdx.x; step = G; end = 256 * 12; }
        if (it < end) m1_load<HG>(p, it, tid, r);
        for (; it < end; it += step) m1_item<HG>(p, lds, it, it + step < end ? it + step : -1, r, tid, lane, wave);
        __syncthreads(); }
#endif
#ifndef NO_XA
    if (!split)
    for (int rep = 0; rep < REP_XA; ++rep) { OPAQUE_TID();
        if (G == 256) xa_phase<HG>(p.proj, (const bf16*)(ws + WS_MEMK), (const bf16*)(ws + WS_MEMVT), p.cat, l, lds, tid, lane, wave, 0, [] {});
        else for (int wi = blockIdx.x * NWAVES + wave; wi < 4096; wi += G * NWAVES) xa_item<HG>(p.proj, (const bf16*)(ws + WS_MEMK), (const bf16*)(ws + WS_MEMVT), p.cat, l, wi, lane); }
#endif
    xcd_barrier(xbar);
#ifndef NO_M2
    if (split) { OPAQUE_TID();
        xa_phase<HG>(p.proj, (const bf16*)(ws + WS_MEMK), (const bf16*)(ws + WS_MEMVT), p.cat, l, lds, tid, lane, wave, 3, [&] { m2_scan<HG>(p, blockIdx.x * NTHR + tid, G * NTHR); }); }
    else { OPAQUE_TID(); m2_scan<HG>(p, blockIdx.x * NTHR + tid, G * NTHR); }
#if REP_M2 > 1
    { OPAQUE_TID(); MixP p2 = p; p2.us = (bf16*)(ws + WS_END); m2_scan<HG>(p2, blockIdx.x * NTHR + tid, G * NTHR); }
#endif
#endif
    xcd_barrier(xbar);
#ifndef NO_M3
    for (int rep = 0; rep < REP_M3; ++rep) { OPAQUE_TID(); constexpr int N3 = 256 * MC<HG>::NH; M3Raw<HG> r; int it = blockIdx.x; if (it < N3) m3_load<HG>(p, it, tid, r);
        for (; it < N3; it += G) m3_item<HG>(p, lds, it, it + G < N3 ? it + G : -1, r, tid, lane, wave);
        __syncthreads(); }
#endif
    xcd_barrier(xbar);
}

__global__ void __launch_bounds__(NTHR, 2) trunk_fwd(Args a) {
    extern __shared__ __attribute__((aligned(16))) unsigned char lds_raw[];
    LAS unsigned char* lds = (LAS unsigned char*)lds_raw;
    cg::grid_group grid = cg::this_grid();
    const int tid = threadIdx.x, lane = tid & 63, wave = __builtin_amdgcn_readfirstlane(tid >> 6), G = gridDim.x, bx = blockIdx.x;
    unsigned char* ws = a.ws;
    float* ssq = (float*)(ws + WS_SSQ2); float* H = (float*)(ws + WS_H); bf16* HB = (bf16*)(ws + WS_HB); bf16* CAT = (bf16*)(ws + WS_CAT); bf16* PROJ = (bf16*)(ws + WS_PROJ); bf16* ACT = PROJ;
#ifndef NO_P0
    for (int rep = 0; rep < REP_P0; ++rep) p0_prologue(a, lds, tid, lane, wave);
#endif
    { unsigned* bw = (unsigned*)(ws + WS_BAR); if (bx == 0) for (int i = tid; i < XCD_BAR_WORDS; i += NTHR) bw[i] = 0u; if (tid < 2) ((volatile LAS unsigned*)(lds + LDS_CTL))[tid] = 0u; }
    grid.sync();
    const XcdBarrier xbar = xcd_barrier_post((unsigned*)(ws + WS_BAR), (volatile LAS unsigned*)(lds + LDS_CTL));
#ifndef NO_PKV
    if (bx >= G - 32 && bx < G - 16) { pg8::EpiScaleBf16<false> E{(bf16*)(ws + WS_MEMK), 2048, nullptr}; run_gemm(lds, (const bf16*)(ws + WS_MEMN), (const bf16*)(ws + WS_WTK), MMEM, 2048, D, 16, bx - (G - 32), E); }
    else if (bx >= G - 16) { pg8::EpiScaleBf16<false> E{(bf16*)(ws + WS_MEMVT), 512, nullptr}; run_gemm(lds, (const bf16*)(ws + WS_WTV), (const bf16*)(ws + WS_MEMN), 2048, MMEM, D, 16, bx - (G - 16), E); }
#endif
#pragma unroll 1
    for (int l = 0; l < DEPTH; ++l) {
#ifndef NO_G1
        for (int rep = 0; rep < REP_G13; ++rep) { pg8::EpiScaleBf16<true> E{PROJ, n_in(l), ssq + (size_t)(2 * l) * M * 32}; run_gemm(lds, HB, wt_in(ws, l), M, (!(l & 1) && G == 256) ? 6144 : n_in(l), D, G, bx, E); }
#endif
        xcd_barrier(xbar);
        if (l & 1) mixer_phases<false>(a, xbar, lds, l, tid, lane, wave); else mixer_phases<true>(a, xbar, lds, l, tid, lane, wave);
#ifndef NO_G2
#if H_BF16
        { pg8::EpiResidBf E{HB, ssq + (size_t)(2 * l + 1) * M * 32}; run_gemm(lds, CAT, wt_out(ws, l), M, D, D, G, bx, E, WGM_G2); }
#else
        { pg8::EpiResid E{l == 0 ? a.x : H, H, HB, ssq + (size_t)(2 * l + 1) * M * 32}; run_gemm(lds, CAT, wt_out(ws, l), M, D, D, G, bx, E); }
#endif
#endif
        xcd_barrier(xbar);
        for (int rep = 0; rep < REP_SYNC; ++rep) xcd_barrier(xbar);
#ifndef NO_G3
        for (int rep = 0; rep < REP_G13; ++rep) { pg8::EpiSwiglu E{ACT, DFF, ssq + (size_t)(2 * l + 1) * M * 32}; run_gemm(lds, HB, wt_gu(ws, l), M, 2 * DFF, D, G, bx, E); }
#endif
        xcd_barrier(xbar);
#ifndef NO_G4
#if H_BF16
        { pg8::EpiResidBf E{HB, ssq + (size_t)(2 * l + 2) * M * 32}; run_gemm(lds, ACT, wt_down(ws, l), M, D, DFF, G, bx, E, WGM_G4); }
#else
        { pg8::EpiResid E{H, H, HB, ssq + (size_t)(2 * l + 2) * M * 32}; run_gemm(lds, ACT, wt_down(ws, l), M, D, DFF, G, bx, E); }
#endif
#endif
        xcd_barrier(xbar);
    }
    for (int m = bx * NWAVES + wave; m < M; m += G * NWAVES) {
        const float r = rsqrtf(wave_sum(lane < 32 ? ssq[((size_t)8 * M + m) * 32 + lane] : 0.f) * (1.0f / D) + EPS);
        const f32x4* hr = (const f32x4*)(H + (size_t)m * D) + lane; const u32x2* hb = (const u32x2*)(HB + (size_t)m * D) + lane; const f32x4* gr = (const f32x4*)a.norm_final + lane; f32x4* o = (f32x4*)(a.out + (size_t)m * D) + lane;
#pragma unroll
        for (int jj = 0; jj < 8; ++jj) { f32x4 v; if (H_BF16) { const u32x2 w = hb[64 * jj]; v = (f32x4){bflo(w.x), bfhi(w.x), bflo(w.y), bfhi(w.y)}; } else v = hr[64 * jj]; const f32x4 gg = gr[64 * jj]; o[64 * jj] = (f32x4){v.x * r * gg.x, v.y * r * gg.y, v.z * r * gg.z, v.w * r * gg.w}; }
    }
}

extern "C" void kernel_launch(void* const* d_in, const int* in_sizes, int n_in_, void* d_out, int out_size, void* d_ws, size_t ws_size, hipStream_t stream) {
    static int grid = 0;
    if (grid == 0) {
        if (n_in_ != 17 || in_sizes[0] != M * D || out_size != M * D || ws_size < WS_END) { fprintf(stderr, "kernel_launch: unexpected shapes (n_in %d, in0 %d, out %d, ws %zu < %zu)\n", n_in_, n_in_ > 0 ? in_sizes[0] : -1, out_size, ws_size, (size_t)WS_END); grid = -1; return; }
        int dev = 0, cus = 0, per_cu = 0;
        hipGetDevice(&dev); hipDeviceGetAttribute(&cus, hipDeviceAttributeMultiprocessorCount, dev);
        if (hipFuncSetAttribute((const void*)trunk_fwd, hipFuncAttributeMaxDynamicSharedMemorySize, LDS_BYTES) != hipSuccess) { fprintf(stderr, "kernel_launch: hipFuncSetAttribute failed\n"); grid = -1; return; }
        if (hipOccupancyMaxActiveBlocksPerMultiprocessor(&per_cu, (const void*)trunk_fwd, NTHR, LDS_BYTES) != hipSuccess || per_cu < 1) { fprintf(stderr, "kernel_launch: occupancy query says %d blocks per CU\n", per_cu); per_cu = 1; }
        (void)hipGetLastError();
        grid = cus;
    }
    if (grid < 0) return;
    Args a{};
    a.x = (const float*)d_in[0]; a.mem = (const float*)d_in[1]; a.norm_mix = (const float*)d_in[2]; a.norm_ffn = (const float*)d_in[3]; a.norm_mem = (const float*)d_in[4]; a.norm_final = (const float*)d_in[5];
    a.hgrn_w_in = (const float*)d_in[6]; a.hgrn_lb = (const float*)d_in[7]; a.hgrn_onorm = (const float*)d_in[8]; a.gla_w_in = (const float*)d_in[9]; a.gla_w_gk = (const float*)d_in[10]; a.gla_b_gk = (const float*)d_in[11];
    a.gla_onorm = (const float*)d_in[12]; a.w_mem_kv = (const float*)d_in[13]; a.w_out = (const float*)d_in[14]; a.w_gate_up = (const float*)d_in[15]; a.w_down = (const float*)d_in[16];
    a.out = (float*)d_out; a.ws = (unsigned char*)d_ws;
    void* args[] = {&a};
    hipError_t e = hipLaunchCooperativeKernel((const void*)trunk_fwd, dim3(grid), dim3(NTHR), args, LDS_BYTES, stream);
    if (e != hipSuccess) fprintf(stderr, "kernel_launch: cooperative launch failed: %s (grid %d)\n", hipGetErrorString(e), grid);
}
```

```cpp
#include <hip/hip_runtime.h>
#ifndef WGM_G4
#define WGM_G4 4
#endif
#ifndef WGM_G2
#define WGM_G2 4
#endif
#include <hip/hip_cooperative_groups.h>
#include <cstdio>
#include <cstdint>
namespace cg = cooperative_groups;
namespace pg8 {
#define PG8_LAS __attribute__((address_space(3)))
typedef unsigned short bf16_t;
typedef short bf16x8 __attribute__((ext_vector_type(8)));
typedef float f32x4 __attribute__((ext_vector_type(4)));
typedef unsigned u32x4 __attribute__((ext_vector_type(4)));
typedef unsigned u32x2 __attribute__((ext_vector_type(2)));
constexpr int BM = 256, BK = 64, HALF = 128, HTB = HALF * BK * 2  , STAGE_BYTES = 8 * HTB, NXCD = 8, WGM = 8;

__host__ __device__ __forceinline__ int lds_byte(int r, int c) { const int st = (r >> 4) * 2 + (c >> 5), rr = r & 15, cc = c & 31, ob = rr * 64 + cc * 2; return st * 1024 + (ob ^ (((ob >> 9) & 1) << 5)); }
__host__ __device__ __forceinline__ void stage_rc(int b, int& R, int& C) { const int st = b / 1024, sb = b % 1024, swz = sb ^ (((sb >> 9) & 1) << 5); R = (st >> 1) * 16 + swz / 64; C = (st & 1) * 32 + (swz % 64) / 2; }
__host__ __device__ __forceinline__ int perm32(int rho) { const int n = rho >> 4, i = rho & 15; return 8 * (i >> 2) + 4 * n + (i & 3); }

struct Unit { int pm, pn; };
struct Gemm { const bf16_t* A; const bf16_t* Bt; int M, N, K; };

struct StaticOrder {
    int nM, nN, nwg, G, c, wgm;
    __host__ __device__ void init(int M, int N, int G_, int c_, int wgm_ = 4) { nM = M / BM; nN = N / BM; nwg = nM * nN; G = G_; c = c_; wgm = wgm_; }
    __host__ __device__ bool next(int i, Unit& u) const {
        const long L = (long)i * G + c; if (L >= nwg) return false;
        int wgid = (int)L; { const int q = nwg / NXCD, r = nwg % NXCD, xcd = wgid % NXCD, off = wgid / NXCD; wgid = (xcd < r ? xcd * (q + 1) : r * (q + 1) + (xcd - r) * q) + off; }
        const int nig = wgm * nN, gid = wgid / nig, fm = gid * wgm, gsz = (nM - fm) < wgm ? (nM - fm) : wgm;
        u.pm = fm + ((wgid % nig) % gsz); u.pn = (wgid % nig) / gsz; return true;
    }
    __device__ __forceinline__ void a_ready(const Unit&) const {}
    __device__ __forceinline__ void done(const Unit&) const {}
};
__device__ __forceinline__ unsigned cvt_pk_bf16(float lo, float hi) { unsigned r; asm volatile("v_cvt_pk_bf16_f32 %0, %1, %2" : "=v"(r) : "v"(lo), "v"(hi)); return r; }
constexpr float RMS_EPS = 1e-6f;
__device__ __forceinline__ float row_rstd(const float* ssqp, int row, int fq) {
    const float* pr = ssqp + (size_t)row * 32 + 8 * fq; const f32x4 a = *(const f32x4*)pr, b = *(const f32x4*)(pr + 4);
    float s = ((a[0] + a[1]) + (a[2] + a[3])) + ((b[0] + b[1]) + (b[2] + b[3]));
    s += __shfl_xor(s, 16); s += __shfl_xor(s, 32);
    return rsqrtf(s * (1.0f / 2048.0f) + RMS_EPS);
}
__device__ __forceinline__ float fsilu(float g) { return g * __builtin_amdgcn_rcpf(1.0f + __builtin_amdgcn_exp2f(-1.44269504f * g)); }
template <bool SCALE> struct EpiScaleBf16 {
    static constexpr bool PERM = true, AFTER_DRAIN = false;
    bf16_t* O; int ldc; const float* ssq;
    __device__ __forceinline__ void operator()(const f32x4 (&acc)[2][2][4][2], const Unit& u, int wr, int wc, int fr, int fq) const {
        const int row0 = u.pm * BM + wr * 64 + fr, col0 = u.pn * BM + wc * 32 + 8 * fq;
#pragma unroll
        for (int ai = 0; ai < 2; ++ai)
#pragma unroll
            for (int m = 0; m < 4; ++m) {
                const int row = row0 + ai * HALF + m * 16;
                float r = 1.0f; if (SCALE) r = row_rstd(ssq, row, fq);
                bf16_t* rowp = O + (size_t)row * ldc + col0;
#pragma unroll
                for (int bj = 0; bj < 2; ++bj) { const f32x4 v0 = acc[ai][bj][m][0] * r, v1 = acc[ai][bj][m][1] * r;
                    u32x4 w; w.x = cvt_pk_bf16(v0[0], v0[1]); w.y = cvt_pk_bf16(v0[2], v0[3]); w.z = cvt_pk_bf16(v1[0], v1[1]); w.w = cvt_pk_bf16(v1[2], v1[3]);
                    *(u32x4*)(rowp + bj * HALF) = w; }
            }
    }
};
struct EpiSwiglu {
    static constexpr bool PERM = true, AFTER_DRAIN = false;
    bf16_t* O; int ldo; const float* ssq;
    __device__ __forceinline__ void operator()(const f32x4 (&acc)[2][2][4][2], const Unit& u, int wr, int wc, int fr, int fq) const {
        const int row0 = u.pm * BM + wr * 64 + fr, col0 = u.pn * HALF + wc * 32 + 8 * fq;
#pragma unroll
        for (int ai = 0; ai < 2; ++ai)
#pragma unroll
            for (int m = 0; m < 4; ++m) {
                const int row = row0 + ai * HALF + m * 16;
                const float r = row_rstd(ssq, row, fq);
                float y[8];
#pragma unroll
                for (int n = 0; n < 2; ++n)
#pragma unroll
                    for (int j = 0; j < 4; ++j) { const float g = acc[ai][0][m][n][j] * r, up = acc[ai][1][m][n][j] * r; y[n * 4 + j] = fsilu(g) * up; }
                u32x4 w; w.x = cvt_pk_bf16(y[0], y[1]); w.y = cvt_pk_bf16(y[2], y[3]); w.z = cvt_pk_bf16(y[4], y[5]); w.w = cvt_pk_bf16(y[6], y[7]);
                *(u32x4*)(O + (size_t)row * ldo + col0) = w;
            }
    }
};
struct EpiResid {
    static constexpr bool PERM = false, AFTER_DRAIN = false;
    const float* Hin; float* Hout; bf16_t* HB; float* ssq;
    __device__ __forceinline__ void operator()(const f32x4 (&acc)[2][2][4][2], const Unit& u, int wr, int wc, int fr, int fq) const {
        const int row0 = u.pm * BM + wr * 64 + fr, col0 = u.pn * BM + wc * 32 + 4 * fq;
#pragma unroll
        for (int ai = 0; ai < 2; ++ai)
#pragma unroll
            for (int m = 0; m < 4; ++m) {
                const int row = row0 + ai * HALF + m * 16; const size_t off = (size_t)row * 2048 + col0; float ss = 0.f;
#pragma unroll
                for (int bj = 0; bj < 2; ++bj)
#pragma unroll
                    for (int n = 0; n < 2; ++n) { const size_t o = off + bj * HALF + n * 16;
                        const f32x4 h = *(const f32x4*)(Hin + o) + acc[ai][bj][m][n];
                        *(f32x4*)(Hout + o) = h;
                        u32x2 w; w.x = cvt_pk_bf16(h[0], h[1]); w.y = cvt_pk_bf16(h[2], h[3]); *(u32x2*)(HB + o) = w;
                        ss += (h[0] * h[0] + h[1] * h[1]) + (h[2] * h[2] + h[3] * h[3]); }
                ss += __shfl_xor(ss, 16); ss += __shfl_xor(ss, 32);
                if (fq == 0) ssq[(size_t)row * 32 + u.pn * 4 + wc] = ss;
                if ((m & 3) == 3) asm volatile("" ::: "memory");
            }
    }
};
struct EpiResidBf {
    static constexpr bool PERM = true, AFTER_DRAIN = false;
    bf16_t* HB; float* ssq;
    __device__ __forceinline__ void operator()(const f32x4 (&acc)[2][2][4][2], const Unit& u, int wr, int wc, int fr, int fq) const {
        const int row0 = u.pm * BM + wr * 64 + fr, col0 = u.pn * BM + wc * 32 + 8 * fq;
#pragma unroll
        for (int ai = 0; ai < 2; ++ai)
#pragma unroll
            for (int m = 0; m < 4; ++m) {
                const int row = row0 + ai * HALF + m * 16; const size_t off = (size_t)row * 2048 + col0; float ss = 0.f;
#pragma unroll
                for (int bj = 0; bj < 2; ++bj) { const size_t o = off + bj * HALF;
                    const u32x4 hw = *(const u32x4*)(HB + o); u32x4 w;
#pragma unroll
                    for (int n = 0; n < 2; ++n) { const unsigned h01 = n ? hw.z : hw.x, h23 = n ? hw.w : hw.y;
                        const float h0 = __uint_as_float(h01 << 16) + acc[ai][bj][m][n][0], h1 = __uint_as_float(h01 & 0xffff0000u) + acc[ai][bj][m][n][1];
                        const float h2 = __uint_as_float(h23 << 16) + acc[ai][bj][m][n][2], h3 = __uint_as_float(h23 & 0xffff0000u) + acc[ai][bj][m][n][3];
                        const unsigned w01 = cvt_pk_bf16(h0, h1), w23 = cvt_pk_bf16(h2, h3);
                        if (n) { w.z = w01; w.w = w23; } else { w.x = w01; w.y = w23; }
                        const float r0 = __uint_as_float(w01 << 16), r1 = __uint_as_float(w01 & 0xffff0000u), r2 = __uint_as_float(w23 << 16), r3 = __uint_as_float(w23 & 0xffff0000u);
                        ss += (r0 * r0 + r1 * r1) + (r2 * r2 + r3 * r3); }
                    *(u32x4*)(HB + o) = w; }
                ss += __shfl_xor(ss, 16); ss += __shfl_xor(ss, 32);
                if (fq == 0) ssq[(size_t)row * 32 + u.pn * 4 + wc] = ss;
            }
    }
};
template <class Epi, class Sched, bool ALIGN_EPI = false, bool SP2 = false>
__device__ __forceinline__ void gemm_phase(PG8_LAS unsigned char* lds, const Gemm g, const Sched& S, const Epi& E) {
    int tid_raw = threadIdx.x; asm volatile("" : "+v"(tid_raw));
    const int tid = tid_raw, wid = __builtin_amdgcn_readfirstlane(tid >> 6), lane = tid & 63, wr = wid >> 2, wc = wid & 3, fr = lane & 15, fq = lane >> 4;
    const int K = g.K, nt = K / BK;
    unsigned voffA[2], voffB[2];
#pragma unroll
    for (int i = 0; i < 2; ++i) { int R, C; stage_rc(tid * 16 + i * 8192, R, C); const int Rb = Epi::PERM ? ((R & ~31) + perm32(R & 31)) : R;
        voffA[i] = (unsigned)(R * K + C) * 2u; voffB[i] = (unsigned)(Rb * K + C) * 2u; }
    const size_t kstep = (size_t)(BK * 2);
    const size_t hstep = (size_t)HALF * K * 2;
    const size_t tstep = 2 * hstep;
    const unsigned ldsw = (unsigned)wid * 1024u;
    const int aoff = lds_byte(wr * 64 + fr, fq * 8), boff = lds_byte(wc * 32 + fr, fq * 8);
#define PG8_SA(b, h) (((b) * 2 + (h)) * HTB)
#define PG8_SB(b, h) ((4 + (b) * 2 + (h)) * HTB)
#define PG8_STAGE(bufoff, gbase, voff) do { _Pragma("unroll") for (int _i = 0; _i < 2; ++_i) \
        __builtin_amdgcn_global_load_lds((const unsigned*)((const char*)(gbase) + (voff)[_i]), (PG8_LAS unsigned*)(lds + (bufoff) + ldsw + _i * 8192), 16, 0, 0); } while (0)
#define PG8_LDA(dst, b, h) do { _Pragma("unroll") for (int m = 0; m < 4; ++m) _Pragma("unroll") for (int k = 0; k < 2; ++k) dst[m][k] = *(const PG8_LAS bf16x8*)(lds + PG8_SA(b, h) + aoff + m * 2048 + k * 1024); } while (0)
#define PG8_LDB(dst, b, h) do { _Pragma("unroll") for (int n = 0; n < 2; ++n) _Pragma("unroll") for (int k = 0; k < 2; ++k) dst[n][k] = *(const PG8_LAS bf16x8*)(lds + PG8_SB(b, h) + boff + n * 2048 + k * 1024); } while (0)
#define PG8_MMA(ai, bj, At, Bt) do { __builtin_amdgcn_s_setprio(1); _Pragma("unroll") for (int m = 0; m < 4; ++m) _Pragma("unroll") for (int n = 0; n < 2; ++n) _Pragma("unroll") for (int k = 0; k < 2; ++k) \
        acc[ai][bj][m][n] = __builtin_amdgcn_mfma_f32_16x16x32_bf16(Bt[n][k], At[m][k], acc[ai][bj][m][n], 0, 0, 0); __builtin_amdgcn_s_setprio(0); } while (0)
#define PG8_WAIT_V(n) asm volatile("s_waitcnt vmcnt(" #n ")" ::: "memory")
#define PG8_WAIT_L(n) asm volatile("s_waitcnt lgkmcnt(" #n ")" ::: "memory")
#define PG8_BAR __builtin_amdgcn_s_barrier()
#define PG8_SCHED __builtin_amdgcn_sched_barrier(0)
    Unit cur, nxt; int ui = 0;
    if (!S.next(0, cur)) return;
    f32x4 acc[2][2][4][2];
#pragma unroll
    for (int a = 0; a < 2; ++a)
#pragma unroll
        for (int b = 0; b < 2; ++b)
#pragma unroll
            for (int m = 0; m < 4; ++m)
#pragma unroll
                for (int n = 0; n < 2; ++n) acc[a][b][m][n] = (f32x4){0.f, 0.f, 0.f, 0.f};
    bf16x8 At[4][2], B0[2][2], B1[2][2];
    const char* cA = (const char*)g.A + (size_t)cur.pm * tstep; const char* cB = (const char*)g.Bt + (size_t)cur.pn * tstep;
    S.a_ready(cur);
    if constexpr (SP2) {
        PG8_STAGE(PG8_SB(0, 0), cB, voffB); PG8_STAGE(PG8_SB(0, 1), cB + hstep, voffB); PG8_STAGE(PG8_SA(0, 0), cA, voffA); PG8_STAGE(PG8_SA(0, 1), cA + hstep, voffA);
        if (wr == 1) PG8_BAR;
        PG8_WAIT_V(2); PG8_BAR;
        PG8_STAGE(PG8_SB(1, 0), cB + kstep, voffB); PG8_STAGE(PG8_SA(1, 0), cA + kstep, voffA); PG8_STAGE(PG8_SB(1, 1), cB + hstep + kstep, voffB);
        PG8_WAIT_V(6); PG8_BAR;
    } else {
        PG8_STAGE(PG8_SB(0, 0), cB, voffB); PG8_STAGE(PG8_SA(0, 0), cA, voffA); PG8_STAGE(PG8_SB(0, 1), cB + hstep, voffB); PG8_STAGE(PG8_SA(0, 1), cA + hstep, voffA);
        if (wr == 1) PG8_BAR;
        PG8_WAIT_V(4); PG8_BAR;
        PG8_STAGE(PG8_SB(1, 0), cB + kstep, voffB); PG8_STAGE(PG8_SA(1, 0), cA + kstep, voffA); PG8_STAGE(PG8_SB(1, 1), cB + hstep + kstep, voffB);
        PG8_WAIT_V(6); PG8_BAR;
    }
    for (;;) {
        const bool has_next = S.next(ui + 1, nxt);
        const char* nA = has_next ? (const char*)g.A + (size_t)nxt.pm * tstep : cA; const char* nB = has_next ? (const char*)g.Bt + (size_t)nxt.pn * tstep : cB;
        for (int t = 0; t < nt; t += 2) {
            const bool last = (t == nt - 2);
            const char* a1 = cA + (size_t)(t + 1) * kstep;
            const char* a2 = last ? nA : cA + (size_t)(t + 2) * kstep; const char* b2 = last ? nB : cB + (size_t)(t + 2) * kstep;
            const char* a3 = a2 + kstep; const char* b3 = b2 + kstep;
            if (last && has_next) S.a_ready(nxt);
            if constexpr (SP2) {
            PG8_LDB(B0, 0, 0); PG8_LDB(B1, 0, 1); PG8_SCHED; PG8_LDA(At, 0, 0); PG8_STAGE(PG8_SA(1, 1), a1 + hstep, voffA);
            PG8_WAIT_V(8); PG8_WAIT_L(0); PG8_BAR; PG8_MMA(0, 0, At, B0); PG8_MMA(0, 1, At, B1); PG8_BAR; PG8_SCHED;
            PG8_LDA(At, 0, 1); PG8_STAGE(PG8_SB(0, 0), b2, voffB); PG8_STAGE(PG8_SB(0, 1), b2 + hstep, voffB); PG8_STAGE(PG8_SA(0, 0), a2, voffA);
            PG8_WAIT_V(8); PG8_WAIT_L(0); PG8_BAR; PG8_MMA(1, 0, At, B0); PG8_MMA(1, 1, At, B1); PG8_BAR; PG8_SCHED;
            PG8_LDB(B0, 1, 0); PG8_LDB(B1, 1, 1); PG8_SCHED; PG8_LDA(At, 1, 0); PG8_STAGE(PG8_SA(0, 1), a2 + hstep, voffA);
            PG8_WAIT_V(8); PG8_WAIT_L(0); PG8_BAR; PG8_MMA(0, 0, At, B0); PG8_MMA(0, 1, At, B1); PG8_BAR; PG8_SCHED;
            PG8_LDA(At, 1, 1); PG8_STAGE(PG8_SB(1, 0), b3, voffB); PG8_STAGE(PG8_SB(1, 1), b3 + hstep, voffB); PG8_STAGE(PG8_SA(1, 0), a3, voffA);
            PG8_WAIT_V(8); PG8_WAIT_L(0); PG8_BAR; PG8_MMA(1, 0, At, B0); PG8_MMA(1, 1, At, B1); PG8_BAR; PG8_SCHED;
            } else {
            PG8_LDB(B0, 0, 0); PG8_SCHED; PG8_LDA(At, 0, 0); PG8_STAGE(PG8_SA(1, 1), a1 + hstep, voffA);
            PG8_WAIT_L(8); PG8_BAR; PG8_WAIT_L(0); PG8_MMA(0, 0, At, B0); PG8_BAR; PG8_SCHED;
            PG8_LDB(B1, 0, 1); PG8_STAGE(PG8_SB(0, 0), b2, voffB);
            PG8_BAR; PG8_WAIT_L(0); PG8_MMA(0, 1, At, B1); PG8_BAR;
            PG8_LDA(At, 0, 1); PG8_STAGE(PG8_SA(0, 0), a2, voffA);
            PG8_BAR; PG8_WAIT_L(0); PG8_MMA(1, 0, At, B0); PG8_BAR; PG8_SCHED;
            PG8_STAGE(PG8_SB(0, 1), b2 + hstep, voffB);
            PG8_WAIT_V(6); PG8_BAR; PG8_MMA(1, 1, At, B1); PG8_BAR;
            PG8_LDB(B0, 1, 0); PG8_SCHED; PG8_LDA(At, 1, 0); PG8_STAGE(PG8_SA(0, 1), a2 + hstep, voffA);
            PG8_WAIT_L(8); PG8_BAR; PG8_WAIT_L(0); PG8_MMA(0, 0, At, B0); PG8_BAR; PG8_SCHED;
            PG8_LDB(B1, 1, 1); PG8_STAGE(PG8_SB(1, 0), b3, voffB);
            PG8_BAR; PG8_WAIT_L(0); PG8_MMA(0, 1, At, B1); PG8_BAR;
            PG8_LDA(At, 1, 1); PG8_STAGE(PG8_SA(1, 0), a3, voffA);
            PG8_BAR; PG8_WAIT_L(0); PG8_MMA(1, 0, At, B0); PG8_BAR; PG8_SCHED;
            PG8_STAGE(PG8_SB(1, 1), b3 + hstep, voffB);
            PG8_WAIT_V(6); PG8_BAR; PG8_MMA(1, 1, At, B1); PG8_BAR;
            }
        }
        if constexpr (ALIGN_EPI) { if (wr == 0) PG8_BAR; }
        if constexpr (!Epi::AFTER_DRAIN) { E(acc, cur, wr, wc, fr, fq); S.done(cur); }
        if (!has_next) break;
#pragma unroll
        for (int a = 0; a < 2; ++a)
#pragma unroll
            for (int b = 0; b < 2; ++b)
#pragma unroll
                for (int m = 0; m < 4; ++m)
#pragma unroll
                    for (int n = 0; n < 2; ++n) acc[a][b][m][n] = (f32x4){0.f, 0.f, 0.f, 0.f};
        cur = nxt; cA = nA; cB = nB; ++ui;
        if constexpr (ALIGN_EPI) { if (wr == 1) PG8_BAR; }
    }
    PG8_WAIT_V(0);
    if constexpr (!ALIGN_EPI) { if (wr == 0) PG8_BAR; }
    PG8_BAR;
    if constexpr (Epi::AFTER_DRAIN) { E.fused(acc, cur, wr, wc, fr, fq, lds, wid, lane); S.done(cur); }
#undef PG8_SA
#undef PG8_SB
#undef PG8_STAGE
#undef PG8_LDA
#undef PG8_LDB
#undef PG8_MMA
#undef PG8_WAIT_V
#undef PG8_WAIT_L
#undef PG8_BAR
#undef PG8_SCHED
}
}

#define LAS __attribute__((address_space(3)))
typedef unsigned short bf16;
typedef short bf16x8 __attribute__((ext_vector_type(8)));
typedef float f32x4 __attribute__((ext_vector_type(4)));
typedef unsigned u32x4 __attribute__((ext_vector_type(4)));
typedef unsigned u32x2 __attribute__((ext_vector_type(2)));
constexpr int NWAVES = 8, NTHR = 512;
constexpr int D = 2048, M = 16384, DEPTH = 4, NMEM = 256, MMEM = 512;
constexpr int MIXW = 1536, XAW = 512, DFF = 5632;
constexpr int HG_IN = 6656, GL_IN_SRC = 5136, GL_IN = 5888;
constexpr float EPS = 1e-6f;
constexpr size_t MiB = 1u << 20;
constexpr size_t WS_WT = 0;
constexpr size_t WT_LAYER = 100 * MiB;
constexpr size_t WS_WTK = 400 * MiB, WS_WTV = 408 * MiB, WS_MEMN = 416 * MiB, WS_MEMK = 418 * MiB, WS_MEMVT = 420 * MiB;
constexpr size_t WS_BAR = 422 * MiB, WS_DEC = 423 * MiB, WS_H = 426 * MiB, WS_HB = 554 * MiB, WS_CAT = 618 * MiB, WS_PROJ = 682 * MiB, WS_US = 890 * MiB, WS_SSQ2 = 1034 * MiB, WS_VTG = 1054 * MiB, WS_END = 1102 * MiB;
constexpr int LDS_BYTES = 144 * 1024, LDS_CTL = 143 * 1024;

struct Args {
    const float *x, *mem, *norm_mix, *norm_ffn, *norm_mem, *norm_final, *hgrn_w_in, *hgrn_lb, *hgrn_onorm, *gla_w_in, *gla_w_gk, *gla_b_gk, *gla_onorm, *w_mem_kv, *w_out, *w_gate_up, *w_down;
    float* out; unsigned char* ws;
};

__device__ __forceinline__ float bf2f(unsigned b) { return __uint_as_float(b << 16); }
__device__ __forceinline__ float bflo(unsigned w) { return __uint_as_float(w << 16); }
__device__ __forceinline__ float bfhi(unsigned w) { return __uint_as_float(w & 0xffff0000u); }
__device__ __forceinline__ unsigned pk2(float lo, float hi) { return pg8::cvt_pk_bf16(lo, hi); }
__device__ __forceinline__ float fexp(float x) { return __builtin_amdgcn_exp2f(1.44269504f * x); }
__device__ __forceinline__ float flog(float x) { return 0.69314718f * __builtin_amdgcn_logf(x); }
__device__ __forceinline__ float fsigm(float x) { return __builtin_amdgcn_rcpf(1.0f + fexp(-x)); }
__device__ __forceinline__ float wave_sum(float v) {
#pragma unroll
    for (int o = 1; o < 64; o <<= 1) v += __shfl_xor(v, o);
    return v;
}
#define LDS_WAIT() asm volatile("s_waitcnt lgkmcnt(0)" ::: "memory")

__device__ __forceinline__ int map_col(int mt, int nd) {
    if (mt == 0) return nd;
    if (mt == 1) return nd < 4608 ? nd : (nd < 5120 ? nd + 16 : -1);
    const int pn = nd >> 8, bj = (nd >> 7) & 1, c = nd & 127; return bj * DFF + 128 * pn + c;
}
__device__ __forceinline__ void conv_item(const float* W, int Nsrc, int K, bf16* WT, const float* gain, int mt, const float* wgk, int item, int nblk, LAS float* scr, int lane) {
    const int kb = item / nblk, nb = item % nblk, k0 = 64 * kb, n0 = 32 * nb;
    const int sc = map_col(mt, n0 + (lane & 31));
    float v[32];
    if (mt == 1 && n0 >= 5120) {
        float wz[16];
#pragma unroll
        for (int r = 0; r < 16; ++r) wz[r] = wgk[r * 768 + (n0 - 5120) + (lane & 31)];
#pragma unroll 4
        for (int i = 0; i < 32; ++i) { const int kk = 2 * i + (lane >> 5); const f32x4* wr = (const f32x4*)(W + (size_t)(k0 + kk) * Nsrc + 4608); float z = 0.f;
#pragma unroll
            for (int q = 0; q < 4; ++q) { const f32x4 w4 = wr[q]; z += w4[0] * wz[4 * q] + w4[1] * wz[4 * q + 1] + w4[2] * wz[4 * q + 2] + w4[3] * wz[4 * q + 3]; }
            v[i] = z; }
    } else {
#pragma unroll
        for (int i = 0; i < 32; ++i) { const int kk = 2 * i + (lane >> 5); v[i] = sc >= 0 ? W[(size_t)(k0 + kk) * Nsrc + sc] : 0.f; }
    }
    if (gain) {
#pragma unroll
        for (int i = 0; i < 32; ++i) v[i] *= gain[k0 + 2 * i + (lane >> 5)];
    }
#pragma unroll
    for (int i = 0; i < 32; ++i) scr[(2 * i + (lane >> 5)) * 33 + (lane & 31)] = v[i];
    LDS_WAIT(); asm volatile("" ::: "memory");
    const int c = lane & 7;
#pragma unroll
    for (int j = 0; j < 4; ++j) { const int n = (lane >> 3) + 8 * j; const LAS float* s = scr + (8 * c) * 33 + n;
        u32x4 o; o.x = pk2(s[0 * 33], s[1 * 33]); o.y = pk2(s[2 * 33], s[3 * 33]); o.z = pk2(s[4 * 33], s[5 * 33]); o.w = pk2(s[6 * 33], s[7 * 33]);
        *(u32x4*)(WT + (size_t)(n0 + n) * K + k0 + 8 * c) = o; }
    LDS_WAIT(); asm volatile("" ::: "memory");
}
__device__ __forceinline__ void conv_matrix(const float* W, int Nsrc, int K, int Ndst, bf16* WT, const float* gain, int mt, LAS float* scr, int lane, int& gw, int NGW, const float* wgk = nullptr) {
    const int nblk = Ndst / 32, nitems = (K / 64) * nblk;
    for (int it = gw; it < nitems; it += NGW) conv_item(W, Nsrc, K, WT, gain, mt, wgk, it, nblk, scr, lane);
    gw -= nitems % NGW; if (gw < 0) gw += NGW;
}
__device__ __forceinline__ bf16* wt_in(unsigned char* ws, int l) { return (bf16*)(ws + WS_WT + (size_t)l * WT_LAYER); }
__device__ __forceinline__ int n_in(int l) { return (l & 1) ? GL_IN : HG_IN; }
__device__ __forceinline__ bf16* wt_out(unsigned char* ws, int l) { return wt_in(ws, l) + (size_t)n_in(l) * D; }
__device__ __forceinline__ bf16* wt_gu(unsigned char* ws, int l) { return wt_out(ws, l) + (size_t)D * D; }
__device__ __forceinline__ bf16* wt_down(unsigned char* ws, int l) { return wt_gu(ws, l) + (size_t)2 * DFF * D; }

__device__ __forceinline__ void p0_prologue(const Args& a, LAS unsigned char* lds, int tid, int lane, int wave) {
    LAS float* scr = (LAS float*)(lds + wave * 8704);
    const int G = gridDim.x, gw0 = blockIdx.x * NWAVES + wave, NGW = G * NWAVES; int gw = gw0;
    unsigned char* ws = a.ws;
    for (int m = gw0; m < MMEM; m += NGW) {
        const f32x4* xr = (const f32x4*)(a.mem + (size_t)m * D) + lane; const f32x4* gr = (const f32x4*)a.norm_mem + lane; u32x2* o = (u32x2*)((bf16*)(ws + WS_MEMN) + (size_t)m * D) + lane;
        f32x4 v[8]; float s = 0.f;
#pragma unroll
        for (int j = 0; j < 8; ++j) { v[j] = xr[64 * j]; s += (v[j].x * v[j].x + v[j].y * v[j].y) + (v[j].z * v[j].z + v[j].w * v[j].w); }
        const float r = rsqrtf(wave_sum(s) * (1.0f / D) + EPS);
#pragma unroll
        for (int j = 0; j < 8; ++j) { const f32x4 g = gr[64 * j]; u32x2 w; w.x = pk2(v[j].x * r * g.x, v[j].y * r * g.y); w.y = pk2(v[j].z * r * g.z, v[j].w * r * g.w); o[64 * j] = w; }
    }
    for (int l = DEPTH - 1; l >= 0; --l) {
        const int j = l >> 1;
        if (l & 1) conv_matrix(a.gla_w_in + (size_t)j * D * GL_IN_SRC, GL_IN_SRC, D, GL_IN, wt_in(ws, l), a.norm_mix + l * D, 1, scr, lane, gw, NGW, a.gla_w_gk + (size_t)j * 16 * 768);
        else       conv_matrix(a.hgrn_w_in + (size_t)j * D * HG_IN, HG_IN, D, HG_IN, wt_in(ws, l), a.norm_mix + l * D, 0, scr, lane, gw, NGW);
        conv_matrix(a.w_out + (size_t)l * D * D, D, D, D, wt_out(ws, l), nullptr, 0, scr, lane, gw, NGW);
        conv_matrix(a.w_gate_up + (size_t)l * D * 2 * DFF, 2 * DFF, D, 2 * DFF, wt_gu(ws, l), a.norm_ffn + l * D, 2, scr, lane, gw, NGW);
        conv_matrix(a.w_down + (size_t)l * DFF * D, D, DFF, D, wt_down(ws, l), nullptr, 0, scr, lane, gw, NGW);
        conv_matrix(a.w_mem_kv + (size_t)l * D * 2 * XAW, 2 * XAW, D, XAW, (bf16*)(ws + WS_WTK) + (size_t)l * XAW * D, nullptr, 0, scr, lane, gw, NGW);
        conv_matrix(a.w_mem_kv + (size_t)l * D * 2 * XAW + XAW, 2 * XAW, D, XAW, (bf16*)(ws + WS_WTV) + (size_t)l * XAW * D, nullptr, 0, scr, lane, gw, NGW);
    }
    for (int m = gw0; m < M; m += NGW) {
        const f32x4* xr = (const f32x4*)(a.x + (size_t)m * D) + lane; u32x2* hb = (u32x2*)((bf16*)(ws + WS_HB) + (size_t)m * D) + lane;
        f32x4 v[8]; float s = 0.f;
#pragma unroll
        for (int j = 0; j < 8; ++j) v[j] = xr[64 * j];
#pragma unroll
        for (int j = 0; j < 8; ++j) { s += (v[j].x * v[j].x + v[j].y * v[j].y) + (v[j].z * v[j].z + v[j].w * v[j].w); u32x2 w; w.x = pk2(v[j].x, v[j].y); w.y = pk2(v[j].z, v[j].w); hb[64 * j] = w; }
        s = wave_sum(s); if (lane < 32) ((float*)(ws + WS_SSQ2))[(size_t)m * 32 + lane] = lane == 0 ? s : 0.f;
    }
}
template <bool HG> struct MC {
    static constexpr int DK = HG ? 128 : 192, DV = HG ? 128 : 384, NH = HG ? 12 : 4, NS = DV / 128, LD = HG ? HG_IN : GL_IN;
    static constexpr int QOFF = 0, KOFF = HG ? 1536 : 768, VOFF = HG ? 3072 : 1536, GOFF = HG ? 4608 : 3072, XQOFF = HG ? 6144 : 4608, ZOFF = 5120;
    static constexpr int RS = DK * 2 + 16;
    static constexpr int TS = 144;
};
struct MixP { const bf16* proj; bf16* vtg; bf16* us; float* dec; bf16* cat; const float* lb; const float* wgk; const float* bgk; const float* onorm; int j; };

__device__ __forceinline__ float hgrn_lb(const MixP& p, int col) {
    if (p.j == 0) return 0.f;
    return fsigm(p.lb[MIXW + col] - p.lb[col]);
}
__device__ __forceinline__ float gla_la(const LAS float* g, const float (&w)[16], float bb) {
    float z = bb;
#pragma unroll
    for (int r = 0; r < 16; ++r) z += g[r] * w[r];
    return (fminf(z, 0.f) - flog(1.0f + fexp(-fabsf(z)))) * (1.0f / 16.0f);
}
__device__ __forceinline__ float gla_lz(float z) { return flog(1.0f + fexp(-fmaxf(z, -60.f))) * (-1.0f / 16.0f); }
__device__ __forceinline__ void hg_gate(float x, float lb, float omlb, bool haslb, float& la, float& k) {
    const float e = fexp(-fmaxf(x, -60.f)), s1 = 1.0f + e; la = -flog(s1); if (haslb) la += flog(1.0f + lb * e); k = omlb * e * __builtin_amdgcn_rcpf(s1);
}
template <bool HG> __device__ __forceinline__ void load_gkl(const MixP& p, LAS float* gkl, int row0, int tid) {
    if (!HG) { const int idx = tid * 2, t = idx >> 4, r = idx & 15; const unsigned w = *(const unsigned*)(p.proj + (size_t)(row0 + t) * MC<HG>::LD + MC<HG>::GKOFF + r); gkl[idx] = bflo(w); gkl[idx + 1] = bfhi(w); }
}


template <bool HG> __device__ __forceinline__ void gate8(const LAS bf16* src, int stride, float bb, float lb, float omlb, bool haslb, float (&la)[8], float (&k)[8]) {
    float x[8], e[8], s1[8], l1[8];
#pragma unroll
    for (int j = 0; j < 8; ++j) x[j] = bf2f(src[j * stride]);
#pragma unroll
    for (int j = 0; j < 8; ++j) x[j] = -1.44269504f * fmaxf(x[j] + bb, -60.f);
#pragma unroll
    for (int j = 0; j < 8; ++j) e[j] = __builtin_amdgcn_exp2f(x[j]);
#pragma unroll
    for (int j = 0; j < 8; ++j) s1[j] = 1.0f + e[j];
#pragma unroll
    for (int j = 0; j < 8; ++j) l1[j] = __builtin_amdgcn_logf(s1[j]);
    if (HG) {
        float r[8], l2[8];
#pragma unroll
        for (int j = 0; j < 8; ++j) r[j] = __builtin_amdgcn_rcpf(s1[j]);
        if (haslb) {
#pragma unroll
            for (int j = 0; j < 8; ++j) l2[j] = __builtin_amdgcn_logf(1.0f + lb * e[j]);
        } else {
#pragma unroll
            for (int j = 0; j < 8; ++j) l2[j] = 0.f;
        }
#pragma unroll
        for (int j = 0; j < 8; ++j) { la[j] = 0.69314718f * (l2[j] - l1[j]); k[j] = omlb * e[j] * r[j]; }
    } else {
#pragma unroll
        for (int j = 0; j < 8; ++j) { la[j] = (-0.69314718f / 16.0f) * l1[j]; k[j] = 0.f; }
    }
}
template <bool HG> struct MixPar { float w[2]; };
template <bool HG> __device__ __forceinline__ void par_load(const MixP& p, int h, int tid, MixPar<HG>& q) {
    if (HG) { const int col = h * 128 + (tid & 127); q.w[0] = p.lb[col]; q.w[1] = p.lb[MIXW + col]; }
    else { q.w[0] = p.bgk[h * 192 + (tid % 192)]; q.w[1] = 0.f; }
}
template <bool HG> struct M1Raw { u32x4 k[HG ? 2 : 3]; u32x4 z[HG ? 1 : 3]; u32x4 v[2]; MixPar<HG> par; };
template <bool HG> __device__ __forceinline__ void m1_load(const MixP& p, int item, int tid, M1Raw<HG>& r) {
    typedef MC<HG> C; constexpr int DK = C::DK, LD = C::LD, CK = DK / 8;
    const int c = item / 12, hs = item % 12, h = hs / C::NS, s = hs % C::NS, row0 = c * 64;
    par_load<HG>(p, h, tid, r.par);
#pragma unroll
    for (int i = 0; i < (HG ? 2 : 3); ++i) { const int ci = tid + NTHR * i, row = ci / CK, cj = ci % CK; r.k[i] = *(const u32x4*)(p.proj + (size_t)(row0 + row) * LD + C::KOFF + h * DK + cj * 8);
        if (!HG) r.z[i] = *(const u32x4*)(p.proj + (size_t)(row0 + row) * LD + C::ZOFF + h * DK + cj * 8); }
#pragma unroll
    for (int i = 0; i < 2; ++i) { const int ci = tid + NTHR * i, row = ci >> 4, cj = ci & 15; r.v[i] = *(const u32x4*)(p.proj + (size_t)(row0 + row) * LD + C::VOFF + h * C::DV + s * 128 + cj * 8); }
}
__device__ __forceinline__ void gkl_store(LAS float* gkl, int tid, const u32x4& g) {
    if (tid < 128) { LAS f32x4* o = (LAS f32x4*)(gkl + (tid >> 1) * 16 + (tid & 1) * 8);
        o[0] = (f32x4){bflo(g.x), bfhi(g.x), bflo(g.y), bfhi(g.y)}; o[1] = (f32x4){bflo(g.z), bfhi(g.z), bflo(g.w), bfhi(g.w)}; }
}
template <bool HG> __device__ __forceinline__ void m1_item(const MixP& p, LAS unsigned char* lds, int item, int nxt, M1Raw<HG>& r, int tid, int lane, int wave) {
    typedef MC<HG> C; constexpr int DK = C::DK, TS = C::TS, CK = DK / 8, RKS = DK * 2 + 16, RVS = 272, NSEG = HG ? 4 : 2, NT = 64 / NSEG;
    const int c = item / 12, hs = item % 12, h = hs / C::NS, s = hs % C::NS;
    constexpr int KDT_OFF = 0, VT_OFF = DK * TS, RAWK_OFF = VT_OFF + 128 * TS, RAWV_OFF = RAWK_OFF + 64 * RKS, RAWZ_OFF = RAWV_OFF + 64 * RVS, TOT_OFF = RAWZ_OFF + (HG ? 0 : 64 * RKS);
    static_assert(TOT_OFF + 4 * 4 * DK <= 140 * 1024, "M1 LDS");
    LAS unsigned char* KDT = lds + KDT_OFF; LAS unsigned char* VT = lds + VT_OFF; LAS float* tot = (LAS float*)(lds + TOT_OFF);
#pragma unroll
    for (int i = 0; i < (HG ? 2 : 3); ++i) { const int ci = tid + NTHR * i, row = ci / CK, cj = ci % CK; *(LAS u32x4*)(lds + RAWK_OFF + row * RKS + cj * 16) = r.k[i]; if (!HG) *(LAS u32x4*)(lds + RAWZ_OFF + row * RKS + cj * 16) = r.z[i]; }
#pragma unroll
    for (int i = 0; i < 2; ++i) { const int ci = tid + NTHR * i, row = ci >> 4, cj = ci & 15; *(LAS u32x4*)(lds + RAWV_OFF + row * RVS + cj * 16) = r.v[i]; }
    float lb = 0.f, omlb = 1.f, bb = 0.f;
    if (HG) { lb = p.j == 0 ? 0.f : fsigm(r.par.w[1] - r.par.w[0]); omlb = 1.0f - lb; } else bb = r.par.w[0];
    __syncthreads();
    if (nxt >= 0) m1_load<HG>(p, nxt, tid, r);
    const int d = HG ? (tid & 127) : (tid % 192), seg = HG ? (tid >> 7) : (tid / 192), t0 = seg * NT;
    const bool act = seg < NSEG;
    const LAS bf16* rk = (const LAS bf16*)(lds + RAWK_OFF) + d; const LAS bf16* rz = (const LAS bf16*)(lds + RAWZ_OFF) + d;
    float la_[NT / 8][8], k_[NT / 8][8]; const bool haslb = p.j != 0;
    if (act) { float tsum = 0.f;
#pragma unroll
        for (int i8 = 0; i8 < NT / 8; ++i8) { gate8<HG>((HG ? rk : rz) + (t0 + i8 * 8) * (RKS / 2), RKS / 2, bb, lb, omlb, haslb, la_[i8], k_[i8]);
#pragma unroll
            for (int j = 0; j < 8; ++j) tsum += la_[i8][j]; }
        tot[seg * DK + d] = tsum; }
    __syncthreads();
    if (act) { float rc = 0.f;
#pragma unroll
        for (int q = 0; q < NSEG; ++q) if (q > seg) rc += tot[q * DK + d];
#pragma unroll
        for (int i8 = NT / 8 - 1; i8 >= 0; --i8) { float kd[8], rcv[8], kk[8];
#pragma unroll
            for (int j = 0; j < 8; ++j) kk[j] = HG ? k_[i8][j] : bf2f(rk[(t0 + i8 * 8 + j) * (RKS / 2)]);
#pragma unroll
            for (int j = 7; j >= 0; --j) { rcv[j] = 1.44269504f * rc; rc += la_[i8][j]; }
#pragma unroll
            for (int j = 0; j < 8; ++j) rcv[j] = __builtin_amdgcn_exp2f(rcv[j]);
#pragma unroll
            for (int j = 0; j < 8; ++j) kd[j] = kk[j] * rcv[j];
            u32x4 w; w.x = pk2(kd[0], kd[1]); w.y = pk2(kd[2], kd[3]); w.z = pk2(kd[4], kd[5]); w.w = pk2(kd[6], kd[7]);
            *(LAS u32x4*)(KDT + d * TS + (t0 + i8 * 8) * 2) = w; }
        if (seg == 0 && s == 0) p.dec[((size_t)c * C::NH + h) * DK + d] = fexp(rc); }
    {
        const int e = tid & 127, tv = (tid >> 7) * 16; const LAS bf16* rv = (const LAS bf16*)(lds + RAWV_OFF) + e; unsigned xs[16];
#pragma unroll
        for (int i = 0; i < 16; ++i) xs[i] = rv[(tv + i) * (RVS / 2)];
#pragma unroll
        for (int q = 0; q < 2; ++q) { u32x4 w; w.x = xs[q * 8] | (xs[q * 8 + 1] << 16); w.y = xs[q * 8 + 2] | (xs[q * 8 + 3] << 16); w.z = xs[q * 8 + 4] | (xs[q * 8 + 5] << 16); w.w = xs[q * 8 + 6] | (xs[q * 8 + 7] << 16);
            *(LAS u32x4*)(VT + e * TS + (tv + q * 8) * 2) = w; }
    }
    __syncthreads();
    {
        const int fr = lane & 15, g = lane >> 4, eb = wave;
        f32x4 acc[DK / 16];
#pragma unroll
        for (int db = 0; db < DK / 16; ++db) acc[db] = (f32x4){0.f, 0.f, 0.f, 0.f};
#pragma unroll
        for (int ks = 0; ks < 2; ++ks) {
            const bf16x8 bfr = *(const LAS bf16x8*)(VT + (16 * eb + fr) * TS + ks * 64 + g * 16);
#pragma unroll
            for (int db = 0; db < DK / 16; ++db) { const bf16x8 afr = *(const LAS bf16x8*)(KDT + (16 * db + fr) * TS + ks * 64 + g * 16);
                acc[db] = __builtin_amdgcn_mfma_f32_16x16x32_bf16(afr, bfr, acc[db], 0, 0, 0); }
        }
        bf16* dst = p.us + (((size_t)c * 12 + hs) * 128 + 16 * eb + fr) * DK + 4 * g;
#pragma unroll
        for (int db = 0; db < DK / 16; ++db) { u32x2 w; w.x = pk2(acc[db][0], acc[db][1]); w.y = pk2(acc[db][2], acc[db][3]); *(u32x2*)(dst + 16 * db) = w; }
        bf16* vt = p.vtg + ((size_t)c * 12 + hs) * 128 * 64;
#pragma unroll
        for (int i = 0; i < 2; ++i) { const int ci = tid + NTHR * i, e = ci >> 3, part = ci & 7; *(u32x4*)(vt + e * 64 + part * 8) = *(const LAS u32x4*)(VT + e * TS + part * 16); }
    }
}

template <bool HG> __device__ __forceinline__ void m2_scan(const MixP& p, int gtid, int gthreads) {
    typedef MC<HG> C; constexpr int DK = C::DK, D8 = DK / 8, NIT = 2 * 12 * 128 * D8;
    const int nblk = gthreads / NTHR, per = ((NIT + nblk - 1) / nblk + 63) & ~63, bidx = gtid / NTHR, lt = gtid % NTHR;
    for (int it = bidx * per + lt; lt < per && it < NIT; it += NIT) {
        const int d8 = it % D8, e = (it / D8) % 128, hs = (it / (D8 * 128)) % 12, b = it / (D8 * 128 * 12), h = hs / C::NS;
        bf16* up = p.us + (((size_t)(b * 128) * 12 + hs) * 128 + e) * DK + d8 * 8; const size_t ustr = (size_t)12 * 128 * DK;
        const float* dp = p.dec + ((size_t)(b * 128) * C::NH + h) * DK + d8 * 8; const size_t dstr = (size_t)C::NH * DK;
        float S[8];
#pragma unroll
        for (int i = 0; i < 8; ++i) S[i] = 0.f;
        for (int n0 = 0; n0 < 128; n0 += 8) {
            u32x4 u[8]; f32x4 d0[8], d1[8];
#pragma unroll
            for (int k = 0; k < 8; ++k) { u[k] = *(const u32x4*)(up + (size_t)(n0 + k) * ustr); d0[k] = *(const f32x4*)(dp + (size_t)(n0 + k) * dstr); d1[k] = *(const f32x4*)(dp + (size_t)(n0 + k) * dstr + 4); }
#pragma unroll
            for (int k = 0; k < 8; ++k) {
                u32x4 w; w.x = pk2(S[0], S[1]); w.y = pk2(S[2], S[3]); w.z = pk2(S[4], S[5]); w.w = pk2(S[6], S[7]);
                *(u32x4*)(up + (size_t)(n0 + k) * ustr) = w;
                S[0] = d0[k].x * S[0] + bflo(u[k].x); S[1] = d0[k].y * S[1] + bfhi(u[k].x); S[2] = d0[k].z * S[2] + bflo(u[k].y); S[3] = d0[k].w * S[3] + bfhi(u[k].y);
                S[4] = d1[k].x * S[4] + bflo(u[k].z); S[5] = d1[k].y * S[5] + bfhi(u[k].z); S[6] = d1[k].z * S[6] + bflo(u[k].w); S[7] = d1[k].w * S[7] + bfhi(u[k].w);
            }
        }
    }
}

template <bool HG> struct M3Raw { u32x4 q[HG ? 2 : 3]; u32x4 k[HG ? 2 : 3]; u32x4 z[HG ? 1 : 3]; MixPar<HG> par; };
template <bool HG> __device__ __forceinline__ void m3_load(const MixP& p, int item, int tid, M3Raw<HG>& r) {
    typedef MC<HG> C; constexpr int DK = C::DK, LD = C::LD, CK = DK / 8;
    const int c = item / C::NH, h = item % C::NH, row0 = c * 64;
    par_load<HG>(p, h, tid, r.par);
#pragma unroll
    for (int i = 0; i < (HG ? 2 : 3); ++i) { const int ci = tid + NTHR * i, row = ci / CK, cj = ci % CK; const bf16* b = p.proj + (size_t)(row0 + row) * LD + h * DK + cj * 8;
        r.q[i] = *(const u32x4*)(b + C::QOFF); r.k[i] = *(const u32x4*)(b + C::KOFF); if (!HG) r.z[i] = *(const u32x4*)(b + C::ZOFF); }
}
template <bool HG> __device__ __forceinline__ void m3_item(const MixP& p, LAS unsigned char* lds, int item, int nxt, M3Raw<HG>& r, int tid, int lane, int wave) {
    typedef MC<HG> C; constexpr int DK = C::DK, DV = C::DV, LD = C::LD, TS = C::TS, RS = C::RS, NS = C::NS, CK = DK / 8, NSEG = HG ? 4 : 2, NT = 64 / NSEG;
    const int c = item / C::NH, h = item % C::NH, row0 = c * 64;
    constexpr int QI_OFF = 0, KP_OFF = 64 * RS, QP_OFF = HG ? 2 * 64 * RS : 0, P_OFF = (HG ? 3 : 2) * 64 * RS, RED_OFF = P_OFF + 64 * TS, ZR_OFF = RED_OFF + 2048, TOT_OFF = ZR_OFF + (HG ? 0 : 64 * RS);
    static_assert(TOT_OFF + 4 * 4 * DK <= 140 * 1024, "M3 LDS");
    LAS float* tot = (LAS float*)(lds + TOT_OFF);
#pragma unroll
    for (int i = 0; i < (HG ? 2 : 3); ++i) { const int ci = tid + NTHR * i, row = ci / CK, cj = ci % CK; *(LAS u32x4*)(lds + QI_OFF + row * RS + cj * 16) = r.q[i]; *(LAS u32x4*)(lds + KP_OFF + row * RS + cj * 16) = r.k[i]; if (!HG) *(LAS u32x4*)(lds + ZR_OFF + row * RS + cj * 16) = r.z[i]; }
    float lb = 0.f, omlb = 1.f, bb = 0.f;
    if (HG) { lb = p.j == 0 ? 0.f : fsigm(r.par.w[1] - r.par.w[0]); omlb = 1.0f - lb; } else bb = r.par.w[0];
    __syncthreads();
    const int fr = lane & 15, g = lane >> 4;
    bf16x8 sfr[NS][DK / 32], vfr[NS][2];
    if (HG)
#pragma unroll
    for (int x = 0; x < NS; ++x) { const int ea = 16 * (wave * NS + x) + fr, sl = ea >> 7, ei = ea & 127;
#pragma unroll
        for (int ks = 0; ks < DK / 32; ++ks) sfr[x][ks] = *(const bf16x8*)(p.us + (((size_t)c * 12 + h * NS + sl) * 128 + ei) * DK + ks * 32 + g * 8);
#pragma unroll
        for (int ks = 0; ks < 2; ++ks) vfr[x][ks] = *(const bf16x8*)(p.vtg + (((size_t)c * 12 + h * NS + sl) * 128 + ei) * 64 + ks * 32 + g * 8); }
    if (nxt >= 0) m3_load<HG>(p, nxt, tid, r);
    u32x2 gpre[NS][4];
#pragma unroll
    for (int x = 0; x < NS; ++x)
#pragma unroll
        for (int tb = 0; tb < 4; ++tb) gpre[x][tb] = *(const u32x2*)(p.proj + (size_t)(row0 + 16 * tb + fr) * LD + C::GOFF + h * DV + 16 * (wave * NS + x) + 4 * g);
    {
        const int d = HG ? (tid & 127) : (tid % 192), seg = HG ? (tid >> 7) : (tid / 192), t0 = seg * NT;
        const bool act = seg < NSEG;
        LAS bf16* qi = (LAS bf16*)(lds + QI_OFF) + d; LAS bf16* kp = (LAS bf16*)(lds + KP_OFF) + d; LAS bf16* qp = (LAS bf16*)(lds + QP_OFF) + d; const LAS bf16* zr = (const LAS bf16*)(lds + ZR_OFF) + d;
        float la_[NT / 8][8], k_[NT / 8][8]; const bool haslb = p.j != 0;
        if (act) { float tsum = 0.f;
#pragma unroll
            for (int i8 = 0; i8 < NT / 8; ++i8) { gate8<HG>((HG ? (const LAS bf16*)kp : zr) + (t0 + i8 * 8) * (RS / 2), RS / 2, bb, lb, omlb, haslb, la_[i8], k_[i8]);
#pragma unroll
                for (int j = 0; j < 8; ++j) tsum += la_[i8][j]; }
            tot[seg * DK + d] = tsum; }
        __syncthreads();
        if (act) { float cum = 0.f;
#pragma unroll
            for (int q = 0; q < NSEG; ++q) if (q < seg) cum += tot[q * DK + d];
            const float cm = HG ? tot[d] + tot[DK + d] : 0.f, ecm = HG ? fexp(cm) : 1.0f;
#pragma unroll
            for (int i8 = 0; i8 < NT / 8; ++i8) { const int tb0 = (t0 + i8 * 8) * (RS / 2);
                float qx[8], kx[8], cv[8], e1[8], e2[8];
#pragma unroll
                for (int j = 0; j < 8; ++j) qx[j] = bf2f(qi[tb0 + j * (RS / 2)]);
#pragma unroll
                for (int j = 0; j < 8; ++j) kx[j] = HG ? k_[i8][j] : bf2f(kp[tb0 + j * (RS / 2)]);
#pragma unroll
                for (int j = 0; j < 8; ++j) { cum += la_[i8][j]; cv[j] = 1.44269504f * (cum - cm); }
#pragma unroll
                for (int j = 0; j < 8; ++j) e1[j] = __builtin_amdgcn_exp2f(cv[j]);
#pragma unroll
                for (int j = 0; j < 8; ++j) e2[j] = __builtin_amdgcn_exp2f(-cv[j]);
                if (HG) { float sg[8];
#pragma unroll
                    for (int j = 0; j < 8; ++j) sg[j] = __builtin_amdgcn_exp2f(-1.44269504f * qx[j]);
#pragma unroll
                    for (int j = 0; j < 8; ++j) sg[j] = __builtin_amdgcn_rcpf(1.0f + sg[j]);
#pragma unroll
                    for (int j = 0; j < 8; ++j) { const float qpv = qx[j] * sg[j] * e1[j];
                        qi[tb0 + j * (RS / 2)] = (bf16)(pk2(qpv * ecm, 0.f) & 0xffffu); qp[tb0 + j * (RS / 2)] = (bf16)(pk2(qpv, 0.f) & 0xffffu); kp[tb0 + j * (RS / 2)] = (bf16)(pk2(kx[j] * e2[j], 0.f) & 0xffffu); }
                } else {
#pragma unroll
                    for (int j = 0; j < 8; ++j) { qi[tb0 + j * (RS / 2)] = (bf16)(pk2(qx[j] * 0.07216878364870322f * e1[j], 0.f) & 0xffffu); kp[tb0 + j * (RS / 2)] = (bf16)(pk2(kx[j] * e2[j], 0.f) & 0xffffu); }
                }
            }
        }
    }
    __syncthreads();
#pragma unroll
    for (int x = 0; x < 2; ++x) {
        const int ti = 2 * wave + x, tb = ti >> 2, sb = ti & 3;
        f32x4 acc = (f32x4){0.f, 0.f, 0.f, 0.f};
        if (sb <= tb) {
#pragma unroll
            for (int ks = 0; ks < DK / 32; ++ks) {
                const bf16x8 afr = *(const LAS bf16x8*)(lds + KP_OFF + (16 * sb + fr) * RS + ks * 64 + g * 16);
                const bf16x8 bfr = *(const LAS bf16x8*)(lds + QP_OFF + (16 * tb + fr) * RS + ks * 64 + g * 16);
                acc = __builtin_amdgcn_mfma_f32_16x16x32_bf16(afr, bfr, acc, 0, 0, 0);
            }
            const int tt = 16 * tb + fr, s0 = 16 * sb + 4 * g;
#pragma unroll
            for (int q = 0; q < 4; ++q) if (s0 + q > tt) acc[q] = 0.f;
        }
        u32x2 w; w.x = pk2(acc[0], acc[1]); w.y = pk2(acc[2], acc[3]);
        *(LAS u32x2*)(lds + P_OFF + (16 * tb + fr) * TS + (16 * sb + 4 * g) * 2) = w;
    }
    __syncthreads();
    f32x4 acc[NS][4];
#pragma unroll
    for (int x = 0; x < NS; ++x)
#pragma unroll
        for (int tb = 0; tb < 4; ++tb) acc[x][tb] = (f32x4){0.f, 0.f, 0.f, 0.f};
#pragma unroll
    for (int ks = 0; ks < DK / 32; ++ks) {
        bf16x8 bq[4];
#pragma unroll
        for (int tb = 0; tb < 4; ++tb) bq[tb] = *(const LAS bf16x8*)(lds + QI_OFF + (16 * tb + fr) * RS + ks * 64 + g * 16);
#pragma unroll
        for (int x = 0; x < NS; ++x) {
            const int ea = 16 * (wave * NS + x) + fr, sl = ea >> 7, ei = ea & 127;
            bf16x8 afr; if (HG) afr = sfr[x][ks]; else afr = *(const bf16x8*)(p.us + (((size_t)c * 12 + h * NS + sl) * 128 + ei) * DK + ks * 32 + g * 8);
#pragma unroll
            for (int tb = 0; tb < 4; ++tb) acc[x][tb] = __builtin_amdgcn_mfma_f32_16x16x32_bf16(afr, bq[tb], acc[x][tb], 0, 0, 0);
        }
    }
#pragma unroll
    for (int ks = 0; ks < 2; ++ks) {
        bf16x8 bp[4];
#pragma unroll
        for (int tb = 0; tb < 4; ++tb) bp[tb] = *(const LAS bf16x8*)(lds + P_OFF + (16 * tb + fr) * TS + ks * 64 + g * 16);
#pragma unroll
        for (int x = 0; x < NS; ++x) {
            const int ea = 16 * (wave * NS + x) + fr, sl = ea >> 7, ei = ea & 127;
            bf16x8 afr; if (HG) afr = vfr[x][ks]; else afr = *(const bf16x8*)(p.vtg + (((size_t)c * 12 + h * NS + sl) * 128 + ei) * 64 + ks * 32 + g * 8);
#pragma unroll
            for (int tb = 0; tb < 4; ++tb) acc[x][tb] = __builtin_amdgcn_mfma_f32_16x16x32_bf16(afr, bp[tb], acc[x][tb], 0, 0, 0);
        }
    }
    LAS float* red = (LAS float*)(lds + RED_OFF);
#pragma unroll
    for (int tb = 0; tb < 4; ++tb) { float ss = 0.f;
#pragma unroll
        for (int x = 0; x < NS; ++x) ss += (acc[x][tb][0] * acc[x][tb][0] + acc[x][tb][1] * acc[x][tb][1]) + (acc[x][tb][2] * acc[x][tb][2] + acc[x][tb][3] * acc[x][tb][3]);
        ss += __shfl_xor(ss, 16); ss += __shfl_xor(ss, 32);
        if (g == 0) red[wave * 64 + 16 * tb + fr] = ss; }
    __syncthreads();
#pragma unroll
    for (int tb = 0; tb < 4; ++tb) { float tsum = 0.f;
#pragma unroll
        for (int w = 0; w < 8; ++w) tsum += red[w * 64 + 16 * tb + fr];
        const float rstd = rsqrtf(tsum * (1.0f / DV) + EPS); const int row = row0 + 16 * tb + fr;
#pragma unroll
        for (int x = 0; x < NS; ++x) { const int e0 = 16 * (wave * NS + x) + 4 * g;
            const u32x2 gw2 = gpre[x][tb]; const f32x4 gn = *(const f32x4*)(p.onorm + e0);
            const float g0 = bflo(gw2.x), g1 = bfhi(gw2.x), g2 = bflo(gw2.y), g3 = bfhi(gw2.y);
            const float y0 = acc[x][tb][0] * rstd * gn.x * pg8::fsilu(g0), y1 = acc[x][tb][1] * rstd * gn.y * pg8::fsilu(g1), y2 = acc[x][tb][2] * rstd * gn.z * pg8::fsilu(g2), y3 = acc[x][tb][3] * rstd * gn.w * pg8::fsilu(g3);
            u32x2 w; w.x = pk2(y0, y1); w.y = pk2(y2, y3); *(u32x2*)(p.cat + (size_t)row * D + h * DV + e0) = w; }
    }
}
template <bool HG> __device__ __forceinline__ void xa_item(const bf16* proj, const bf16* memk, const bf16* memvt, bf16* cat, int l, int wi, int lane) {
    typedef MC<HG> C; constexpr int LD = C::LD;
    const int tblk = wi >> 2, hd = wi & 3, fr = lane & 15, g = lane >> 4, b = tblk >> 9;
    bf16x8 qf[4];
#pragma unroll
    for (int ks = 0; ks < 4; ++ks) qf[ks] = *(const bf16x8*)(proj + (size_t)(16 * tblk + fr) * LD + C::XQOFF + hd * 128 + ks * 32 + g * 8);
    f32x4 st[16];
    const bf16* kb = memk + (size_t)(b * 256 + fr) * 2048 + l * 512 + hd * 128 + g * 8;
#pragma unroll
    for (int mb = 0; mb < 16; ++mb) { f32x4 a = (f32x4){0.f, 0.f, 0.f, 0.f};
#pragma unroll
        for (int ks = 0; ks < 4; ++ks) { const bf16x8 kf = *(const bf16x8*)(kb + (size_t)(16 * mb) * 2048 + ks * 32); a = __builtin_amdgcn_mfma_f32_16x16x32_bf16(kf, qf[ks], a, 0, 0, 0); }
        st[mb] = a; }
    float mx = -3.0e38f;
#pragma unroll
    for (int mb = 0; mb < 16; ++mb) mx = fmaxf(fmaxf(fmaxf(st[mb][0], st[mb][1]), fmaxf(st[mb][2], st[mb][3])), mx);
    mx = fmaxf(mx, __shfl_xor(mx, 16)); mx = fmaxf(mx, __shfl_xor(mx, 32));
    constexpr float SC = 0.08838834764831845f * 1.44269504f; float sum = 0.f;
#pragma unroll
    for (int mb = 0; mb < 16; ++mb)
#pragma unroll
        for (int r = 0; r < 4; ++r) { const float pz = __builtin_amdgcn_exp2f((st[mb][r] - mx) * SC); st[mb][r] = pz; sum += pz; }
    sum += __shfl_xor(sum, 16); sum += __shfl_xor(sum, 32);
    const float inv = __builtin_amdgcn_rcpf(sum);
    bf16x8 pf[8];
#pragma unroll
    for (int kk = 0; kk < 8; ++kk) { u32x4 w; w.x = pk2(st[2 * kk][0], st[2 * kk][1]); w.y = pk2(st[2 * kk][2], st[2 * kk][3]); w.z = pk2(st[2 * kk + 1][0], st[2 * kk + 1][1]); w.w = pk2(st[2 * kk + 1][2], st[2 * kk + 1][3]);
        pf[kk] = __builtin_bit_cast(bf16x8, w); }
    const bf16* vb = memvt + (size_t)(l * 512 + hd * 128 + fr) * 512 + b * 256 + 4 * g;
#pragma unroll
    for (int eb = 0; eb < 8; ++eb) { f32x4 o = (f32x4){0.f, 0.f, 0.f, 0.f};
#pragma unroll
        for (int kk = 0; kk < 8; ++kk) { const u32x2 v0 = *(const u32x2*)(vb + (size_t)(16 * eb) * 512 + 32 * kk), v1 = *(const u32x2*)(vb + (size_t)(16 * eb) * 512 + 32 * kk + 16);
            u32x4 w; w.x = v0.x; w.y = v0.y; w.z = v1.x; w.w = v1.y;
            o = __builtin_amdgcn_mfma_f32_16x16x32_bf16(__builtin_bit_cast(bf16x8, w), pf[kk], o, 0, 0, 0); }
        u32x2 w; w.x = pk2(o[0] * inv, o[1] * inv); w.y = pk2(o[2] * inv, o[3] * inv);
        *(u32x2*)(cat + (size_t)(16 * tblk + fr) * D + MIXW + hd * 128 + 16 * eb + 4 * g) = w; }
}

template <bool HG> __device__ __forceinline__ void xa_phase(const bf16* proj, const bf16* memk, const bf16* memvt, bf16* cat, int l, LAS unsigned char* lds, int tid, int lane, int wave) {
    typedef MC<HG> C; constexpr int LD = C::LD, KS = 272, VS = 528, K_OFF = 0, V_OFF = 256 * KS;
    static_assert(V_OFF + 128 * VS <= 140 * 1024, "XA LDS");
    const int bx = blockIdx.x, bh = bx & 7, b = bh >> 2, hd = bh & 3, part = bx >> 3;
#pragma unroll
    for (int i = 0; i < 8; ++i) { const int ci = tid + NTHR * i, m = ci >> 4, cj = ci & 15;
        *(LAS u32x4*)(lds + K_OFF + m * KS + cj * 16) = *(const u32x4*)(memk + (size_t)(b * 256 + m) * 2048 + l * 512 + hd * 128 + cj * 8); }
#pragma unroll
    for (int i = 0; i < 8; ++i) { const int ci = tid + NTHR * i, e = ci >> 5, cj = ci & 31;
        *(LAS u32x4*)(lds + V_OFF + e * VS + cj * 16) = *(const u32x4*)(memvt + (size_t)(l * 512 + hd * 128 + e) * 512 + b * 256 + cj * 8); }
    __syncthreads();
    const int fr = lane & 15, g = lane >> 4;
    for (int j = wave; j < 16; j += NWAVES) {
        const int tblk = b * 512 + part * 16 + j;
        bf16x8 qf[4];
#pragma unroll
        for (int ks = 0; ks < 4; ++ks) qf[ks] = *(const bf16x8*)(proj + (size_t)(16 * tblk + fr) * LD + C::XQOFF + hd * 128 + ks * 32 + g * 8);
        f32x4 st[16];
#pragma unroll
        for (int mb = 0; mb < 16; ++mb) { f32x4 a = (f32x4){0.f, 0.f, 0.f, 0.f};
#pragma unroll
            for (int ks = 0; ks < 4; ++ks) { const bf16x8 kf = *(const LAS bf16x8*)(lds + K_OFF + (16 * mb + fr) * KS + ks * 64 + g * 16); a = __builtin_amdgcn_mfma_f32_16x16x32_bf16(kf, qf[ks], a, 0, 0, 0); }
            st[mb] = a; }
        float mx = -3.0e38f;
#pragma unroll
        for (int mb = 0; mb < 16; ++mb) mx = fmaxf(fmaxf(fmaxf(st[mb][0], st[mb][1]), fmaxf(st[mb][2], st[mb][3])), mx);
        mx = fmaxf(mx, __shfl_xor(mx, 16)); mx = fmaxf(mx, __shfl_xor(mx, 32));
        constexpr float SC = 0.08838834764831845f * 1.44269504f; float sum = 0.f;
#pragma unroll
        for (int mb = 0; mb < 16; ++mb)
#pragma unroll
            for (int q = 0; q < 4; ++q) { const float pz = __builtin_amdgcn_exp2f((st[mb][q] - mx) * SC); st[mb][q] = pz; sum += pz; }
        sum += __shfl_xor(sum, 16); sum += __shfl_xor(sum, 32);
        const float inv = __builtin_amdgcn_rcpf(sum);
        bf16x8 pf[8];
#pragma unroll
        for (int kk = 0; kk < 8; ++kk) { u32x4 w; w.x = pk2(st[2 * kk][0], st[2 * kk][1]); w.y = pk2(st[2 * kk][2], st[2 * kk][3]); w.z = pk2(st[2 * kk + 1][0], st[2 * kk + 1][1]); w.w = pk2(st[2 * kk + 1][2], st[2 * kk + 1][3]);
            pf[kk] = __builtin_bit_cast(bf16x8, w); }
#pragma unroll
        for (int eb = 0; eb < 8; ++eb) { f32x4 o = (f32x4){0.f, 0.f, 0.f, 0.f};
#pragma unroll
            for (int kk = 0; kk < 8; ++kk) { const LAS unsigned char* vp = lds + V_OFF + (16 * eb + fr) * VS + (32 * kk + 4 * g) * 2;
                const u32x2 v0 = *(const LAS u32x2*)vp, v1 = *(const LAS u32x2*)(vp + 32);
                u32x4 w; w.x = v0.x; w.y = v0.y; w.z = v1.x; w.w = v1.y;
                o = __builtin_amdgcn_mfma_f32_16x16x32_bf16(__builtin_bit_cast(bf16x8, w), pf[kk], o, 0, 0, 0); }
            u32x2 w; w.x = pk2(o[0] * inv, o[1] * inv); w.y = pk2(o[2] * inv, o[3] * inv);
            *(u32x2*)(cat + (size_t)(16 * tblk + fr) * D + MIXW + hd * 128 + 16 * eb + 4 * g) = w; }
    }
    __syncthreads();
}
#define RLX_AGENT __ATOMIC_RELAXED, __HIP_MEMORY_SCOPE_AGENT
#define XB_TMO      128
#define XB_XCNT(j)  (256  + 64 * (j))
#define XB_XSUB(j)  (1280 + 64 * (j))
#define XB_XGEN(j)  (2304 + 64 * (j))
#define XB_TOP      3328
#define XB_TOPGEN   3392
#define XCD_BAR_WORDS 3456
#define XB_SPIN_CAP (1u << 18)

__device__ __forceinline__ unsigned xb_ld(unsigned* p)              { return __hip_atomic_load(p, __ATOMIC_RELAXED, __HIP_MEMORY_SCOPE_AGENT); }
__device__ __forceinline__ unsigned xb_add(unsigned* p, unsigned v) { return __hip_atomic_fetch_add(p, v, __ATOMIC_RELAXED, __HIP_MEMORY_SCOPE_AGENT); }
__device__ __forceinline__ unsigned xb_xcc_id() { return (unsigned)__builtin_amdgcn_s_getreg((3 << 11) | 20) & 0xFu; }
#define XB_SPIN(cond, bar) do { unsigned _sp = 0; while (cond) { __builtin_amdgcn_s_sleep(1); \
    if ((++_sp & 255u) == 0u) { if (xb_ld(&(bar)[XB_TMO])) break; if (_sp > XB_SPIN_CAP) { atomicAdd(&(bar)[XB_TMO], 1u); break; } } } } while (0)

struct XcdBarrier {
    unsigned* bar; unsigned x;
    volatile LAS unsigned* st;
};

__device__ __forceinline__ XcdBarrier xcd_barrier_post(unsigned* bar, volatile LAS unsigned* st) {
    XcdBarrier b; b.bar = bar; b.x = xb_xcc_id(); b.st = st;
    if (threadIdx.x == 0) (void)xb_add(&bar[XB_XCNT(b.x)], 1u);
    return b;
}
__device__ __forceinline__ void xcd_barrier_complete(unsigned* bar, unsigned x, unsigned& nloc, unsigned& nx) {
    const unsigned G = gridDim.x * gridDim.y * gridDim.z;
    unsigned sum, cnt, mine, sp = 0u;
    for (;;) {
        sum = 0u; cnt = 0u; mine = 0u;
#pragma unroll
        for (unsigned j = 0; j < 16; ++j) { const unsigned c = xb_ld(&bar[XB_XCNT(j)]); sum += c; cnt += (c > 0u) ? 1u : 0u; mine = (j == x) ? c : mine; }
        if (sum == G) break;
        __builtin_amdgcn_s_sleep(1);
        if ((++sp & 255u) == 0u) { if (xb_ld(&bar[XB_TMO])) break; if (sp > XB_SPIN_CAP) { atomicAdd(&bar[XB_TMO], 1u); break; } }
    }
    nloc = mine > 0u ? mine : 1u; nx = cnt > 0u ? cnt : 1u;
}

__device__ __forceinline__ void xcd_barrier(const XcdBarrier& b) {
    asm volatile("s_waitcnt vmcnt(0)" ::: "memory");
    __syncthreads();
    if (threadIdx.x == 0) {
        unsigned* bar = b.bar;
        __builtin_amdgcn_s_waitcnt(0);
        unsigned nloc = b.st[0], nx = b.st[1];
        if (nloc == 0u) { xcd_barrier_complete(bar, b.x, nloc, nx); b.st[0] = nloc; b.st[1] = nx; }
        const unsigned old = xb_add(&bar[XB_XSUB(b.x)], 1u);
        const unsigned gen = old / nloc;
        if (old + 1u == (gen + 1u) * nloc) {
            __builtin_amdgcn_fence(__ATOMIC_RELEASE, "agent");
            asm volatile("s_waitcnt vmcnt(0)" ::: "memory");
            const unsigned og = xb_add(&bar[XB_TOP], 1u);
            const unsigned tg = og / nx;
            if (og + 1u == (tg + 1u) * nx) xb_add(&bar[XB_TOPGEN], 1u);
            else XB_SPIN(xb_ld(&bar[XB_TOPGEN]) == tg, bar);
            __builtin_amdgcn_fence(__ATOMIC_ACQUIRE, "agent");
            xb_add(&bar[XB_XGEN(b.x)], 1u);
            asm volatile("s_waitcnt vmcnt(0)" ::: "memory");
        } else {
            XB_SPIN(xb_ld(&bar[XB_XGEN(b.x)]) == gen, bar);
            __builtin_amdgcn_fence(__ATOMIC_ACQUIRE, "agent");
            asm volatile("s_waitcnt vmcnt(0)" ::: "memory");
        }
    }
    __syncthreads();
}

#ifndef REP_P0
#define REP_P0 1
#endif
#ifndef REP_SYNC
#define REP_SYNC 0
#endif
#ifndef H_BF16
#define H_BF16 1
#endif
#ifndef REP_M2
#define REP_M2 1
#endif
#ifndef REP_M1
#define REP_M1 1
#endif
#ifndef REP_XA
#define REP_XA 1
#endif
#ifndef REP_M3
#define REP_M3 1
#endif
#ifndef REP_G13
#define REP_G13 1
#endif
#ifndef MK_SKELETON
#define MK_SKELETON 0
#endif
template <class Epi> __device__ __forceinline__ void run_gemm(LAS unsigned char* lds, const bf16* A, const bf16* Bt, int Mr, int N, int K, int G, int c, const Epi& E, int wgm = 4) {
    pg8::Gemm g{A, Bt, Mr, N, K}; pg8::StaticOrder S; S.init(Mr, N, G, c, wgm);
    pg8::gemm_phase<Epi, pg8::StaticOrder, true, true>(lds, g, S, E);
}
template <bool HG> __device__ __forceinline__ void mixer_phases(const Args& a, const XcdBarrier& xbar, LAS unsigned char* lds, int l, int tid_, int lane_, int wave_) {
#define OPAQUE_TID() int tid = threadIdx.x; asm volatile("" : "+v"(tid)); const int lane = tid & 63, wave = __builtin_amdgcn_readfirstlane(tid >> 6);
    unsigned char* ws = a.ws; const int j = l >> 1, G = gridDim.x;
    MixP p; p.proj = (const bf16*)(ws + WS_PROJ); p.us = (bf16*)(ws + WS_US); p.vtg = (bf16*)(ws + WS_VTG); p.dec = (float*)(ws + WS_DEC); p.cat = (bf16*)(ws + WS_CAT);
    p.lb = a.hgrn_lb; p.wgk = a.gla_w_gk + (size_t)j * 16 * 768; p.bgk = a.gla_b_gk + j * 768; p.onorm = HG ? a.hgrn_onorm + j * 128 : a.gla_onorm + j * 384; p.j = j;
    const bool split = HG && G == 256;
#ifndef NO_M1
    if (split && blockIdx.x < 128) { pg8::EpiScaleBf16<true> E{(bf16*)(ws + WS_PROJ) + 6144, HG_IN, (const float*)(ws + WS_SSQ2) + (size_t)(2 * l) * M * 32};
        run_gemm(lds, (const bf16*)(ws + WS_HB), wt_in(ws, l) + (size_t)6144 * D, M, 512, D, 128, (int)blockIdx.x, E); }
    for (int rep = 0; rep < REP_M1; ++rep) { OPAQUE_TID(); M1Raw<HG> r;
        int it, step, end;
        if (split) { step = 1; if (blockIdx.x < 128) { it = blockIdx.x * 8; end = it + 8; } else { it = 1024 + (blockIdx.x - 128) * 16; end = it + 16; } }
        else { it = blockIdx.x; step = G; end = 256 * 12; }
        if (it < end) m1_load<HG>(p, it, tid, r);
        for (; it < end; it += step) m1_item<HG>(p, lds, it, it + step < end ? it + step : -1, r, tid, lane, wave);
        __syncthreads(); }
#endif
#ifndef NO_XA
    if (!split)
    for (int rep = 0; rep < REP_XA; ++rep) { OPAQUE_TID();
        if (G == 256) xa_phase<HG>(p.proj, (const bf16*)(ws + WS_MEMK), (const bf16*)(ws + WS_MEMVT), p.cat, l, lds, tid, lane, wave);
        else for (int wi = blockIdx.x * NWAVES + wave; wi < 4096; wi += G * NWAVES) xa_item<HG>(p.proj, (const bf16*)(ws + WS_MEMK), (const bf16*)(ws + WS_MEMVT), p.cat, l, wi, lane); }
#endif
    xcd_barrier(xbar);
#ifndef NO_M2
    { OPAQUE_TID(); m2_scan<HG>(p, blockIdx.x * NTHR + tid, G * NTHR); }
    if (split) { OPAQUE_TID(); xa_phase<HG>(p.proj, (const bf16*)(ws + WS_MEMK), (const bf16*)(ws + WS_MEMVT), p.cat, l, lds, tid, lane, wave); }
#if REP_M2 > 1
    { OPAQUE_TID(); MixP p2 = p; p2.us = (bf16*)(ws + WS_END); m2_scan<HG>(p2, blockIdx.x * NTHR + tid, G * NTHR); }
#endif
#endif
    xcd_barrier(xbar);
#ifndef NO_M3
    for (int rep = 0; rep < REP_M3; ++rep) { OPAQUE_TID(); constexpr int N3 = 256 * MC<HG>::NH; M3Raw<HG> r; int it = blockIdx.x; if (it < N3) m3_load<HG>(p, it, tid, r);
        for (; it < N3; it += G) m3_item<HG>(p, lds, it, it + G < N3 ? it + G : -1, r, tid, lane, wave);
        __syncthreads(); }
#endif
    xcd_barrier(xbar);
}

__global__ void __launch_bounds__(NTHR, 2) trunk_fwd(Args a) {
    extern __shared__ __attribute__((aligned(16))) unsigned char lds_raw[];
    LAS unsigned char* lds = (LAS unsigned char*)lds_raw;
    cg::grid_group grid = cg::this_grid();
    const int tid = threadIdx.x, lane = tid & 63, wave = __builtin_amdgcn_readfirstlane(tid >> 6), G = gridDim.x, bx = blockIdx.x;
    unsigned char* ws = a.ws;
    float* ssq = (float*)(ws + WS_SSQ2); float* H = (float*)(ws + WS_H); bf16* HB = (bf16*)(ws + WS_HB); bf16* CAT = (bf16*)(ws + WS_CAT); bf16* PROJ = (bf16*)(ws + WS_PROJ); bf16* ACT = PROJ;
#ifndef NO_P0
    for (int rep = 0; rep < REP_P0; ++rep) p0_prologue(a, lds, tid, lane, wave);
#endif
    { unsigned* bw = (unsigned*)(ws + WS_BAR); if (bx == 0) for (int i = tid; i < XCD_BAR_WORDS; i += NTHR) bw[i] = 0u; if (tid < 2) ((volatile LAS unsigned*)(lds + LDS_CTL))[tid] = 0u; }
    grid.sync();
    const XcdBarrier xbar = xcd_barrier_post((unsigned*)(ws + WS_BAR), (volatile LAS unsigned*)(lds + LDS_CTL));
#ifndef NO_PKV
    if (bx >= G - 32 && bx < G - 16) { pg8::EpiScaleBf16<false> E{(bf16*)(ws + WS_MEMK), 2048, nullptr}; run_gemm(lds, (const bf16*)(ws + WS_MEMN), (const bf16*)(ws + WS_WTK), MMEM, 2048, D, 16, bx - (G - 32), E); }
    else if (bx >= G - 16) { pg8::EpiScaleBf16<false> E{(bf16*)(ws + WS_MEMVT), 512, nullptr}; run_gemm(lds, (const bf16*)(ws + WS_WTV), (const bf16*)(ws + WS_MEMN), 2048, MMEM, D, 16, bx - (G - 16), E); }
#endif
#pragma unroll 1
    for (int l = 0; l < DEPTH; ++l) {
#ifndef NO_G1
        for (int rep = 0; rep < REP_G13; ++rep) { pg8::EpiScaleBf16<true> E{PROJ, n_in(l), ssq + (size_t)(2 * l) * M * 32}; run_gemm(lds, HB, wt_in(ws, l), M, (!(l & 1) && G == 256) ? 6144 : n_in(l), D, G, bx, E); }
#endif
        xcd_barrier(xbar);
        if (l & 1) mixer_phases<false>(a, xbar, lds, l, tid, lane, wave); else mixer_phases<true>(a, xbar, lds, l, tid, lane, wave);
#ifndef NO_G2
#if H_BF16
        { pg8::EpiResidBf E{HB, ssq + (size_t)(2 * l + 1) * M * 32}; run_gemm(lds, CAT, wt_out(ws, l), M, D, D, G, bx, E, WGM_G2); }
#else
        { pg8::EpiResid E{l == 0 ? a.x : H, H, HB, ssq + (size_t)(2 * l + 1) * M * 32}; run_gemm(lds, CAT, wt_out(ws, l), M, D, D, G, bx, E); }
#endif
#endif
        xcd_barrier(xbar);
        for (int rep = 0; rep < REP_SYNC; ++rep) xcd_barrier(xbar);
#ifndef NO_G3
        for (int rep = 0; rep < REP_G13; ++rep) { pg8::EpiSwiglu E{ACT, DFF, ssq + (size_t)(2 * l + 1) * M * 32}; run_gemm(lds, HB, wt_gu(ws, l), M, 2 * DFF, D, G, bx, E); }
#endif
        xcd_barrier(xbar);
#ifndef NO_G4
#if H_BF16
        { pg8::EpiResidBf E{HB, ssq + (size_t)(2 * l + 2) * M * 32}; run_gemm(lds, ACT, wt_down(ws, l), M, D, DFF, G, bx, E, WGM_G4); }
#else
        { pg8::EpiResid E{H, H, HB, ssq + (size_t)(2 * l + 2) * M * 32}; run_gemm(lds, ACT, wt_down(ws, l), M, D, DFF, G, bx, E); }
#endif
#endif
        xcd_barrier(xbar);
    }
    for (int m = bx * NWAVES + wave; m < M; m += G * NWAVES) {
        const float r = rsqrtf(wave_sum(lane < 32 ? ssq[((size_t)8 * M + m) * 32 + lane] : 0.f) * (1.0f / D) + EPS);
        const f32x4* hr = (const f32x4*)(H + (size_t)m * D) + lane; const u32x2* hb = (const u32x2*)(HB + (size_t)m * D) + lane; const f32x4* gr = (const f32x4*)a.norm_final + lane; f32x4* o = (f32x4*)(a.out + (size_t)m * D) + lane;
#pragma unroll
        for (int jj = 0; jj < 8; ++jj) { f32x4 v; if (H_BF16) { const u32x2 w = hb[64 * jj]; v = (f32x4){bflo(w.x), bfhi(w.x), bflo(w.y), bfhi(w.y)}; } else v = hr[64 * jj]; const f32x4 gg = gr[64 * jj]; o[64 * jj] = (f32x4){v.x * r * gg.x, v.y * r * gg.y, v.z * r * gg.z, v.w * r * gg.w}; }
    }
}

extern "C" void kernel_launch(void* const* d_in, const int* in_sizes, int n_in_, void* d_out, int out_size, void* d_ws, size_t ws_size, hipStream_t stream) {
    static int grid = 0;
    if (grid == 0) {
        if (n_in_ != 17 || in_sizes[0] != M * D || out_size != M * D || ws_size < WS_END) { fprintf(stderr, "kernel_launch: unexpected shapes (n_in %d, in0 %d, out %d, ws %zu < %zu)\n", n_in_, n_in_ > 0 ? in_sizes[0] : -1, out_size, ws_size, (size_t)WS_END); grid = -1; return; }
        int dev = 0, cus = 0, per_cu = 0;
        hipGetDevice(&dev); hipDeviceGetAttribute(&cus, hipDeviceAttributeMultiprocessorCount, dev);
        if (hipFuncSetAttribute((const void*)trunk_fwd, hipFuncAttributeMaxDynamicSharedMemorySize, LDS_BYTES) != hipSuccess) { fprintf(stderr, "kernel_launch: hipFuncSetAttribute failed\n"); grid = -1; return; }
        if (hipOccupancyMaxActiveBlocksPerMultiprocessor(&per_cu, (const void*)trunk_fwd, NTHR, LDS_BYTES) != hipSuccess || per_cu < 1) { fprintf(stderr, "kernel_launch: occupancy query says %d blocks per CU\n", per_cu); per_cu = 1; }
        (void)hipGetLastError();
        grid = cus;
    }
    if (grid < 0) return;
    Args a{};
    a.x = (const float*)d_in[0]; a.mem = (const float*)d_in[1]; a.norm_mix = (const float*)d_in[2]; a.norm_ffn = (const float*)d_in[3]; a.norm_mem = (const float*)d_in[4]; a.norm_final = (const float*)d_in[5];
    a.hgrn_w_in = (const float*)d_in[6]; a.hgrn_lb = (const float*)d_in[7]; a.hgrn_onorm = (const float*)d_in[8]; a.gla_w_in = (const float*)d_in[9]; a.gla_w_gk = (const float*)d_in[10]; a.gla_b_gk = (const float*)d_in[11];
    a.gla_onorm = (const float*)d_in[12]; a.w_mem_kv = (const float*)d_in[13]; a.w_out = (const float*)d_in[14]; a.w_gate_up = (const float*)d_in[15]; a.w_down = (const float*)d_in[16];
    a.out = (float*)d_out; a.ws = (unsigned char*)d_ws;
    void* args[] = {&a};
    hipError_t e = hipLaunchCooperativeKernel((const void*)trunk_fwd, dim3(grid), dim3(NTHR), args, LDS_BYTES, stream);
    if (e != hipSuccess) fprintf(stderr, "kernel_launch: cooperative launch failed: %s (grid %d)\n", hipGetErrorString(e), grid);
}
```

```cpp
#include <hip/hip_runtime.h>
#ifndef WGM_G4
#define WGM_G4 4
#endif
#ifndef WGM_G2
#define WGM_G2 4
#endif
#include <hip/hip_cooperative_groups.h>
#include <cstdio>
#include <cstdint>
namespace cg = cooperative_groups;
namespace pg8 {
#define PG8_LAS __attribute__((address_space(3)))
typedef unsigned short bf16_t;
typedef short bf16x8 __attribute__((ext_vector_type(8)));
typedef float f32x4 __attribute__((ext_vector_type(4)));
typedef unsigned u32x4 __attribute__((ext_vector_type(4)));
typedef unsigned u32x2 __attribute__((ext_vector_type(2)));
constexpr int BM = 256, BK = 64, HALF = 128, HTB = HALF * BK * 2  , STAGE_BYTES = 8 * HTB, NXCD = 8, WGM = 8;

__host__ __device__ __forceinline__ int lds_byte(int r, int c) { const int st = (r >> 4) * 2 + (c >> 5), rr = r & 15, cc = c & 31, ob = rr * 64 + cc * 2; return st * 1024 + (ob ^ (((ob >> 9) & 1) << 5)); }
__host__ __device__ __forceinline__ void stage_rc(int b, int& R, int& C) { const int st = b / 1024, sb = b % 1024, swz = sb ^ (((sb >> 9) & 1) << 5); R = (st >> 1) * 16 + swz / 64; C = (st & 1) * 32 + (swz % 64) / 2; }
__host__ __device__ __forceinline__ int perm32(int rho) { const int n = rho >> 4, i = rho & 15; return 8 * (i >> 2) + 4 * n + (i & 3); }

struct Unit { int pm, pn; };
struct Gemm { const bf16_t* A; const bf16_t* Bt; int M, N, K; };

struct StaticOrder {
    int nM, nN, nwg, G, c, wgm;
    __host__ __device__ void init(int M, int N, int G_, int c_, int wgm_ = 4) { nM = M / BM; nN = N / BM; nwg = nM * nN; G = G_; c = c_; wgm = wgm_; }
    __host__ __device__ bool next(int i, Unit& u) const {
        const long L = (long)i * G + c; if (L >= nwg) return false;
        int wgid = (int)L; { const int q = nwg / NXCD, r = nwg % NXCD, xcd = wgid % NXCD, off = wgid / NXCD; wgid = (xcd < r ? xcd * (q + 1) : r * (q + 1) + (xcd - r) * q) + off; }
        const int nig = wgm * nN, gid = wgid / nig, fm = gid * wgm, gsz = (nM - fm) < wgm ? (nM - fm) : wgm;
        u.pm = fm + ((wgid % nig) % gsz); u.pn = (wgid % nig) / gsz; return true;
    }
    __device__ __forceinline__ void a_ready(const Unit&) const {}
    __device__ __forceinline__ void done(const Unit&) const {}
};
__device__ __forceinline__ unsigned cvt_pk_bf16(float lo, float hi) { unsigned r; asm volatile("v_cvt_pk_bf16_f32 %0, %1, %2" : "=v"(r) : "v"(lo), "v"(hi)); return r; }
constexpr float RMS_EPS = 1e-6f;
__device__ __forceinline__ float row_rstd(const float* ssqp, int row, int fq) {
    const float* pr = ssqp + (size_t)row * 32 + 8 * fq; const f32x4 a = *(const f32x4*)pr, b = *(const f32x4*)(pr + 4);
    float s = ((a[0] + a[1]) + (a[2] + a[3])) + ((b[0] + b[1]) + (b[2] + b[3]));
    s += __shfl_xor(s, 16); s += __shfl_xor(s, 32);
    return rsqrtf(s * (1.0f / 2048.0f) + RMS_EPS);
}
__device__ __forceinline__ float fsilu(float g) { return g * __builtin_amdgcn_rcpf(1.0f + __builtin_amdgcn_exp2f(-1.44269504f * g)); }
template <bool SCALE> struct EpiScaleBf16 {
    static constexpr bool PERM = true, AFTER_DRAIN = false;
    bf16_t* O; int ldc; const float* ssq;
    __device__ __forceinline__ void operator()(const f32x4 (&acc)[2][2][4][2], const Unit& u, int wr, int wc, int fr, int fq) const {
        const int row0 = u.pm * BM + wr * 64 + fr, col0 = u.pn * BM + wc * 32 + 8 * fq;
#pragma unroll
        for (int ai = 0; ai < 2; ++ai)
#pragma unroll
            for (int m = 0; m < 4; ++m) {
                const int row = row0 + ai * HALF + m * 16;
                float r = 1.0f; if (SCALE) r = row_rstd(ssq, row, fq);
                bf16_t* rowp = O + (size_t)row * ldc + col0;
#pragma unroll
                for (int bj = 0; bj < 2; ++bj) { const f32x4 v0 = acc[ai][bj][m][0] * r, v1 = acc[ai][bj][m][1] * r;
                    u32x4 w; w.x = cvt_pk_bf16(v0[0], v0[1]); w.y = cvt_pk_bf16(v0[2], v0[3]); w.z = cvt_pk_bf16(v1[0], v1[1]); w.w = cvt_pk_bf16(v1[2], v1[3]);
                    *(u32x4*)(rowp + bj * HALF) = w; }
            }
    }
};
struct EpiSwiglu {
    static constexpr bool PERM = true, AFTER_DRAIN = false;
    bf16_t* O; int ldo; const float* ssq;
    __device__ __forceinline__ void operator()(const f32x4 (&acc)[2][2][4][2], const Unit& u, int wr, int wc, int fr, int fq) const {
        const int row0 = u.pm * BM + wr * 64 + fr, col0 = u.pn * HALF + wc * 32 + 8 * fq;
#pragma unroll
        for (int ai = 0; ai < 2; ++ai)
#pragma unroll
            for (int m = 0; m < 4; ++m) {
                const int row = row0 + ai * HALF + m * 16;
                const float r = row_rstd(ssq, row, fq);
                float y[8];
#pragma unroll
                for (int n = 0; n < 2; ++n)
#pragma unroll
                    for (int j = 0; j < 4; ++j) { const float g = acc[ai][0][m][n][j] * r, up = acc[ai][1][m][n][j] * r; y[n * 4 + j] = fsilu(g) * up; }
                u32x4 w; w.x = cvt_pk_bf16(y[0], y[1]); w.y = cvt_pk_bf16(y[2], y[3]); w.z = cvt_pk_bf16(y[4], y[5]); w.w = cvt_pk_bf16(y[6], y[7]);
                *(u32x4*)(O + (size_t)row * ldo + col0) = w;
            }
    }
};
struct EpiResid {
    static constexpr bool PERM = false, AFTER_DRAIN = false;
    const float* Hin; float* Hout; bf16_t* HB; float* ssq;
    __device__ __forceinline__ void operator()(const f32x4 (&acc)[2][2][4][2], const Unit& u, int wr, int wc, int fr, int fq) const {
        const int row0 = u.pm * BM + wr * 64 + fr, col0 = u.pn * BM + wc * 32 + 4 * fq;
#pragma unroll
        for (int ai = 0; ai < 2; ++ai)
#pragma unroll
            for (int m = 0; m < 4; ++m) {
                const int row = row0 + ai * HALF + m * 16; const size_t off = (size_t)row * 2048 + col0; float ss = 0.f;
#pragma unroll
                for (int bj = 0; bj < 2; ++bj)
#pragma unroll
                    for (int n = 0; n < 2; ++n) { const size_t o = off + bj * HALF + n * 16;
                        const f32x4 h = *(const f32x4*)(Hin + o) + acc[ai][bj][m][n];
                        *(f32x4*)(Hout + o) = h;
                        u32x2 w; w.x = cvt_pk_bf16(h[0], h[1]); w.y = cvt_pk_bf16(h[2], h[3]); *(u32x2*)(HB + o) = w;
                        ss += (h[0] * h[0] + h[1] * h[1]) + (h[2] * h[2] + h[3] * h[3]); }
                ss += __shfl_xor(ss, 16); ss += __shfl_xor(ss, 32);
                if (fq == 0) ssq[(size_t)row * 32 + u.pn * 4 + wc] = ss;
                if ((m & 3) == 3) asm volatile("" ::: "memory");
            }
    }
};
struct EpiResidBf {
    static constexpr bool PERM = true, AFTER_DRAIN = false;
    bf16_t* HB; float* ssq;
    __device__ __forceinline__ void operator()(const f32x4 (&acc)[2][2][4][2], const Unit& u, int wr, int wc, int fr, int fq) const {
        const int row0 = u.pm * BM + wr * 64 + fr, col0 = u.pn * BM + wc * 32 + 8 * fq;
#pragma unroll
        for (int ai = 0; ai < 2; ++ai)
#pragma unroll
            for (int m = 0; m < 4; ++m) {
                const int row = row0 + ai * HALF + m * 16; const size_t off = (size_t)row * 2048 + col0; float ss = 0.f;
#pragma unroll
                for (int bj = 0; bj < 2; ++bj) { const size_t o = off + bj * HALF;
                    const u32x4 hw = *(const u32x4*)(HB + o); u32x4 w;
#pragma unroll
                    for (int n = 0; n < 2; ++n) { const unsigned h01 = n ? hw.z : hw.x, h23 = n ? hw.w : hw.y;
                        const float h0 = __uint_as_float(h01 << 16) + acc[ai][bj][m][n][0], h1 = __uint_as_float(h01 & 0xffff0000u) + acc[ai][bj][m][n][1];
                        const float h2 = __uint_as_float(h23 << 16) + acc[ai][bj][m][n][2], h3 = __uint_as_float(h23 & 0xffff0000u) + acc[ai][bj][m][n][3];
                        const unsigned w01 = cvt_pk_bf16(h0, h1), w23 = cvt_pk_bf16(h2, h3);
                        if (n) { w.z = w01; w.w = w23; } else { w.x = w01; w.y = w23; }
                        const float r0 = __uint_as_float(w01 << 16), r1 = __uint_as_float(w01 & 0xffff0000u), r2 = __uint_as_float(w23 << 16), r3 = __uint_as_float(w23 & 0xffff0000u);
                        ss += (r0 * r0 + r1 * r1) + (r2 * r2 + r3 * r3); }
                    *(u32x4*)(HB + o) = w; }
                ss += __shfl_xor(ss, 16); ss += __shfl_xor(ss, 32);
                if (fq == 0) ssq[(size_t)row * 32 + u.pn * 4 + wc] = ss;
            }
    }
};
template <class Epi, class Sched, bool ALIGN_EPI = false, bool SP2 = false>
__device__ __forceinline__ void gemm_phase(PG8_LAS unsigned char* lds, const Gemm g, const Sched& S, const Epi& E) {
    int tid_raw = threadIdx.x; asm volatile("" : "+v"(tid_raw));
    const int tid = tid_raw, wid = __builtin_amdgcn_readfirstlane(tid >> 6), lane = tid & 63, wr = wid >> 2, wc = wid & 3, fr = lane & 15, fq = lane >> 4;
    const int K = g.K, nt = K / BK;
    unsigned voffA[2], voffB[2];
#pragma unroll
    for (int i = 0; i < 2; ++i) { int R, C; stage_rc(tid * 16 + i * 8192, R, C); const int Rb = Epi::PERM ? ((R & ~31) + perm32(R & 31)) : R;
        voffA[i] = (unsigned)(R * K + C) * 2u; voffB[i] = (unsigned)(Rb * K + C) * 2u; }
    const size_t kstep = (size_t)(BK * 2);
    const size_t hstep = (size_t)HALF * K * 2;
    const size_t tstep = 2 * hstep;
    const unsigned ldsw = (unsigned)wid * 1024u;
    const int aoff = lds_byte(wr * 64 + fr, fq * 8), boff = lds_byte(wc * 32 + fr, fq * 8);
#define PG8_SA(b, h) (((b) * 2 + (h)) * HTB)
#define PG8_SB(b, h) ((4 + (b) * 2 + (h)) * HTB)
#define PG8_STAGE(bufoff, gbase, voff) do { _Pragma("unroll") for (int _i = 0; _i < 2; ++_i) \
        __builtin_amdgcn_global_load_lds((const unsigned*)((const char*)(gbase) + (voff)[_i]), (PG8_LAS unsigned*)(lds + (bufoff) + ldsw + _i * 8192), 16, 0, 0); } while (0)
#define PG8_LDA(dst, b, h) do { _Pragma("unroll") for (int m = 0; m < 4; ++m) _Pragma("unroll") for (int k = 0; k < 2; ++k) dst[m][k] = *(const PG8_LAS bf16x8*)(lds + PG8_SA(b, h) + aoff + m * 2048 + k * 1024); } while (0)
#define PG8_LDB(dst, b, h) do { _Pragma("unroll") for (int n = 0; n < 2; ++n) _Pragma("unroll") for (int k = 0; k < 2; ++k) dst[n][k] = *(const PG8_LAS bf16x8*)(lds + PG8_SB(b, h) + boff + n * 2048 + k * 1024); } while (0)
#define PG8_MMA(ai, bj, At, Bt) do { __builtin_amdgcn_s_setprio(1); _Pragma("unroll") for (int m = 0; m < 4; ++m) _Pragma("unroll") for (int n = 0; n < 2; ++n) _Pragma("unroll") for (int k = 0; k < 2; ++k) \
        acc[ai][bj][m][n] = __builtin_amdgcn_mfma_f32_16x16x32_bf16(Bt[n][k], At[m][k], acc[ai][bj][m][n], 0, 0, 0); __builtin_amdgcn_s_setprio(0); } while (0)
#define PG8_WAIT_V(n) asm volatile("s_waitcnt vmcnt(" #n ")" ::: "memory")
#define PG8_WAIT_L(n) asm volatile("s_waitcnt lgkmcnt(" #n ")" ::: "memory")
#define PG8_BAR __builtin_amdgcn_s_barrier()
#define PG8_SCHED __builtin_amdgcn_sched_barrier(0)
    Unit cur, nxt; int ui = 0;
    if (!S.next(0, cur)) return;
    f32x4 acc[2][2][4][2];
#pragma unroll
    for (int a = 0; a < 2; ++a)
#pragma unroll
        for (int b = 0; b < 2; ++b)
#pragma unroll
            for (int m = 0; m < 4; ++m)
#pragma unroll
                for (int n = 0; n < 2; ++n) acc[a][b][m][n] = (f32x4){0.f, 0.f, 0.f, 0.f};
    bf16x8 At[4][2], B0[2][2], B1[2][2];
    const char* cA = (const char*)g.A + (size_t)cur.pm * tstep; const char* cB = (const char*)g.Bt + (size_t)cur.pn * tstep;
    S.a_ready(cur);
    if constexpr (SP2) {
        PG8_STAGE(PG8_SB(0, 0), cB, voffB); PG8_STAGE(PG8_SB(0, 1), cB + hstep, voffB); PG8_STAGE(PG8_SA(0, 0), cA, voffA); PG8_STAGE(PG8_SA(0, 1), cA + hstep, voffA);
        if (wr == 1) PG8_BAR;
        PG8_WAIT_V(2); PG8_BAR;
        PG8_STAGE(PG8_SB(1, 0), cB + kstep, voffB); PG8_STAGE(PG8_SA(1, 0), cA + kstep, voffA); PG8_STAGE(PG8_SB(1, 1), cB + hstep + kstep, voffB);
        PG8_WAIT_V(6); PG8_BAR;
    } else {
        PG8_STAGE(PG8_SB(0, 0), cB, voffB); PG8_STAGE(PG8_SA(0, 0), cA, voffA); PG8_STAGE(PG8_SB(0, 1), cB + hstep, voffB); PG8_STAGE(PG8_SA(0, 1), cA + hstep, voffA);
        if (wr == 1) PG8_BAR;
        PG8_WAIT_V(4); PG8_BAR;
        PG8_STAGE(PG8_SB(1, 0), cB + kstep, voffB); PG8_STAGE(PG8_SA(1, 0), cA + kstep, voffA); PG8_STAGE(PG8_SB(1, 1), cB + hstep + kstep, voffB);
        PG8_WAIT_V(6); PG8_BAR;
    }
    for (;;) {
        const bool has_next = S.next(ui + 1, nxt);
        const char* nA = has_next ? (const char*)g.A + (size_t)nxt.pm * tstep : cA; const char* nB = has_next ? (const char*)g.Bt + (size_t)nxt.pn * tstep : cB;
        for (int t = 0; t < nt; t += 2) {
            const bool last = (t == nt - 2);
            const char* a1 = cA + (size_t)(t + 1) * kstep;
            const char* a2 = last ? nA : cA + (size_t)(t + 2) * kstep; const char* b2 = last ? nB : cB + (size_t)(t + 2) * kstep;
            const char* a3 = a2 + kstep; const char* b3 = b2 + kstep;
            if (last && has_next) S.a_ready(nxt);
            if constexpr (SP2) {
            PG8_LDB(B0, 0, 0); PG8_LDB(B1, 0, 1); PG8_SCHED; PG8_LDA(At, 0, 0); PG8_STAGE(PG8_SA(1, 1), a1 + hstep, voffA);
            PG8_WAIT_V(8); PG8_WAIT_L(0); PG8_BAR; PG8_MMA(0, 0, At, B0); PG8_MMA(0, 1, At, B1); PG8_BAR; PG8_SCHED;
            PG8_LDA(At, 0, 1); PG8_STAGE(PG8_SB(0, 0), b2, voffB); PG8_STAGE(PG8_SB(0, 1), b2 + hstep, voffB); PG8_STAGE(PG8_SA(0, 0), a2, voffA);
            PG8_WAIT_V(8); PG8_WAIT_L(0); PG8_BAR; PG8_MMA(1, 0, At, B0); PG8_MMA(1, 1, At, B1); PG8_BAR; PG8_SCHED;
            PG8_LDB(B0, 1, 0); PG8_LDB(B1, 1, 1); PG8_SCHED; PG8_LDA(At, 1, 0); PG8_STAGE(PG8_SA(0, 1), a2 + hstep, voffA);
            PG8_WAIT_V(8); PG8_WAIT_L(0); PG8_BAR; PG8_MMA(0, 0, At, B0); PG8_MMA(0, 1, At, B1); PG8_BAR; PG8_SCHED;
            PG8_LDA(At, 1, 1); PG8_STAGE(PG8_SB(1, 0), b3, voffB); PG8_STAGE(PG8_SB(1, 1), b3 + hstep, voffB); PG8_STAGE(PG8_SA(1, 0), a3, voffA);
            PG8_WAIT_V(8); PG8_WAIT_L(0); PG8_BAR; PG8_MMA(1, 0, At, B0); PG8_MMA(1, 1, At, B1); PG8_BAR; PG8_SCHED;
            } else {
            PG8_LDB(B0, 0, 0); PG8_SCHED; PG8_LDA(At, 0, 0); PG8_STAGE(PG8_SA(1, 1), a1 + hstep, voffA);
            PG8_WAIT_L(8); PG8_BAR; PG8_WAIT_L(0); PG8_MMA(0, 0, At, B0); PG8_BAR; PG8_SCHED;
            PG8_LDB(B1, 0, 1); PG8_STAGE(PG8_SB(0, 0), b2, voffB);
            PG8_BAR; PG8_WAIT_L(0); PG8_MMA(0, 1, At, B1); PG8_BAR;
            PG8_LDA(At, 0, 1); PG8_STAGE(PG8_SA(0, 0), a2, voffA);
            PG8_BAR; PG8_WAIT_L(0); PG8_MMA(1, 0, At, B0); PG8_BAR; PG8_SCHED;
            PG8_STAGE(PG8_SB(0, 1), b2 + hstep, voffB);
            PG8_WAIT_V(6); PG8_BAR; PG8_MMA(1, 1, At, B1); PG8_BAR;
            PG8_LDB(B0, 1, 0); PG8_SCHED; PG8_LDA(At, 1, 0); PG8_STAGE(PG8_SA(0, 1), a2 + hstep, voffA);
            PG8_WAIT_L(8); PG8_BAR; PG8_WAIT_L(0); PG8_MMA(0, 0, At, B0); PG8_BAR; PG8_SCHED;
            PG8_LDB(B1, 1, 1); PG8_STAGE(PG8_SB(1, 0), b3, voffB);
            PG8_BAR; PG8_WAIT_L(0); PG8_MMA(0, 1, At, B1); PG8_BAR;
            PG8_LDA(At, 1, 1); PG8_STAGE(PG8_SA(1, 0), a3, voffA);
            PG8_BAR; PG8_WAIT_L(0); PG8_MMA(1, 0, At, B0); PG8_BAR; PG8_SCHED;
            PG8_STAGE(PG8_SB(1, 1), b3 + hstep, voffB);
            PG8_WAIT_V(6); PG8_BAR; PG8_MMA(1, 1, At, B1); PG8_BAR;
            }
        }
        if constexpr (ALIGN_EPI) { if (wr == 0) PG8_BAR; }
        if constexpr (!Epi::AFTER_DRAIN) { E(acc, cur, wr, wc, fr, fq); S.done(cur); }
        if (!has_next) break;
#pragma unroll
        for (int a = 0; a < 2; ++a)
#pragma unroll
            for (int b = 0; b < 2; ++b)
#pragma unroll
                for (int m = 0; m < 4; ++m)
#pragma unroll
                    for (int n = 0; n < 2; ++n) acc[a][b][m][n] = (f32x4){0.f, 0.f, 0.f, 0.f};
        cur = nxt; cA = nA; cB = nB; ++ui;
        if constexpr (ALIGN_EPI) { if (wr == 1) PG8_BAR; }
    }
    PG8_WAIT_V(0);
    if constexpr (!ALIGN_EPI) { if (wr == 0) PG8_BAR; }
    PG8_BAR;
    if constexpr (Epi::AFTER_DRAIN) { E.fused(acc, cur, wr, wc, fr, fq, lds, wid, lane); S.done(cur); }
#undef PG8_SA
#undef PG8_SB
#undef PG8_STAGE
#undef PG8_LDA
#undef PG8_LDB
#undef PG8_MMA
#undef PG8_WAIT_V
#undef PG8_WAIT_L
#undef PG8_BAR
#undef PG8_SCHED
}
}

#define LAS __attribute__((address_space(3)))
typedef unsigned short bf16;
typedef short bf16x8 __attribute__((ext_vector_type(8)));
typedef float f32x4 __attribute__((ext_vector_type(4)));
typedef unsigned u32x4 __attribute__((ext_vector_type(4)));
typedef unsigned u32x2 __attribute__((ext_vector_type(2)));
constexpr int NWAVES = 8, NTHR = 512;
constexpr int D = 2048, M = 16384, DEPTH = 4, NMEM = 256, MMEM = 512;
constexpr int MIXW = 1536, XAW = 512, DFF = 5632;
constexpr int HG_IN = 6656, GL_IN_SRC = 5136, GL_IN = 5888;
constexpr float EPS = 1e-6f;
constexpr size_t MiB = 1u << 20;
constexpr size_t WS_WT = 0;
constexpr size_t WT_LAYER = 100 * MiB;
constexpr size_t WS_WTK = 400 * MiB, WS_WTV = 408 * MiB, WS_MEMN = 416 * MiB, WS_MEMK = 418 * MiB, WS_MEMVT = 420 * MiB;
constexpr size_t WS_BAR = 422 * MiB, WS_DEC = 423 * MiB, WS_H = 426 * MiB, WS_HB = 554 * MiB, WS_CAT = 618 * MiB, WS_PROJ = 682 * MiB, WS_US = 890 * MiB, WS_SSQ2 = 1034 * MiB, WS_VTG = 1054 * MiB, WS_END = 1102 * MiB;
constexpr int LDS_BYTES = 144 * 1024, LDS_CTL = 143 * 1024;

struct Args {
    const float *x, *mem, *norm_mix, *norm_ffn, *norm_mem, *norm_final, *hgrn_w_in, *hgrn_lb, *hgrn_onorm, *gla_w_in, *gla_w_gk, *gla_b_gk, *gla_onorm, *w_mem_kv, *w_out, *w_gate_up, *w_down;
    float* out; unsigned char* ws;
};

__device__ __forceinline__ float bf2f(unsigned b) { return __uint_as_float(b << 16); }
__device__ __forceinline__ float bflo(unsigned w) { return __uint_as_float(w << 16); }
__device__ __forceinline__ float bfhi(unsigned w) { return __uint_as_float(w & 0xffff0000u); }
__device__ __forceinline__ unsigned pk2(float lo, float hi) { return pg8::cvt_pk_bf16(lo, hi); }
__device__ __forceinline__ float fexp(float x) { return __builtin_amdgcn_exp2f(1.44269504f * x); }
__device__ __forceinline__ float flog(float x) { return 0.69314718f * __builtin_amdgcn_logf(x); }
__device__ __forceinline__ float fsigm(float x) { return __builtin_amdgcn_rcpf(1.0f + fexp(-x)); }
__device__ __forceinline__ float wave_sum(float v) {
#pragma unroll
    for (int o = 1; o < 64; o <<= 1) v += __shfl_xor(v, o);
    return v;
}
#define LDS_WAIT() asm volatile("s_waitcnt lgkmcnt(0)" ::: "memory")

__device__ __forceinline__ int map_col(int mt, int nd) {
    if (mt == 0) return nd;
    if (mt == 1) return nd < 4608 ? nd : (nd < 5120 ? nd + 16 : -1);
    const int pn = nd >> 8, bj = (nd >> 7) & 1, c = nd & 127; return bj * DFF + 128 * pn + c;
}
__device__ __forceinline__ void conv_item(const float* W, int Nsrc, int K, bf16* WT, const float* gain, int mt, const float* wgk, int item, int nblk, LAS float* scr, int lane) {
    const int kb = item / nblk, nb = item % nblk, k0 = 64 * kb, n0 = 32 * nb;
    const int sc = map_col(mt, n0 + (lane & 31));
    float v[32];
    if (mt == 1 && n0 >= 5120) {
        float wz[16];
#pragma unroll
        for (int r = 0; r < 16; ++r) wz[r] = wgk[r * 768 + (n0 - 5120) + (lane & 31)];
#pragma unroll 4
        for (int i = 0; i < 32; ++i) { const int kk = 2 * i + (lane >> 5); const f32x4* wr = (const f32x4*)(W + (size_t)(k0 + kk) * Nsrc + 4608); float z = 0.f;
#pragma unroll
            for (int q = 0; q < 4; ++q) { const f32x4 w4 = wr[q]; z += w4[0] * wz[4 * q] + w4[1] * wz[4 * q + 1] + w4[2] * wz[4 * q + 2] + w4[3] * wz[4 * q + 3]; }
            v[i] = z; }
    } else {
#pragma unroll
        for (int i = 0; i < 32; ++i) { const int kk = 2 * i + (lane >> 5); v[i] = sc >= 0 ? W[(size_t)(k0 + kk) * Nsrc + sc] : 0.f; }
    }
    if (gain) {
#pragma unroll
        for (int i = 0; i < 32; ++i) v[i] *= gain[k0 + 2 * i + (lane >> 5)];
    }
#pragma unroll
    for (int i = 0; i < 32; ++i) scr[(2 * i + (lane >> 5)) * 33 + (lane & 31)] = v[i];
    LDS_WAIT(); asm volatile("" ::: "memory");
    const int c = lane & 7;
#pragma unroll
    for (int j = 0; j < 4; ++j) { const int n = (lane >> 3) + 8 * j; const LAS float* s = scr + (8 * c) * 33 + n;
        u32x4 o; o.x = pk2(s[0 * 33], s[1 * 33]); o.y = pk2(s[2 * 33], s[3 * 33]); o.z = pk2(s[4 * 33], s[5 * 33]); o.w = pk2(s[6 * 33], s[7 * 33]);
        *(u32x4*)(WT + (size_t)(n0 + n) * K + k0 + 8 * c) = o; }
    LDS_WAIT(); asm volatile("" ::: "memory");
}
__device__ __forceinline__ void conv_matrix(const float* W, int Nsrc, int K, int Ndst, bf16* WT, const float* gain, int mt, LAS float* scr, int lane, int& gw, int NGW, const float* wgk = nullptr) {
    const int nblk = Ndst / 32, nitems = (K / 64) * nblk;
    for (int it = gw; it < nitems; it += NGW) conv_item(W, Nsrc, K, WT, gain, mt, wgk, it, nblk, scr, lane);
    gw -= nitems % NGW; if (gw < 0) gw += NGW;
}
__device__ __forceinline__ bf16* wt_in(unsigned char* ws, int l) { return (bf16*)(ws + WS_WT + (size_t)l * WT_LAYER); }
__device__ __forceinline__ int n_in(int l) { return (l & 1) ? GL_IN : HG_IN; }
__device__ __forceinline__ bf16* wt_out(unsigned char* ws, int l) { return wt_in(ws, l) + (size_t)n_in(l) * D; }
__device__ __forceinline__ bf16* wt_gu(unsigned char* ws, int l) { return wt_out(ws, l) + (size_t)D * D; }
__device__ __forceinline__ bf16* wt_down(unsigned char* ws, int l) { return wt_gu(ws, l) + (size_t)2 * DFF * D; }

__device__ __forceinline__ void p0_prologue(const Args& a, LAS unsigned char* lds, int tid, int lane, int wave) {
    LAS float* scr = (LAS float*)(lds + wave * 8704);
    const int G = gridDim.x, gw0 = blockIdx.x * NWAVES + wave, NGW = G * NWAVES; int gw = gw0;
    unsigned char* ws = a.ws;
    for (int m = gw0; m < MMEM; m += NGW) {
        const f32x4* xr = (const f32x4*)(a.mem + (size_t)m * D) + lane; const f32x4* gr = (const f32x4*)a.norm_mem + lane; u32x2* o = (u32x2*)((bf16*)(ws + WS_MEMN) + (size_t)m * D) + lane;
        f32x4 v[8]; float s = 0.f;
#pragma unroll
        for (int j = 0; j < 8; ++j) { v[j] = xr[64 * j]; s += (v[j].x * v[j].x + v[j].y * v[j].y) + (v[j].z * v[j].z + v[j].w * v[j].w); }
        const float r = rsqrtf(wave_sum(s) * (1.0f / D) + EPS);
#pragma unroll
        for (int j = 0; j < 8; ++j) { const f32x4 g = gr[64 * j]; u32x2 w; w.x = pk2(v[j].x * r * g.x, v[j].y * r * g.y); w.y = pk2(v[j].z * r * g.z, v[j].w * r * g.w); o[64 * j] = w; }
    }
    for (int l = DEPTH - 1; l >= 0; --l) {
        const int j = l >> 1;
        if (l & 1) conv_matrix(a.gla_w_in + (size_t)j * D * GL_IN_SRC, GL_IN_SRC, D, GL_IN, wt_in(ws, l), a.norm_mix + l * D, 1, scr, lane, gw, NGW, a.gla_w_gk + (size_t)j * 16 * 768);
        else       conv_matrix(a.hgrn_w_in + (size_t)j * D * HG_IN, HG_IN, D, HG_IN, wt_in(ws, l), a.norm_mix + l * D, 0, scr, lane, gw, NGW);
        conv_matrix(a.w_out + (size_t)l * D * D, D, D, D, wt_out(ws, l), nullptr, 0, scr, lane, gw, NGW);
        conv_matrix(a.w_gate_up + (size_t)l * D * 2 * DFF, 2 * DFF, D, 2 * DFF, wt_gu(ws, l), a.norm_ffn + l * D, 2, scr, lane, gw, NGW);
        conv_matrix(a.w_down + (size_t)l * DFF * D, D, DFF, D, wt_down(ws, l), nullptr, 0, scr, lane, gw, NGW);
        conv_matrix(a.w_mem_kv + (size_t)l * D * 2 * XAW, 2 * XAW, D, XAW, (bf16*)(ws + WS_WTK) + (size_t)l * XAW * D, nullptr, 0, scr, lane, gw, NGW);
        conv_matrix(a.w_mem_kv + (size_t)l * D * 2 * XAW + XAW, 2 * XAW, D, XAW, (bf16*)(ws + WS_WTV) + (size_t)l * XAW * D, nullptr, 0, scr, lane, gw, NGW);
    }
    for (int m = gw0; m < M; m += NGW) {
        const f32x4* xr = (const f32x4*)(a.x + (size_t)m * D) + lane; u32x2* hb = (u32x2*)((bf16*)(ws + WS_HB) + (size_t)m * D) + lane;
        f32x4 v[8]; float s = 0.f;
#pragma unroll
        for (int j = 0; j < 8; ++j) v[j] = xr[64 * j];
#pragma unroll
        for (int j = 0; j < 8; ++j) { s += (v[j].x * v[j].x + v[j].y * v[j].y) + (v[j].z * v[j].z + v[j].w * v[j].w); u32x2 w; w.x = pk2(v[j].x, v[j].y); w.y = pk2(v[j].z, v[j].w); hb[64 * j] = w; }
        s = wave_sum(s); if (lane < 32) ((float*)(ws + WS_SSQ2))[(size_t)m * 32 + lane] = lane == 0 ? s : 0.f;
    }
}
template <bool HG> struct MC {
    static constexpr int DK = HG ? 128 : 192, DV = HG ? 128 : 384, NH = HG ? 12 : 4, NS = DV / 128, LD = HG ? HG_IN : GL_IN;
    static constexpr int QOFF = 0, KOFF = HG ? 1536 : 768, VOFF = HG ? 3072 : 1536, GOFF = HG ? 4608 : 3072, XQOFF = HG ? 6144 : 4608, ZOFF = 5120;
    static constexpr int RS = DK * 2 + 16;
    static constexpr int TS = 144;
};
struct MixP { const bf16* proj; bf16* vtg; bf16* us; float* dec; bf16* cat; const float* lb; const float* wgk; const float* bgk; const float* onorm; int j; };

__device__ __forceinline__ float hgrn_lb(const MixP& p, int col) {
    if (p.j == 0) return 0.f;
    return fsigm(p.lb[MIXW + col] - p.lb[col]);
}
__device__ __forceinline__ float gla_la(const LAS float* g, const float (&w)[16], float bb) {
    float z = bb;
#pragma unroll
    for (int r = 0; r < 16; ++r) z += g[r] * w[r];
    return (fminf(z, 0.f) - flog(1.0f + fexp(-fabsf(z)))) * (1.0f / 16.0f);
}
__device__ __forceinline__ float gla_lz(float z) { return flog(1.0f + fexp(-fmaxf(z, -60.f))) * (-1.0f / 16.0f); }
__device__ __forceinline__ void hg_gate(float x, float lb, float omlb, bool haslb, float& la, float& k) {
    const float e = fexp(-fmaxf(x, -60.f)), s1 = 1.0f + e; la = -flog(s1); if (haslb) la += flog(1.0f + lb * e); k = omlb * e * __builtin_amdgcn_rcpf(s1);
}
template <bool HG> __device__ __forceinline__ void load_gkl(const MixP& p, LAS float* gkl, int row0, int tid) {
    if (!HG) { const int idx = tid * 2, t = idx >> 4, r = idx & 15; const unsigned w = *(const unsigned*)(p.proj + (size_t)(row0 + t) * MC<HG>::LD + MC<HG>::GKOFF + r); gkl[idx] = bflo(w); gkl[idx + 1] = bfhi(w); }
}


template <bool HG> __device__ __forceinline__ void gate8(const LAS bf16* src, int stride, float bb, float lb, float omlb, bool haslb, float (&la)[8], float (&k)[8]) {
    float x[8], e[8], s1[8], l1[8];
#pragma unroll
    for (int j = 0; j < 8; ++j) x[j] = bf2f(src[j * stride]);
#pragma unroll
    for (int j = 0; j < 8; ++j) x[j] = -1.44269504f * fmaxf(x[j] + bb, -60.f);
#pragma unroll
    for (int j = 0; j < 8; ++j) e[j] = __builtin_amdgcn_exp2f(x[j]);
#pragma unroll
    for (int j = 0; j < 8; ++j) s1[j] = 1.0f + e[j];
#pragma unroll
    for (int j = 0; j < 8; ++j) l1[j] = __builtin_amdgcn_logf(s1[j]);
    if (HG) {
        float r[8], l2[8];
#pragma unroll
        for (int j = 0; j < 8; ++j) r[j] = __builtin_amdgcn_rcpf(s1[j]);
        if (haslb) {
#pragma unroll
            for (int j = 0; j < 8; ++j) l2[j] = __builtin_amdgcn_logf(1.0f + lb * e[j]);
        } else {
#pragma unroll
            for (int j = 0; j < 8; ++j) l2[j] = 0.f;
        }
#pragma unroll
        for (int j = 0; j < 8; ++j) { la[j] = 0.69314718f * (l2[j] - l1[j]); k[j] = omlb * e[j] * r[j]; }
    } else {
#pragma unroll
        for (int j = 0; j < 8; ++j) { la[j] = (-0.69314718f / 16.0f) * l1[j]; k[j] = 0.f; }
    }
}
template <bool HG> struct MixPar { float w[2]; };
template <bool HG> __device__ __forceinline__ void par_load(const MixP& p, int h, int tid, MixPar<HG>& q) {
    if (HG) { const int col = h * 128 + (tid & 127); q.w[0] = p.lb[col]; q.w[1] = p.lb[MIXW + col]; }
    else { q.w[0] = p.bgk[h * 192 + (tid % 192)]; q.w[1] = 0.f; }
}
template <bool HG> struct M1Raw { u32x4 k[HG ? 2 : 3]; u32x4 z[HG ? 1 : 3]; u32x4 v[2]; MixPar<HG> par; };
template <bool HG> __device__ __forceinline__ void m1_load(const MixP& p, int item, int tid, M1Raw<HG>& r) {
    typedef MC<HG> C; constexpr int DK = C::DK, LD = C::LD, CK = DK / 8;
    const int c = item / 12, hs = item % 12, h = hs / C::NS, s = hs % C::NS, row0 = c * 64;
    par_load<HG>(p, h, tid, r.par);
#pragma unroll
    for (int i = 0; i < (HG ? 2 : 3); ++i) { const int ci = tid + NTHR * i, row = ci / CK, cj = ci % CK; r.k[i] = *(const u32x4*)(p.proj + (size_t)(row0 + row) * LD + C::KOFF + h * DK + cj * 8);
        if (!HG) r.z[i] = *(const u32x4*)(p.proj + (size_t)(row0 + row) * LD + C::ZOFF + h * DK + cj * 8); }
#pragma unroll
    for (int i = 0; i < 2; ++i) { const int ci = tid + NTHR * i, row = ci >> 4, cj = ci & 15; r.v[i] = *(const u32x4*)(p.proj + (size_t)(row0 + row) * LD + C::VOFF + h * C::DV + s * 128 + cj * 8); }
}
__device__ __forceinline__ void gkl_store(LAS float* gkl, int tid, const u32x4& g) {
    if (tid < 128) { LAS f32x4* o = (LAS f32x4*)(gkl + (tid >> 1) * 16 + (tid & 1) * 8);
        o[0] = (f32x4){bflo(g.x), bfhi(g.x), bflo(g.y), bfhi(g.y)}; o[1] = (f32x4){bflo(g.z), bfhi(g.z), bflo(g.w), bfhi(g.w)}; }
}
template <bool HG> __device__ __forceinline__ void m1_item(const MixP& p, LAS unsigned char* lds, int item, int nxt, M1Raw<HG>& r, int tid, int lane, int wave) {
    typedef MC<HG> C; constexpr int DK = C::DK, TS = C::TS, CK = DK / 8, RKS = DK * 2 + 16, RVS = 272, NSEG = HG ? 4 : 2, NT = 64 / NSEG;
    const int c = item / 12, hs = item % 12, h = hs / C::NS, s = hs % C::NS;
    constexpr int KDT_OFF = 0, VT_OFF = DK * TS, RAWK_OFF = VT_OFF + 128 * TS, RAWV_OFF = RAWK_OFF + 64 * RKS, RAWZ_OFF = RAWV_OFF + 64 * RVS, TOT_OFF = RAWZ_OFF + (HG ? 0 : 64 * RKS);
    static_assert(TOT_OFF + 4 * 4 * DK <= 140 * 1024 && 128 * RKS <= RAWZ_OFF - RAWK_OFF + (HG ? 0 : 64 * RKS), "M1 LDS");
    LAS unsigned char* KDT = lds + KDT_OFF; LAS unsigned char* VT = lds + VT_OFF; LAS float* tot = (LAS float*)(lds + TOT_OFF);
#pragma unroll
    for (int i = 0; i < (HG ? 2 : 3); ++i) { const int ci = tid + NTHR * i, row = ci / CK, cj = ci % CK; *(LAS u32x4*)(lds + RAWK_OFF + row * RKS + cj * 16) = r.k[i]; if (!HG) *(LAS u32x4*)(lds + RAWZ_OFF + row * RKS + cj * 16) = r.z[i]; }
#pragma unroll
    for (int i = 0; i < 2; ++i) { const int ci = tid + NTHR * i, row = ci >> 4, cj = ci & 15; *(LAS u32x4*)(lds + RAWV_OFF + row * RVS + cj * 16) = r.v[i]; }
    float lb = 0.f, omlb = 1.f, bb = 0.f;
    if (HG) { lb = p.j == 0 ? 0.f : fsigm(r.par.w[1] - r.par.w[0]); omlb = 1.0f - lb; } else bb = r.par.w[0];
    __syncthreads();
    if (nxt >= 0) m1_load<HG>(p, nxt, tid, r);
    const int d = HG ? (tid & 127) : (tid % 192), seg = HG ? (tid >> 7) : (tid / 192), t0 = seg * NT;
    const bool act = seg < NSEG;
    const LAS bf16* rk = (const LAS bf16*)(lds + RAWK_OFF) + d; const LAS bf16* rz = (const LAS bf16*)(lds + RAWZ_OFF) + d;
    float la_[NT / 8][8], k_[NT / 8][8]; const bool haslb = p.j != 0;
    if (act) { float tsum = 0.f;
#pragma unroll
        for (int i8 = 0; i8 < NT / 8; ++i8) { gate8<HG>((HG ? rk : rz) + (t0 + i8 * 8) * (RKS / 2), RKS / 2, bb, lb, omlb, haslb, la_[i8], k_[i8]);
#pragma unroll
            for (int j = 0; j < 8; ++j) tsum += la_[i8][j]; }
        tot[seg * DK + d] = tsum; }
    __syncthreads();
    if (act) { float rc = 0.f;
#pragma unroll
        for (int q = 0; q < NSEG; ++q) if (q > seg) rc += tot[q * DK + d];
#pragma unroll
        for (int i8 = NT / 8 - 1; i8 >= 0; --i8) { float kd[8], rcv[8], kk[8];
#pragma unroll
            for (int j = 0; j < 8; ++j) kk[j] = HG ? k_[i8][j] : bf2f(rk[(t0 + i8 * 8 + j) * (RKS / 2)]);
#pragma unroll
            for (int j = 7; j >= 0; --j) { rcv[j] = 1.44269504f * rc; rc += la_[i8][j]; }
#pragma unroll
            for (int j = 0; j < 8; ++j) rcv[j] = __builtin_amdgcn_exp2f(rcv[j]);
#pragma unroll
            for (int j = 0; j < 8; ++j) kd[j] = kk[j] * rcv[j];
            u32x4 w; w.x = pk2(kd[0], kd[1]); w.y = pk2(kd[2], kd[3]); w.z = pk2(kd[4], kd[5]); w.w = pk2(kd[6], kd[7]);
            *(LAS u32x4*)(KDT + d * TS + (t0 + i8 * 8) * 2) = w; }
        if (seg == 0 && s == 0) p.dec[((size_t)c * C::NH + h) * DK + d] = fexp(rc); }
    {
        const int e = tid & 127, tv = (tid >> 7) * 16; const LAS bf16* rv = (const LAS bf16*)(lds + RAWV_OFF) + e; unsigned xs[16];
#pragma unroll
        for (int i = 0; i < 16; ++i) xs[i] = rv[(tv + i) * (RVS / 2)];
#pragma unroll
        for (int q = 0; q < 2; ++q) { u32x4 w; w.x = xs[q * 8] | (xs[q * 8 + 1] << 16); w.y = xs[q * 8 + 2] | (xs[q * 8 + 3] << 16); w.z = xs[q * 8 + 4] | (xs[q * 8 + 5] << 16); w.w = xs[q * 8 + 6] | (xs[q * 8 + 7] << 16);
            *(LAS u32x4*)(VT + e * TS + (tv + q * 8) * 2) = w; }
    }
    __syncthreads();
    {
        const int fr = lane & 15, g = lane >> 4, eb = wave;
        f32x4 acc[DK / 16];
#pragma unroll
        for (int db = 0; db < DK / 16; ++db) acc[db] = (f32x4){0.f, 0.f, 0.f, 0.f};
#pragma unroll
        for (int ks = 0; ks < 2; ++ks) {
            const bf16x8 bfr = *(const LAS bf16x8*)(VT + (16 * eb + fr) * TS + ks * 64 + g * 16);
#pragma unroll
            for (int db = 0; db < DK / 16; ++db) { const bf16x8 afr = *(const LAS bf16x8*)(KDT + (16 * db + fr) * TS + ks * 64 + g * 16);
                acc[db] = __builtin_amdgcn_mfma_f32_16x16x32_bf16(afr, bfr, acc[db], 0, 0, 0); }
        }
        LAS unsigned char* ut = lds + RAWK_OFF + (16 * eb + fr) * RKS + 8 * g;
#pragma unroll
        for (int db = 0; db < DK / 16; ++db) { u32x2 w; w.x = pk2(acc[db][0], acc[db][1]); w.y = pk2(acc[db][2], acc[db][3]); *(LAS u32x2*)(ut + 32 * db) = w; }
        bf16* vt = p.vtg + ((size_t)c * 12 + hs) * 128 * 64;
#pragma unroll
        for (int i = 0; i < 2; ++i) { const int ci = tid + NTHR * i, e = ci >> 3, part = ci & 7; *(u32x4*)(vt + e * 64 + part * 8) = *(const LAS u32x4*)(VT + e * TS + part * 16); }
    }
    __syncthreads();
    { bf16* ug = p.us + ((size_t)c * 12 + hs) * 128 * DK;
#pragma unroll
        for (int i = 0; i < DK / 32; ++i) { const int ci = tid + NTHR * i, e = ci / CK, cj = ci % CK; *(u32x4*)(ug + (size_t)e * DK + cj * 8) = *(const LAS u32x4*)(lds + RAWK_OFF + e * RKS + cj * 16); } }
    __syncthreads();
}

template <bool HG> __device__ __forceinline__ void m2_scan(const MixP& p, int gtid, int gthreads) {
    typedef MC<HG> C; constexpr int DK = C::DK, D8 = DK / 8, NIT = 2 * 12 * 128 * D8;
    const int nblk = gthreads / NTHR, per = ((NIT + nblk - 1) / nblk + 63) & ~63, bidx = gtid / NTHR, lt = gtid % NTHR;
    for (int it = bidx * per + lt; lt < per && it < NIT; it += NIT) {
        const int d8 = it % D8, e = (it / D8) % 128, hs = (it / (D8 * 128)) % 12, b = it / (D8 * 128 * 12), h = hs / C::NS;
        bf16* up = p.us + (((size_t)(b * 128) * 12 + hs) * 128 + e) * DK + d8 * 8; const size_t ustr = (size_t)12 * 128 * DK;
        const float* dp = p.dec + ((size_t)(b * 128) * C::NH + h) * DK + d8 * 8; const size_t dstr = (size_t)C::NH * DK;
        float S[8];
#pragma unroll
        for (int i = 0; i < 8; ++i) S[i] = 0.f;
        for (int n0 = 0; n0 < 128; n0 += 8) {
            u32x4 u[8]; f32x4 d0[8], d1[8];
#pragma unroll
            for (int k = 0; k < 8; ++k) { u[k] = *(const u32x4*)(up + (size_t)(n0 + k) * ustr); d0[k] = *(const f32x4*)(dp + (size_t)(n0 + k) * dstr); d1[k] = *(const f32x4*)(dp + (size_t)(n0 + k) * dstr + 4); }
#pragma unroll
            for (int k = 0; k < 8; ++k) {
                u32x4 w; w.x = pk2(S[0], S[1]); w.y = pk2(S[2], S[3]); w.z = pk2(S[4], S[5]); w.w = pk2(S[6], S[7]);
                *(u32x4*)(up + (size_t)(n0 + k) * ustr) = w;
                S[0] = d0[k].x * S[0] + bflo(u[k].x); S[1] = d0[k].y * S[1] + bfhi(u[k].x); S[2] = d0[k].z * S[2] + bflo(u[k].y); S[3] = d0[k].w * S[3] + bfhi(u[k].y);
                S[4] = d1[k].x * S[4] + bflo(u[k].z); S[5] = d1[k].y * S[5] + bfhi(u[k].z); S[6] = d1[k].z * S[6] + bflo(u[k].w); S[7] = d1[k].w * S[7] + bfhi(u[k].w);
            }
        }
    }
}

template <bool HG> struct M3Raw { u32x4 q[HG ? 2 : 3]; u32x4 k[HG ? 2 : 3]; u32x4 z[HG ? 1 : 3]; MixPar<HG> par; };
template <bool HG> __device__ __forceinline__ void m3_load(const MixP& p, int item, int tid, M3Raw<HG>& r) {
    typedef MC<HG> C; constexpr int DK = C::DK, LD = C::LD, CK = DK / 8;
    const int c = item / C::NH, h = item % C::NH, row0 = c * 64;
    par_load<HG>(p, h, tid, r.par);
#pragma unroll
    for (int i = 0; i < (HG ? 2 : 3); ++i) { const int ci = tid + NTHR * i, row = ci / CK, cj = ci % CK; const bf16* b = p.proj + (size_t)(row0 + row) * LD + h * DK + cj * 8;
        r.q[i] = *(const u32x4*)(b + C::QOFF); r.k[i] = *(const u32x4*)(b + C::KOFF); if (!HG) r.z[i] = *(const u32x4*)(b + C::ZOFF); }
}
template <bool HG> __device__ __forceinline__ void m3_item(const MixP& p, LAS unsigned char* lds, int item, int nxt, M3Raw<HG>& r, int tid, int lane, int wave) {
    typedef MC<HG> C; constexpr int DK = C::DK, DV = C::DV, LD = C::LD, TS = C::TS, RS = C::RS, NS = C::NS, CK = DK / 8, NSEG = HG ? 4 : 2, NT = 64 / NSEG;
    const int c = item / C::NH, h = item % C::NH, row0 = c * 64;
    constexpr int QI_OFF = 0, KP_OFF = 64 * RS, QP_OFF = HG ? 2 * 64 * RS : 0, P_OFF = (HG ? 3 : 2) * 64 * RS, RED_OFF = P_OFF + 64 * TS, ZR_OFF = RED_OFF + 2048, TOT_OFF = ZR_OFF + (HG ? 0 : 64 * RS);
    static_assert(TOT_OFF + 4 * 4 * DK <= 140 * 1024, "M3 LDS");
    LAS float* tot = (LAS float*)(lds + TOT_OFF);
#pragma unroll
    for (int i = 0; i < (HG ? 2 : 3); ++i) { const int ci = tid + NTHR * i, row = ci / CK, cj = ci % CK; *(LAS u32x4*)(lds + QI_OFF + row * RS + cj * 16) = r.q[i]; *(LAS u32x4*)(lds + KP_OFF + row * RS + cj * 16) = r.k[i]; if (!HG) *(LAS u32x4*)(lds + ZR_OFF + row * RS + cj * 16) = r.z[i]; }
    float lb = 0.f, omlb = 1.f, bb = 0.f;
    if (HG) { lb = p.j == 0 ? 0.f : fsigm(r.par.w[1] - r.par.w[0]); omlb = 1.0f - lb; } else bb = r.par.w[0];
    __syncthreads();
    const int fr = lane & 15, g = lane >> 4;
    bf16x8 sfr[NS][DK / 32], vfr[NS][2];
    if (HG)
#pragma unroll
    for (int x = 0; x < NS; ++x) { const int ea = 16 * (wave * NS + x) + fr, sl = ea >> 7, ei = ea & 127;
#pragma unroll
        for (int ks = 0; ks < DK / 32; ++ks) sfr[x][ks] = *(const bf16x8*)(p.us + (((size_t)c * 12 + h * NS + sl) * 128 + ei) * DK + ks * 32 + g * 8);
#pragma unroll
        for (int ks = 0; ks < 2; ++ks) vfr[x][ks] = *(const bf16x8*)(p.vtg + (((size_t)c * 12 + h * NS + sl) * 128 + ei) * 64 + ks * 32 + g * 8); }
    if (nxt >= 0) m3_load<HG>(p, nxt, tid, r);
    u32x2 gpre[NS][4];
#pragma unroll
    for (int x = 0; x < NS; ++x)
#pragma unroll
        for (int tb = 0; tb < 4; ++tb) gpre[x][tb] = *(const u32x2*)(p.proj + (size_t)(row0 + 16 * tb + fr) * LD + C::GOFF + h * DV + 16 * (wave * NS + x) + 4 * g);
    {
        const int d = HG ? (tid & 127) : (tid % 192), seg = HG ? (tid >> 7) : (tid / 192), t0 = seg * NT;
        const bool act = seg < NSEG;
        LAS bf16* qi = (LAS bf16*)(lds + QI_OFF) + d; LAS bf16* kp = (LAS bf16*)(lds + KP_OFF) + d; LAS bf16* qp = (LAS bf16*)(lds + QP_OFF) + d; const LAS bf16* zr = (const LAS bf16*)(lds + ZR_OFF) + d;
        float la_[NT / 8][8], k_[NT / 8][8]; const bool haslb = p.j != 0;
        if (act) { float tsum = 0.f;
#pragma unroll
            for (int i8 = 0; i8 < NT / 8; ++i8) { gate8<HG>((HG ? (const LAS bf16*)kp : zr) + (t0 + i8 * 8) * (RS / 2), RS / 2, bb, lb, omlb, haslb, la_[i8], k_[i8]);
#pragma unroll
                for (int j = 0; j < 8; ++j) tsum += la_[i8][j]; }
            tot[seg * DK + d] = tsum; }
        __syncthreads();
        if (act) { float cum = 0.f;
#pragma unroll
            for (int q = 0; q < NSEG; ++q) if (q < seg) cum += tot[q * DK + d];
            const float cm = HG ? tot[d] + tot[DK + d] : 0.f, ecm = HG ? fexp(cm) : 1.0f;
#pragma unroll
            for (int i8 = 0; i8 < NT / 8; ++i8) { const int tb0 = (t0 + i8 * 8) * (RS / 2);
                float qx[8], kx[8], cv[8], e1[8], e2[8];
#pragma unroll
                for (int j = 0; j < 8; ++j) qx[j] = bf2f(qi[tb0 + j * (RS / 2)]);
#pragma unroll
                for (int j = 0; j < 8; ++j) kx[j] = HG ? k_[i8][j] : bf2f(kp[tb0 + j * (RS / 2)]);
#pragma unroll
                for (int j = 0; j < 8; ++j) { cum += la_[i8][j]; cv[j] = 1.44269504f * (cum - cm); }
#pragma unroll
                for (int j = 0; j < 8; ++j) e1[j] = __builtin_amdgcn_exp2f(cv[j]);
#pragma unroll
                for (int j = 0; j < 8; ++j) e2[j] = __builtin_amdgcn_exp2f(-cv[j]);
                if (HG) { float sg[8];
#pragma unroll
                    for (int j = 0; j < 8; ++j) sg[j] = __builtin_amdgcn_exp2f(-1.44269504f * qx[j]);
#pragma unroll
                    for (int j = 0; j < 8; ++j) sg[j] = __builtin_amdgcn_rcpf(1.0f + sg[j]);
#pragma unroll
                    for (int j = 0; j < 8; ++j) { const float qpv = qx[j] * sg[j] * e1[j];
                        qi[tb0 + j * (RS / 2)] = (bf16)(pk2(qpv * ecm, 0.f) & 0xffffu); qp[tb0 + j * (RS / 2)] = (bf16)(pk2(qpv, 0.f) & 0xffffu); kp[tb0 + j * (RS / 2)] = (bf16)(pk2(kx[j] * e2[j], 0.f) & 0xffffu); }
                } else {
#pragma unroll
                    for (int j = 0; j < 8; ++j) { qi[tb0 + j * (RS / 2)] = (bf16)(pk2(qx[j] * 0.07216878364870322f * e1[j], 0.f) & 0xffffu); kp[tb0 + j * (RS / 2)] = (bf16)(pk2(kx[j] * e2[j], 0.f) & 0xffffu); }
                }
            }
        }
    }
    __syncthreads();
#pragma unroll
    for (int x = 0; x < 2; ++x) {
        const int ti = 2 * wave + x, tb = ti >> 2, sb = ti & 3;
        f32x4 acc = (f32x4){0.f, 0.f, 0.f, 0.f};
        if (sb <= tb) {
#pragma unroll
            for (int ks = 0; ks < DK / 32; ++ks) {
                const bf16x8 afr = *(const LAS bf16x8*)(lds + KP_OFF + (16 * sb + fr) * RS + ks * 64 + g * 16);
                const bf16x8 bfr = *(const LAS bf16x8*)(lds + QP_OFF + (16 * tb + fr) * RS + ks * 64 + g * 16);
                acc = __builtin_amdgcn_mfma_f32_16x16x32_bf16(afr, bfr, acc, 0, 0, 0);
            }
            const int tt = 16 * tb + fr, s0 = 16 * sb + 4 * g;
#pragma unroll
            for (int q = 0; q < 4; ++q) if (s0 + q > tt) acc[q] = 0.f;
        }
        u32x2 w; w.x = pk2(acc[0], acc[1]); w.y = pk2(acc[2], acc[3]);
        *(LAS u32x2*)(lds + P_OFF + (16 * tb + fr) * TS + (16 * sb + 4 * g) * 2) = w;
    }
    __syncthreads();
    f32x4 acc[NS][4];
#pragma unroll
    for (int x = 0; x < NS; ++x)
#pragma unroll
        for (int tb = 0; tb < 4; ++tb) acc[x][tb] = (f32x4){0.f, 0.f, 0.f, 0.f};
#pragma unroll
    for (int ks = 0; ks < DK / 32; ++ks) {
        bf16x8 bq[4];
#pragma unroll
        for (int tb = 0; tb < 4; ++tb) bq[tb] = *(const LAS bf16x8*)(lds + QI_OFF + (16 * tb + fr) * RS + ks * 64 + g * 16);
#pragma unroll
        for (int x = 0; x < NS; ++x) {
            const int ea = 16 * (wave * NS + x) + fr, sl = ea >> 7, ei = ea & 127;
            bf16x8 afr; if (HG) afr = sfr[x][ks]; else afr = *(const bf16x8*)(p.us + (((size_t)c * 12 + h * NS + sl) * 128 + ei) * DK + ks * 32 + g * 8);
#pragma unroll
            for (int tb = 0; tb < 4; ++tb) acc[x][tb] = __builtin_amdgcn_mfma_f32_16x16x32_bf16(afr, bq[tb], acc[x][tb], 0, 0, 0);
        }
    }
#pragma unroll
    for (int ks = 0; ks < 2; ++ks) {
        bf16x8 bp[4];
#pragma unroll
        for (int tb = 0; tb < 4; ++tb) bp[tb] = *(const LAS bf16x8*)(lds + P_OFF + (16 * tb + fr) * TS + ks * 64 + g * 16);
#pragma unroll
        for (int x = 0; x < NS; ++x) {
            const int ea = 16 * (wave * NS + x) + fr, sl = ea >> 7, ei = ea & 127;
            bf16x8 afr; if (HG) afr = vfr[x][ks]; else afr = *(const bf16x8*)(p.vtg + (((size_t)c * 12 + h * NS + sl) * 128 + ei) * 64 + ks * 32 + g * 8);
#pragma unroll
            for (int tb = 0; tb < 4; ++tb) acc[x][tb] = __builtin_amdgcn_mfma_f32_16x16x32_bf16(afr, bp[tb], acc[x][tb], 0, 0, 0);
        }
    }
    LAS float* red = (LAS float*)(lds + RED_OFF);
#pragma unroll
    for (int tb = 0; tb < 4; ++tb) { float ss = 0.f;
#pragma unroll
        for (int x = 0; x < NS; ++x) ss += (acc[x][tb][0] * acc[x][tb][0] + acc[x][tb][1] * acc[x][tb][1]) + (acc[x][tb][2] * acc[x][tb][2] + acc[x][tb][3] * acc[x][tb][3]);
        ss += __shfl_xor(ss, 16); ss += __shfl_xor(ss, 32);
        if (g == 0) red[wave * 64 + 16 * tb + fr] = ss; }
    __syncthreads();
#pragma unroll
    for (int tb = 0; tb < 4; ++tb) { float tsum = 0.f;
#pragma unroll
        for (int w = 0; w < 8; ++w) tsum += red[w * 64 + 16 * tb + fr];
        const float rstd = rsqrtf(tsum * (1.0f / DV) + EPS); const int row = row0 + 16 * tb + fr;
#pragma unroll
        for (int x = 0; x < NS; ++x) { const int e0 = 16 * (wave * NS + x) + 4 * g;
            const u32x2 gw2 = gpre[x][tb]; const f32x4 gn = *(const f32x4*)(p.onorm + e0);
            const float g0 = bflo(gw2.x), g1 = bfhi(gw2.x), g2 = bflo(gw2.y), g3 = bfhi(gw2.y);
            const float y0 = acc[x][tb][0] * rstd * gn.x * pg8::fsilu(g0), y1 = acc[x][tb][1] * rstd * gn.y * pg8::fsilu(g1), y2 = acc[x][tb][2] * rstd * gn.z * pg8::fsilu(g2), y3 = acc[x][tb][3] * rstd * gn.w * pg8::fsilu(g3);
            u32x2 w; w.x = pk2(y0, y1); w.y = pk2(y2, y3); *(u32x2*)(p.cat + (size_t)row * D + h * DV + e0) = w; }
    }
}
template <bool HG> __device__ __forceinline__ void xa_item(const bf16* proj, const bf16* memk, const bf16* memvt, bf16* cat, int l, int wi, int lane) {
    typedef MC<HG> C; constexpr int LD = C::LD;
    const int tblk = wi >> 2, hd = wi & 3, fr = lane & 15, g = lane >> 4, b = tblk >> 9;
    bf16x8 qf[4];
#pragma unroll
    for (int ks = 0; ks < 4; ++ks) qf[ks] = *(const bf16x8*)(proj + (size_t)(16 * tblk + fr) * LD + C::XQOFF + hd * 128 + ks * 32 + g * 8);
    f32x4 st[16];
    const bf16* kb = memk + (size_t)(b * 256 + fr) * 2048 + l * 512 + hd * 128 + g * 8;
#pragma unroll
    for (int mb = 0; mb < 16; ++mb) { f32x4 a = (f32x4){0.f, 0.f, 0.f, 0.f};
#pragma unroll
        for (int ks = 0; ks < 4; ++ks) { const bf16x8 kf = *(const bf16x8*)(kb + (size_t)(16 * mb) * 2048 + ks * 32); a = __builtin_amdgcn_mfma_f32_16x16x32_bf16(kf, qf[ks], a, 0, 0, 0); }
        st[mb] = a; }
    float mx = -3.0e38f;
#pragma unroll
    for (int mb = 0; mb < 16; ++mb) mx = fmaxf(fmaxf(fmaxf(st[mb][0], st[mb][1]), fmaxf(st[mb][2], st[mb][3])), mx);
    mx = fmaxf(mx, __shfl_xor(mx, 16)); mx = fmaxf(mx, __shfl_xor(mx, 32));
    constexpr float SC = 0.08838834764831845f * 1.44269504f; float sum = 0.f;
#pragma unroll
    for (int mb = 0; mb < 16; ++mb)
#pragma unroll
        for (int r = 0; r < 4; ++r) { const float pz = __builtin_amdgcn_exp2f((st[mb][r] - mx) * SC); st[mb][r] = pz; sum += pz; }
    sum += __shfl_xor(sum, 16); sum += __shfl_xor(sum, 32);
    const float inv = __builtin_amdgcn_rcpf(sum);
    bf16x8 pf[8];
#pragma unroll
    for (int kk = 0; kk < 8; ++kk) { u32x4 w; w.x = pk2(st[2 * kk][0], st[2 * kk][1]); w.y = pk2(st[2 * kk][2], st[2 * kk][3]); w.z = pk2(st[2 * kk + 1][0], st[2 * kk + 1][1]); w.w = pk2(st[2 * kk + 1][2], st[2 * kk + 1][3]);
        pf[kk] = __builtin_bit_cast(bf16x8, w); }
    const bf16* vb = memvt + (size_t)(l * 512 + hd * 128 + fr) * 512 + b * 256 + 4 * g;
#pragma unroll
    for (int eb = 0; eb < 8; ++eb) { f32x4 o = (f32x4){0.f, 0.f, 0.f, 0.f};
#pragma unroll
        for (int kk = 0; kk < 8; ++kk) { const u32x2 v0 = *(const u32x2*)(vb + (size_t)(16 * eb) * 512 + 32 * kk), v1 = *(const u32x2*)(vb + (size_t)(16 * eb) * 512 + 32 * kk + 16);
            u32x4 w; w.x = v0.x; w.y = v0.y; w.z = v1.x; w.w = v1.y;
            o = __builtin_amdgcn_mfma_f32_16x16x32_bf16(__builtin_bit_cast(bf16x8, w), pf[kk], o, 0, 0, 0); }
        u32x2 w; w.x = pk2(o[0] * inv, o[1] * inv); w.y = pk2(o[2] * inv, o[3] * inv);
        *(u32x2*)(cat + (size_t)(16 * tblk + fr) * D + MIXW + hd * 128 + 16 * eb + 4 * g) = w; }
}

template <bool HG> __device__ __forceinline__ void xa_phase(const bf16* proj, const bf16* memk, const bf16* memvt, bf16* cat, int l, LAS unsigned char* lds, int tid, int lane, int wave) {
    typedef MC<HG> C; constexpr int LD = C::LD, KS = 272, VS = 528, K_OFF = 0, V_OFF = 256 * KS;
    static_assert(V_OFF + 128 * VS <= 140 * 1024, "XA LDS");
    const int bx = blockIdx.x, bh = bx & 7, b = bh >> 2, hd = bh & 3, part = bx >> 3;
#pragma unroll
    for (int i = 0; i < 8; ++i) { const int ci = tid + NTHR * i, m = ci >> 4, cj = ci & 15;
        *(LAS u32x4*)(lds + K_OFF + m * KS + cj * 16) = *(const u32x4*)(memk + (size_t)(b * 256 + m) * 2048 + l * 512 + hd * 128 + cj * 8); }
#pragma unroll
    for (int i = 0; i < 8; ++i) { const int ci = tid + NTHR * i, e = ci >> 5, cj = ci & 31;
        *(LAS u32x4*)(lds + V_OFF + e * VS + cj * 16) = *(const u32x4*)(memvt + (size_t)(l * 512 + hd * 128 + e) * 512 + b * 256 + cj * 8); }
    __syncthreads();
    const int fr = lane & 15, g = lane >> 4;
    for (int j = wave; j < 16; j += NWAVES) {
        const int tblk = b * 512 + part * 16 + j;
        bf16x8 qf[4];
#pragma unroll
        for (int ks = 0; ks < 4; ++ks) qf[ks] = *(const bf16x8*)(proj + (size_t)(16 * tblk + fr) * LD + C::XQOFF + hd * 128 + ks * 32 + g * 8);
        f32x4 st[16];
#pragma unroll
        for (int mb = 0; mb < 16; ++mb) { f32x4 a = (f32x4){0.f, 0.f, 0.f, 0.f};
#pragma unroll
            for (int ks = 0; ks < 4; ++ks) { const bf16x8 kf = *(const LAS bf16x8*)(lds + K_OFF + (16 * mb + fr) * KS + ks * 64 + g * 16); a = __builtin_amdgcn_mfma_f32_16x16x32_bf16(kf, qf[ks], a, 0, 0, 0); }
            st[mb] = a; }
        float mx = -3.0e38f;
#pragma unroll
        for (int mb = 0; mb < 16; ++mb) mx = fmaxf(fmaxf(fmaxf(st[mb][0], st[mb][1]), fmaxf(st[mb][2], st[mb][3])), mx);
        mx = fmaxf(mx, __shfl_xor(mx, 16)); mx = fmaxf(mx, __shfl_xor(mx, 32));
        constexpr float SC = 0.08838834764831845f * 1.44269504f; float sum = 0.f;
#pragma unroll
        for (int mb = 0; mb < 16; ++mb)
#pragma unroll
            for (int q = 0; q < 4; ++q) { const float pz = __builtin_amdgcn_exp2f((st[mb][q] - mx) * SC); st[mb][q] = pz; sum += pz; }
        sum += __shfl_xor(sum, 16); sum += __shfl_xor(sum, 32);
        const float inv = __builtin_amdgcn_rcpf(sum);
        bf16x8 pf[8];
#pragma unroll
        for (int kk = 0; kk < 8; ++kk) { u32x4 w; w.x = pk2(st[2 * kk][0], st[2 * kk][1]); w.y = pk2(st[2 * kk][2], st[2 * kk][3]); w.z = pk2(st[2 * kk + 1][0], st[2 * kk + 1][1]); w.w = pk2(st[2 * kk + 1][2], st[2 * kk + 1][3]);
            pf[kk] = __builtin_bit_cast(bf16x8, w); }
#pragma unroll
        for (int eb = 0; eb < 8; ++eb) { f32x4 o = (f32x4){0.f, 0.f, 0.f, 0.f};
#pragma unroll
            for (int kk = 0; kk < 8; ++kk) { const LAS unsigned char* vp = lds + V_OFF + (16 * eb + fr) * VS + (32 * kk + 4 * g) * 2;
                const u32x2 v0 = *(const LAS u32x2*)vp, v1 = *(const LAS u32x2*)(vp + 32);
                u32x4 w; w.x = v0.x; w.y = v0.y; w.z = v1.x; w.w = v1.y;
                o = __builtin_amdgcn_mfma_f32_16x16x32_bf16(__builtin_bit_cast(bf16x8, w), pf[kk], o, 0, 0, 0); }
            u32x2 w; w.x = pk2(o[0] * inv, o[1] * inv); w.y = pk2(o[2] * inv, o[3] * inv);
            *(u32x2*)(cat + (size_t)(16 * tblk + fr) * D + MIXW + hd * 128 + 16 * eb + 4 * g) = w; }
    }
    __syncthreads();
}
#define RLX_AGENT __ATOMIC_RELAXED, __HIP_MEMORY_SCOPE_AGENT
#define XB_TMO      128
#define XB_XCNT(j)  (256  + 64 * (j))
#define XB_XSUB(j)  (1280 + 64 * (j))
#define XB_XGEN(j)  (2304 + 64 * (j))
#define XB_TOP      3328
#define XB_TOPGEN   3392
#define XCD_BAR_WORDS 3456
#define XB_SPIN_CAP (1u << 18)

__device__ __forceinline__ unsigned xb_ld(unsigned* p)              { return __hip_atomic_load(p, __ATOMIC_RELAXED, __HIP_MEMORY_SCOPE_AGENT); }
__device__ __forceinline__ unsigned xb_add(unsigned* p, unsigned v) { return __hip_atomic_fetch_add(p, v, __ATOMIC_RELAXED, __HIP_MEMORY_SCOPE_AGENT); }
__device__ __forceinline__ unsigned xb_xcc_id() { return (unsigned)__builtin_amdgcn_s_getreg((3 << 11) | 20) & 0xFu; }
#define XB_SPIN(cond, bar) do { unsigned _sp = 0; while (cond) { __builtin_amdgcn_s_sleep(1); \
    if ((++_sp & 255u) == 0u) { if (xb_ld(&(bar)[XB_TMO])) break; if (_sp > XB_SPIN_CAP) { atomicAdd(&(bar)[XB_TMO], 1u); break; } } } } while (0)

struct XcdBarrier {
    unsigned* bar; unsigned x;
    volatile LAS unsigned* st;
};

__device__ __forceinline__ XcdBarrier xcd_barrier_post(unsigned* bar, volatile LAS unsigned* st) {
    XcdBarrier b; b.bar = bar; b.x = xb_xcc_id(); b.st = st;
    if (threadIdx.x == 0) (void)xb_add(&bar[XB_XCNT(b.x)], 1u);
    return b;
}
__device__ __forceinline__ void xcd_barrier_complete(unsigned* bar, unsigned x, unsigned& nloc, unsigned& nx) {
    const unsigned G = gridDim.x * gridDim.y * gridDim.z;
    unsigned sum, cnt, mine, sp = 0u;
    for (;;) {
        sum = 0u; cnt = 0u; mine = 0u;
#pragma unroll
        for (unsigned j = 0; j < 16; ++j) { const unsigned c = xb_ld(&bar[XB_XCNT(j)]); sum += c; cnt += (c > 0u) ? 1u : 0u; mine = (j == x) ? c : mine; }
        if (sum == G) break;
        __builtin_amdgcn_s_sleep(1);
        if ((++sp & 255u) == 0u) { if (xb_ld(&bar[XB_TMO])) break; if (sp > XB_SPIN_CAP) { atomicAdd(&bar[XB_TMO], 1u); break; } }
    }
    nloc = mine > 0u ? mine : 1u; nx = cnt > 0u ? cnt : 1u;
}

__device__ __forceinline__ void xcd_barrier(const XcdBarrier& b) {
    asm volatile("s_waitcnt vmcnt(0)" ::: "memory");
    __syncthreads();
    if (threadIdx.x == 0) {
        unsigned* bar = b.bar;
        __builtin_amdgcn_s_waitcnt(0);
        unsigned nloc = b.st[0], nx = b.st[1];
        if (nloc == 0u) { xcd_barrier_complete(bar, b.x, nloc, nx); b.st[0] = nloc; b.st[1] = nx; }
        const unsigned old = xb_add(&bar[XB_XSUB(b.x)], 1u);
        const unsigned gen = old / nloc;
        if (old + 1u == (gen + 1u) * nloc) {
            __builtin_amdgcn_fence(__ATOMIC_RELEASE, "agent");
            asm volatile("s_waitcnt vmcnt(0)" ::: "memory");
            const unsigned og = xb_add(&bar[XB_TOP], 1u);
            const unsigned tg = og / nx;
            if (og + 1u == (tg + 1u) * nx) xb_add(&bar[XB_TOPGEN], 1u);
            else XB_SPIN(xb_ld(&bar[XB_TOPGEN]) == tg, bar);
            __builtin_amdgcn_fence(__ATOMIC_ACQUIRE, "agent");
            xb_add(&bar[XB_XGEN(b.x)], 1u);
            asm volatile("s_waitcnt vmcnt(0)" ::: "memory");
        } else {
            XB_SPIN(xb_ld(&bar[XB_XGEN(b.x)]) == gen, bar);
            __builtin_amdgcn_fence(__ATOMIC_ACQUIRE, "agent");
            asm volatile("s_waitcnt vmcnt(0)" ::: "memory");
        }
    }
    __syncthreads();
}

#ifndef REP_P0
#define REP_P0 1
#endif
#ifndef REP_SYNC
#define REP_SYNC 0
#endif
#ifndef H_BF16
#define H_BF16 1
#endif
#ifndef REP_M2
#define REP_M2 1
#endif
#ifndef REP_M1
#define REP_M1 1
#endif
#ifndef REP_XA
#define REP_XA 1
#endif
#ifndef REP_M3
#define REP_M3 1
#endif
#ifndef REP_G13
#define REP_G13 1
#endif
#ifndef MK_SKELETON
#define MK_SKELETON 0
#endif
template <class Epi> __device__ __forceinline__ void run_gemm(LAS unsigned char* lds, const bf16* A, const bf16* Bt, int Mr, int N, int K, int G, int c, const Epi& E, int wgm = 4) {
    pg8::Gemm g{A, Bt, Mr, N, K}; pg8::StaticOrder S; S.init(Mr, N, G, c, wgm);
    pg8::gemm_phase<Epi, pg8::StaticOrder, true, true>(lds, g, S, E);
}
template <bool HG> __device__ __forceinline__ void mixer_phases(const Args& a, const XcdBarrier& xbar, LAS unsigned char* lds, int l, int tid_, int lane_, int wave_) {
#define OPAQUE_TID() int tid = threadIdx.x; asm volatile("" : "+v"(tid)); const int lane = tid & 63, wave = __builtin_amdgcn_readfirstlane(tid >> 6);
    unsigned char* ws = a.ws; const int j = l >> 1, G = gridDim.x;
    MixP p; p.proj = (const bf16*)(ws + WS_PROJ); p.us = (bf16*)(ws + WS_US); p.vtg = (bf16*)(ws + WS_VTG); p.dec = (float*)(ws + WS_DEC); p.cat = (bf16*)(ws + WS_CAT);
    p.lb = a.hgrn_lb; p.wgk = a.gla_w_gk + (size_t)j * 16 * 768; p.bgk = a.gla_b_gk + j * 768; p.onorm = HG ? a.hgrn_onorm + j * 128 : a.gla_onorm + j * 384; p.j = j;
    const bool split = HG && G == 256;
#ifndef NO_M1
    if (split && blockIdx.x < 128) { pg8::EpiScaleBf16<true> E{(bf16*)(ws + WS_PROJ) + 6144, HG_IN, (const float*)(ws + WS_SSQ2) + (size_t)(2 * l) * M * 32};
        run_gemm(lds, (const bf16*)(ws + WS_HB), wt_in(ws, l) + (size_t)6144 * D, M, 512, D, 128, (int)blockIdx.x, E); }
    for (int rep = 0; rep < REP_M1; ++rep) { OPAQUE_TID(); M1Raw<HG> r;
        int it, step, end;
        if (split) { step = 1; if (blockIdx.x < 128) { it = blockIdx.x * 8; end = it + 8; } else { it = 1024 + (blockIdx.x - 128) * 16; end = it + 16; } }
        else { it = blockIdx.x; step = G; end = 256 * 12; }
        if (it < end) m1_load<HG>(p, it, tid, r);
        for (; it < end; it += step) m1_item<HG>(p, lds, it, it + step < end ? it + step : -1, r, tid, lane, wave);
        __syncthreads(); }
#endif
#ifndef NO_XA
    if (!split)
    for (int rep = 0; rep < REP_XA; ++rep) { OPAQUE_TID();
        if (G == 256) xa_phase<HG>(p.proj, (const bf16*)(ws + WS_MEMK), (const bf16*)(ws + WS_MEMVT), p.cat, l, lds, tid, lane, wave);
        else for (int wi = blockIdx.x * NWAVES + wave; wi < 4096; wi += G * NWAVES) xa_item<HG>(p.proj, (const bf16*)(ws + WS_MEMK), (const bf16*)(ws + WS_MEMVT), p.cat, l, wi, lane); }
#endif
    xcd_barrier(xbar);
#ifndef NO_M2
    { OPAQUE_TID(); m2_scan<HG>(p, blockIdx.x * NTHR + tid, G * NTHR); }
    if (split) { OPAQUE_TID(); xa_phase<HG>(p.proj, (const bf16*)(ws + WS_MEMK), (const bf16*)(ws + WS_MEMVT), p.cat, l, lds, tid, lane, wave); }
#if REP_M2 > 1
    { OPAQUE_TID(); MixP p2 = p; p2.us = (bf16*)(ws + WS_END); m2_scan<HG>(p2, blockIdx.x * NTHR + tid, G * NTHR); }
#endif
#endif
    xcd_barrier(xbar);
#ifndef NO_M3
    for (int rep = 0; rep < REP_M3; ++rep) { OPAQUE_TID(); constexpr int N3 = 256 * MC<HG>::NH; M3Raw<HG> r; int it = blockIdx.x; if (it < N3) m3_load<HG>(p, it, tid, r);
        for (; it < N3; it += G) m3_item<HG>(p, lds, it, it + G < N3 ? it + G : -1, r, tid, lane, wave);
        __syncthreads(); }
#endif
    xcd_barrier(xbar);
}

__global__ void __launch_bounds__(NTHR, 2) trunk_fwd(Args a) {
    extern __shared__ __attribute__((aligned(16))) unsigned char lds_raw[];
    LAS unsigned char* lds = (LAS unsigned char*)lds_raw;
    cg::grid_group grid = cg::this_grid();
    const int tid = threadIdx.x, lane = tid & 63, wave = __builtin_amdgcn_readfirstlane(tid >> 6), G = gridDim.x, bx = blockIdx.x;
    unsigned char* ws = a.ws;
    float* ssq = (float*)(ws + WS_SSQ2); float* H = (float*)(ws + WS_H); bf16* HB = (bf16*)(ws + WS_HB); bf16* CAT = (bf16*)(ws + WS_CAT); bf16* PROJ = (bf16*)(ws + WS_PROJ); bf16* ACT = PROJ;
#ifndef NO_P0
    for (int rep = 0; rep < REP_P0; ++rep) p0_prologue(a, lds, tid, lane, wave);
#endif
    { unsigned* bw = (unsigned*)(ws + WS_BAR); if (bx == 0) for (int i = tid; i < XCD_BAR_WORDS; i += NTHR) bw[i] = 0u; if (tid < 2) ((volatile LAS unsigned*)(lds + LDS_CTL))[tid] = 0u; }
    grid.sync();
    const XcdBarrier xbar = xcd_barrier_post((unsigned*)(ws + WS_BAR), (volatile LAS unsigned*)(lds + LDS_CTL));
#ifndef NO_PKV
    if (bx >= G - 32 && bx < G - 16) { pg8::EpiScaleBf16<false> E{(bf16*)(ws + WS_MEMK), 2048, nullptr}; run_gemm(lds, (const bf16*)(ws + WS_MEMN), (const bf16*)(ws + WS_WTK), MMEM, 2048, D, 16, bx - (G - 32), E); }
    else if (bx >= G - 16) { pg8::EpiScaleBf16<false> E{(bf16*)(ws + WS_MEMVT), 512, nullptr}; run_gemm(lds, (const bf16*)(ws + WS_WTV), (const bf16*)(ws + WS_MEMN), 2048, MMEM, D, 16, bx - (G - 16), E); }
#endif
#pragma unroll 1
    for (int l = 0; l < DEPTH; ++l) {
#ifndef NO_G1
        for (int rep = 0; rep < REP_G13; ++rep) { pg8::EpiScaleBf16<true> E{PROJ, n_in(l), ssq + (size_t)(2 * l) * M * 32}; run_gemm(lds, HB, wt_in(ws, l), M, (!(l & 1) && G == 256) ? 6144 : n_in(l), D, G, bx, E); }
#endif
        xcd_barrier(xbar);
        if (l & 1) mixer_phases<false>(a, xbar, lds, l, tid, lane, wave); else mixer_phases<true>(a, xbar, lds, l, tid, lane, wave);
#ifndef NO_G2
#if H_BF16
        { pg8::EpiResidBf E{HB, ssq + (size_t)(2 * l + 1) * M * 32}; run_gemm(lds, CAT, wt_out(ws, l), M, D, D, G, bx, E, WGM_G2); }
#else
        { pg8::EpiResid E{l == 0 ? a.x : H, H, HB, ssq + (size_t)(2 * l + 1) * M * 32}; run_gemm(lds, CAT, wt_out(ws, l), M, D, D, G, bx, E); }
#endif
#endif
        xcd_barrier(xbar);
        for (int rep = 0; rep < REP_SYNC; ++rep) xcd_barrier(xbar);
#ifndef NO_G3
        for (int rep = 0; rep < REP_G13; ++rep) { pg8::EpiSwiglu E{ACT, DFF, ssq + (size_t)(2 * l + 1) * M * 32}; run_gemm(lds, HB, wt_gu(ws, l), M, 2 * DFF, D, G, bx, E); }
#endif
        xcd_barrier(xbar);
#ifndef NO_G4
#if H_BF16
        { pg8::EpiResidBf E{HB, ssq + (size_t)(2 * l + 2) * M * 32}; run_gemm(lds, ACT, wt_down(ws, l), M, D, DFF, G, bx, E, WGM_G4); }
#else
        { pg8::EpiResid E{H, H, HB, ssq + (size_t)(2 * l + 2) * M * 32}; run_gemm(lds, ACT, wt_down(ws, l), M, D, DFF, G, bx, E); }
#endif
#endif
        xcd_barrier(xbar);
    }
    for (int m = bx * NWAVES + wave; m < M; m += G * NWAVES) {
        const float r = rsqrtf(wave_sum(lane < 32 ? ssq[((size_t)8 * M + m) * 32 + lane] : 0.f) * (1.0f / D) + EPS);
        const f32x4* hr = (const f32x4*)(H + (size_t)m * D) + lane; const u32x2* hb = (const u32x2*)(HB + (size_t)m * D) + lane; const f32x4* gr = (const f32x4*)a.norm_final + lane; f32x4* o = (f32x4*)(a.out + (size_t)m * D) + lane;
#pragma unroll
        for (int jj = 0; jj < 8; ++jj) { f32x4 v; if (H_BF16) { const u32x2 w = hb[64 * jj]; v = (f32x4){bflo(w.x), bfhi(w.x), bflo(w.y), bfhi(w.y)}; } else v = hr[64 * jj]; const f32x4 gg = gr[64 * jj]; o[64 * jj] = (f32x4){v.x * r * gg.x, v.y * r * gg.y, v.z * r * gg.z, v.w * r * gg.w}; }
    }
}

extern "C" void kernel_launch(void* const* d_in, const int* in_sizes, int n_in_, void* d_out, int out_size, void* d_ws, size_t ws_size, hipStream_t stream) {
    static int grid = 0;
    if (grid == 0) {
        if (n_in_ != 17 || in_sizes[0] != M * D || out_size != M * D || ws_size < WS_END) { fprintf(stderr, "kernel_launch: unexpected shapes (n_in %d, in0 %d, out %d, ws %zu < %zu)\n", n_in_, n_in_ > 0 ? in_sizes[0] : -1, out_size, ws_size, (size_t)WS_END); grid = -1; return; }
        int dev = 0, cus = 0, per_cu = 0;
        hipGetDevice(&dev); hipDeviceGetAttribute(&cus, hipDeviceAttributeMultiprocessorCount, dev);
        if (hipFuncSetAttribute((const void*)trunk_fwd, hipFuncAttributeMaxDynamicSharedMemorySize, LDS_BYTES) != hipSuccess) { fprintf(stderr, "kernel_launch: hipFuncSetAttribute failed\n"); grid = -1; return; }
        if (hipOccupancyMaxActiveBlocksPerMultiprocessor(&per_cu, (const void*)trunk_fwd, NTHR, LDS_BYTES) != hipSuccess || per_cu < 1) { fprintf(stderr, "kernel_launch: occupancy query says %d blocks per CU\n", per_cu); per_cu = 1; }
        (void)hipGetLastError();
        grid = cus;
    }
    if (grid < 0) return;
    Args a{};
    a.x = (const float*)d_in[0]; a.mem = (const float*)d_in[1]; a.norm_mix = (const float*)d_in[2]; a.norm_ffn = (const float*)d_in[3]; a.norm_mem = (const float*)d_in[4]; a.norm_final = (const float*)d_in[5];
    a.hgrn_w_in = (const float*)d_in[6]; a.hgrn_lb = (const float*)d_in[7]; a.hgrn_onorm = (const float*)d_in[8]; a.gla_w_in = (const float*)d_in[9]; a.gla_w_gk = (const float*)d_in[10]; a.gla_b_gk = (const float*)d_in[11];
    a.gla_onorm = (const float*)d_in[12]; a.w_mem_kv = (const float*)d_in[13]; a.w_out = (const float*)d_in[14]; a.w_gate_up = (const float*)d_in[15]; a.w_down = (const float*)d_in[16];
    a.out = (float*)d_out; a.ws = (unsigned char*)d_ws;
    void* args[] = {&a};
    hipError_t e = hipLaunchCooperativeKernel((const void*)trunk_fwd, dim3(grid), dim3(NTHR), args, LDS_BYTES, stream);
    if (e != hipSuccess) fprintf(stderr, "kernel_launch: cooperative launch failed: %s (grid %d)\n", hipGetErrorString(e), grid);
}
```

```cpp
#include <hip/hip_runtime.h>
#ifndef WGM_G4
#define WGM_G4 4
#endif
#ifndef WGM_G2
#define WGM_G2 4
#endif
#include <hip/hip_cooperative_groups.h>
#include <cstdio>
#include <cstdint>
namespace cg = cooperative_groups;
namespace pg8 {
#define PG8_LAS __attribute__((address_space(3)))
typedef unsigned short bf16_t;
typedef short bf16x8 __attribute__((ext_vector_type(8)));
typedef float f32x4 __attribute__((ext_vector_type(4)));
typedef unsigned u32x4 __attribute__((ext_vector_type(4)));
typedef unsigned u32x2 __attribute__((ext_vector_type(2)));
constexpr int BM = 256, BK = 64, HALF = 128, HTB = HALF * BK * 2  , STAGE_BYTES = 8 * HTB, NXCD = 8, WGM = 8;

__host__ __device__ __forceinline__ int lds_byte(int r, int c) { const int st = (r >> 4) * 2 + (c >> 5), rr = r & 15, cc = c & 31, ob = rr * 64 + cc * 2; return st * 1024 + (ob ^ (((ob >> 9) & 1) << 5)); }
__host__ __device__ __forceinline__ void stage_rc(int b, int& R, int& C) { const int st = b / 1024, sb = b % 1024, swz = sb ^ (((sb >> 9) & 1) << 5); R = (st >> 1) * 16 + swz / 64; C = (st & 1) * 32 + (swz % 64) / 2; }
__host__ __device__ __forceinline__ int perm32(int rho) { const int n = rho >> 4, i = rho & 15; return 8 * (i >> 2) + 4 * n + (i & 3); }

struct Unit { int pm, pn; };
struct Gemm { const bf16_t* A; const bf16_t* Bt; int M, N, K; };

struct StaticOrder {
    int nM, nN, nwg, G, c, wgm;
    __host__ __device__ void init(int M, int N, int G_, int c_, int wgm_ = 4) { nM = M / BM; nN = N / BM; nwg = nM * nN; G = G_; c = c_; wgm = wgm_; }
    __host__ __device__ bool next(int i, Unit& u) const {
        const long L = (long)i * G + c; if (L >= nwg) return false;
        int wgid = (int)L; { const int q = nwg / NXCD, r = nwg % NXCD, xcd = wgid % NXCD, off = wgid / NXCD; wgid = (xcd < r ? xcd * (q + 1) : r * (q + 1) + (xcd - r) * q) + off; }
        const int nig = wgm * nN, gid = wgid / nig, fm = gid * wgm, gsz = (nM - fm) < wgm ? (nM - fm) : wgm;
        u.pm = fm + ((wgid % nig) % gsz); u.pn = (wgid % nig) / gsz; return true;
    }
    __device__ __forceinline__ void a_ready(const Unit&) const {}
    __device__ __forceinline__ void done(const Unit&) const {}
};
__device__ __forceinline__ unsigned cvt_pk_bf16(float lo, float hi) { unsigned r; asm volatile("v_cvt_pk_bf16_f32 %0, %1, %2" : "=v"(r) : "v"(lo), "v"(hi)); return r; }
constexpr float RMS_EPS = 1e-6f;
__device__ __forceinline__ float row_rstd(const float* ssqp, int row, int fq) {
    const float* pr = ssqp + (size_t)row * 32 + 8 * fq; const f32x4 a = *(const f32x4*)pr, b = *(const f32x4*)(pr + 4);
    float s = ((a[0] + a[1]) + (a[2] + a[3])) + ((b[0] + b[1]) + (b[2] + b[3]));
    s += __shfl_xor(s, 16); s += __shfl_xor(s, 32);
    return rsqrtf(s * (1.0f / 2048.0f) + RMS_EPS);
}
__device__ __forceinline__ float fsilu(float g) { return g * __builtin_amdgcn_rcpf(1.0f + __builtin_amdgcn_exp2f(-1.44269504f * g)); }
template <bool SCALE> struct EpiScaleBf16 {
    static constexpr bool PERM = true, AFTER_DRAIN = false;
    bf16_t* O; int ldc; const float* ssq;
    __device__ __forceinline__ void operator()(const f32x4 (&acc)[2][2][4][2], const Unit& u, int wr, int wc, int fr, int fq) const {
        const int row0 = u.pm * BM + wr * 64 + fr, col0 = u.pn * BM + wc * 32 + 8 * fq;
#pragma unroll
        for (int ai = 0; ai < 2; ++ai)
#pragma unroll
            for (int m = 0; m < 4; ++m) {
                const int row = row0 + ai * HALF + m * 16;
                float r = 1.0f; if (SCALE) r = row_rstd(ssq, row, fq);
                bf16_t* rowp = O + (size_t)row * ldc + col0;
#pragma unroll
                for (int bj = 0; bj < 2; ++bj) { const f32x4 v0 = acc[ai][bj][m][0] * r, v1 = acc[ai][bj][m][1] * r;
                    u32x4 w; w.x = cvt_pk_bf16(v0[0], v0[1]); w.y = cvt_pk_bf16(v0[2], v0[3]); w.z = cvt_pk_bf16(v1[0], v1[1]); w.w = cvt_pk_bf16(v1[2], v1[3]);
                    *(u32x4*)(rowp + bj * HALF) = w; }
            }
    }
};
struct EpiSwiglu {
    static constexpr bool PERM = true, AFTER_DRAIN = false;
    bf16_t* O; int ldo; const float* ssq;
    __device__ __forceinline__ void operator()(const f32x4 (&acc)[2][2][4][2], const Unit& u, int wr, int wc, int fr, int fq) const {
        const int row0 = u.pm * BM + wr * 64 + fr, col0 = u.pn * HALF + wc * 32 + 8 * fq;
#pragma unroll
        for (int ai = 0; ai < 2; ++ai)
#pragma unroll
            for (int m = 0; m < 4; ++m) {
                const int row = row0 + ai * HALF + m * 16;
                const float r = row_rstd(ssq, row, fq);
                float y[8];
#pragma unroll
                for (int n = 0; n < 2; ++n)
#pragma unroll
                    for (int j = 0; j < 4; ++j) { const float g = acc[ai][0][m][n][j] * r, up = acc[ai][1][m][n][j] * r; y[n * 4 + j] = fsilu(g) * up; }
                u32x4 w; w.x = cvt_pk_bf16(y[0], y[1]); w.y = cvt_pk_bf16(y[2], y[3]); w.z = cvt_pk_bf16(y[4], y[5]); w.w = cvt_pk_bf16(y[6], y[7]);
                *(u32x4*)(O + (size_t)row * ldo + col0) = w;
            }
    }
};
struct EpiResid {
    static constexpr bool PERM = false, AFTER_DRAIN = false;
    const float* Hin; float* Hout; bf16_t* HB; float* ssq;
    __device__ __forceinline__ void operator()(const f32x4 (&acc)[2][2][4][2], const Unit& u, int wr, int wc, int fr, int fq) const {
        const int row0 = u.pm * BM + wr * 64 + fr, col0 = u.pn * BM + wc * 32 + 4 * fq;
#pragma unroll
        for (int ai = 0; ai < 2; ++ai)
#pragma unroll
            for (int m = 0; m < 4; ++m) {
                const int row = row0 + ai * HALF + m * 16; const size_t off = (size_t)row * 2048 + col0; float ss = 0.f;
#pragma unroll
                for (int bj = 0; bj < 2; ++bj)
#pragma unroll
                    for (int n = 0; n < 2; ++n) { const size_t o = off + bj * HALF + n * 16;
                        const f32x4 h = *(const f32x4*)(Hin + o) + acc[ai][bj][m][n];
                        *(f32x4*)(Hout + o) = h;
                        u32x2 w; w.x = cvt_pk_bf16(h[0], h[1]); w.y = cvt_pk_bf16(h[2], h[3]); *(u32x2*)(HB + o) = w;
                        ss += (h[0] * h[0] + h[1] * h[1]) + (h[2] * h[2] + h[3] * h[3]); }
                ss += __shfl_xor(ss, 16); ss += __shfl_xor(ss, 32);
                if (fq == 0) ssq[(size_t)row * 32 + u.pn * 4 + wc] = ss;
                if ((m & 3) == 3) asm volatile("" ::: "memory");
            }
    }
};
struct EpiResidBf {
    static constexpr bool PERM = true, AFTER_DRAIN = false;
    bf16_t* HB; float* ssq;
    __device__ __forceinline__ void operator()(const f32x4 (&acc)[2][2][4][2], const Unit& u, int wr, int wc, int fr, int fq) const {
        const int row0 = u.pm * BM + wr * 64 + fr, col0 = u.pn * BM + wc * 32 + 8 * fq;
#pragma unroll
        for (int ai = 0; ai < 2; ++ai)
#pragma unroll
            for (int m = 0; m < 4; ++m) {
                const int row = row0 + ai * HALF + m * 16; const size_t off = (size_t)row * 2048 + col0; float ss = 0.f;
#pragma unroll
                for (int bj = 0; bj < 2; ++bj) { const size_t o = off + bj * HALF;
                    const u32x4 hw = *(const u32x4*)(HB + o); u32x4 w;
#pragma unroll
                    for (int n = 0; n < 2; ++n) { const unsigned h01 = n ? hw.z : hw.x, h23 = n ? hw.w : hw.y;
                        const float h0 = __uint_as_float(h01 << 16) + acc[ai][bj][m][n][0], h1 = __uint_as_float(h01 & 0xffff0000u) + acc[ai][bj][m][n][1];
                        const float h2 = __uint_as_float(h23 << 16) + acc[ai][bj][m][n][2], h3 = __uint_as_float(h23 & 0xffff0000u) + acc[ai][bj][m][n][3];
                        const unsigned w01 = cvt_pk_bf16(h0, h1), w23 = cvt_pk_bf16(h2, h3);
                        if (n) { w.z = w01; w.w = w23; } else { w.x = w01; w.y = w23; }
                        const float r0 = __uint_as_float(w01 << 16), r1 = __uint_as_float(w01 & 0xffff0000u), r2 = __uint_as_float(w23 << 16), r3 = __uint_as_float(w23 & 0xffff0000u);
                        ss += (r0 * r0 + r1 * r1) + (r2 * r2 + r3 * r3); }
                    *(u32x4*)(HB + o) = w; }
                ss += __shfl_xor(ss, 16); ss += __shfl_xor(ss, 32);
                if (fq == 0) ssq[(size_t)row * 32 + u.pn * 4 + wc] = ss;
            }
    }
};
template <class Epi, class Sched, bool ALIGN_EPI = false, bool SP2 = false>
__device__ __forceinline__ void gemm_phase(PG8_LAS unsigned char* lds, const Gemm g, const Sched& S, const Epi& E) {
    int tid_raw = threadIdx.x; asm volatile("" : "+v"(tid_raw));
    const int tid = tid_raw, wid = __builtin_amdgcn_readfirstlane(tid >> 6), lane = tid & 63, wr = wid >> 2, wc = wid & 3, fr = lane & 15, fq = lane >> 4;
    const int K = g.K, nt = K / BK;
    unsigned voffA[2], voffB[2];
#pragma unroll
    for (int i = 0; i < 2; ++i) { int R, C; stage_rc(tid * 16 + i * 8192, R, C); const int Rb = Epi::PERM ? ((R & ~31) + perm32(R & 31)) : R;
        voffA[i] = (unsigned)(R * K + C) * 2u; voffB[i] = (unsigned)(Rb * K + C) * 2u; }
    const size_t kstep = (size_t)(BK * 2);
    const size_t hstep = (size_t)HALF * K * 2;
    const size_t tstep = 2 * hstep;
    const unsigned ldsw = (unsigned)wid * 1024u;
    const int aoff = lds_byte(wr * 64 + fr, fq * 8), boff = lds_byte(wc * 32 + fr, fq * 8);
#define PG8_SA(b, h) (((b) * 2 + (h)) * HTB)
#define PG8_SB(b, h) ((4 + (b) * 2 + (h)) * HTB)
#define PG8_STAGE(bufoff, gbase, voff) do { _Pragma("unroll") for (int _i = 0; _i < 2; ++_i) \
        __builtin_amdgcn_global_load_lds((const unsigned*)((const char*)(gbase) + (voff)[_i]), (PG8_LAS unsigned*)(lds + (bufoff) + ldsw + _i * 8192), 16, 0, 0); } while (0)
#define PG8_LDA(dst, b, h) do { _Pragma("unroll") for (int m = 0; m < 4; ++m) _Pragma("unroll") for (int k = 0; k < 2; ++k) dst[m][k] = *(const PG8_LAS bf16x8*)(lds + PG8_SA(b, h) + aoff + m * 2048 + k * 1024); } while (0)
#define PG8_LDB(dst, b, h) do { _Pragma("unroll") for (int n = 0; n < 2; ++n) _Pragma("unroll") for (int k = 0; k < 2; ++k) dst[n][k] = *(const PG8_LAS bf16x8*)(lds + PG8_SB(b, h) + boff + n * 2048 + k * 1024); } while (0)
#define PG8_MMA(ai, bj, At, Bt) do { __builtin_amdgcn_s_setprio(1); _Pragma("unroll") for (int m = 0; m < 4; ++m) _Pragma("unroll") for (int n = 0; n < 2; ++n) _Pragma("unroll") for (int k = 0; k < 2; ++k) \
        acc[ai][bj][m][n] = __builtin_amdgcn_mfma_f32_16x16x32_bf16(Bt[n][k], At[m][k], acc[ai][bj][m][n], 0, 0, 0); __builtin_amdgcn_s_setprio(0); } while (0)
#define PG8_WAIT_V(n) asm volatile("s_waitcnt vmcnt(" #n ")" ::: "memory")
#define PG8_WAIT_L(n) asm volatile("s_waitcnt lgkmcnt(" #n ")" ::: "memory")
#define PG8_BAR __builtin_amdgcn_s_barrier()
#define PG8_SCHED __builtin_amdgcn_sched_barrier(0)
    Unit cur, nxt; int ui = 0;
    if (!S.next(0, cur)) return;
    f32x4 acc[2][2][4][2];
#pragma unroll
    for (int a = 0; a < 2; ++a)
#pragma unroll
        for (int b = 0; b < 2; ++b)
#pragma unroll
            for (int m = 0; m < 4; ++m)
#pragma unroll
                for (int n = 0; n < 2; ++n) acc[a][b][m][n] = (f32x4){0.f, 0.f, 0.f, 0.f};
    bf16x8 At[4][2], B0[2][2], B1[2][2];
    const char* cA = (const char*)g.A + (size_t)cur.pm * tstep; const char* cB = (const char*)g.Bt + (size_t)cur.pn * tstep;
    S.a_ready(cur);
    if constexpr (SP2) {
        PG8_STAGE(PG8_SB(0, 0), cB, voffB); PG8_STAGE(PG8_SB(0, 1), cB + hstep, voffB); PG8_STAGE(PG8_SA(0, 0), cA, voffA); PG8_STAGE(PG8_SA(0, 1), cA + hstep, voffA);
        if (wr == 1) PG8_BAR;
        PG8_WAIT_V(2); PG8_BAR;
        PG8_STAGE(PG8_SB(1, 0), cB + kstep, voffB); PG8_STAGE(PG8_SA(1, 0), cA + kstep, voffA); PG8_STAGE(PG8_SB(1, 1), cB + hstep + kstep, voffB);
        PG8_WAIT_V(6); PG8_BAR;
    } else {
        PG8_STAGE(PG8_SB(0, 0), cB, voffB); PG8_STAGE(PG8_SA(0, 0), cA, voffA); PG8_STAGE(PG8_SB(0, 1), cB + hstep, voffB); PG8_STAGE(PG8_SA(0, 1), cA + hstep, voffA);
        if (wr == 1) PG8_BAR;
        PG8_WAIT_V(4); PG8_BAR;
        PG8_STAGE(PG8_SB(1, 0), cB + kstep, voffB); PG8_STAGE(PG8_SA(1, 0), cA + kstep, voffA); PG8_STAGE(PG8_SB(1, 1), cB + hstep + kstep, voffB);
        PG8_WAIT_V(6); PG8_BAR;
    }
    for (;;) {
        const bool has_next = S.next(ui + 1, nxt);
        const char* nA = has_next ? (const char*)g.A + (size_t)nxt.pm * tstep : cA; const char* nB = has_next ? (const char*)g.Bt + (size_t)nxt.pn * tstep : cB;
        for (int t = 0; t < nt; t += 2) {
            const bool last = (t == nt - 2);
            const char* a1 = cA + (size_t)(t + 1) * kstep;
            const char* a2 = last ? nA : cA + (size_t)(t + 2) * kstep; const char* b2 = last ? nB : cB + (size_t)(t + 2) * kstep;
            const char* a3 = a2 + kstep; const char* b3 = b2 + kstep;
            if (last && has_next) S.a_ready(nxt);
            if constexpr (SP2) {
            PG8_LDB(B0, 0, 0); PG8_LDB(B1, 0, 1); PG8_SCHED; PG8_LDA(At, 0, 0); PG8_STAGE(PG8_SA(1, 1), a1 + hstep, voffA);
            PG8_WAIT_V(8); PG8_WAIT_L(0); PG8_BAR; PG8_MMA(0, 0, At, B0); PG8_MMA(0, 1, At, B1); PG8_BAR; PG8_SCHED;
            PG8_LDA(At, 0, 1); PG8_STAGE(PG8_SB(0, 0), b2, voffB); PG8_STAGE(PG8_SB(0, 1), b2 + hstep, voffB); PG8_STAGE(PG8_SA(0, 0), a2, voffA);
            PG8_WAIT_V(8); PG8_WAIT_L(0); PG8_BAR; PG8_MMA(1, 0, At, B0); PG8_MMA(1, 1, At, B1); PG8_BAR; PG8_SCHED;
            PG8_LDB(B0, 1, 0); PG8_LDB(B1, 1, 1); PG8_SCHED; PG8_LDA(At, 1, 0); PG8_STAGE(PG8_SA(0, 1), a2 + hstep, voffA);
            PG8_WAIT_V(8); PG8_WAIT_L(0); PG8_BAR; PG8_MMA(0, 0, At, B0); PG8_MMA(0, 1, At, B1); PG8_BAR; PG8_SCHED;
            PG8_LDA(At, 1, 1); PG8_STAGE(PG8_SB(1, 0), b3, voffB); PG8_STAGE(PG8_SB(1, 1), b3 + hstep, voffB); PG8_STAGE(PG8_SA(1, 0), a3, voffA);
            PG8_WAIT_V(8); PG8_WAIT_L(0); PG8_BAR; PG8_MMA(1, 0, At, B0); PG8_MMA(1, 1, At, B1); PG8_BAR; PG8_SCHED;
            } else {
            PG8_LDB(B0, 0, 0); PG8_SCHED; PG8_LDA(At, 0, 0); PG8_STAGE(PG8_SA(1, 1), a1 + hstep, voffA);
            PG8_WAIT_L(8); PG8_BAR; PG8_WAIT_L(0); PG8_MMA(0, 0, At, B0); PG8_BAR; PG8_SCHED;
            PG8_LDB(B1, 0, 1); PG8_STAGE(PG8_SB(0, 0), b2, voffB);
            PG8_BAR; PG8_WAIT_L(0); PG8_MMA(0, 1, At, B1); PG8_BAR;
            PG8_LDA(At, 0, 1); PG8_STAGE(PG8_SA(0, 0), a2, voffA);
            PG8_BAR; PG8_WAIT_L(0); PG8_MMA(1, 0, At, B0); PG8_BAR; PG8_SCHED;
            PG8_STAGE(PG8_SB(0, 1), b2 + hstep, voffB);
            PG8_WAIT_V(6); PG8_BAR; PG8_MMA(1, 1, At, B1); PG8_BAR;
            PG8_LDB(B0, 1, 0); PG8_SCHED; PG8_LDA(At, 1, 0); PG8_STAGE(PG8_SA(0, 1), a2 + hstep, voffA);
            PG8_WAIT_L(8); PG8_BAR; PG8_WAIT_L(0); PG8_MMA(0, 0, At, B0); PG8_BAR; PG8_SCHED;
            PG8_LDB(B1, 1, 1); PG8_STAGE(PG8_SB(1, 0), b3, voffB);
            PG8_BAR; PG8_WAIT_L(0); PG8_MMA(0, 1, At, B1); PG8_BAR;
            PG8_LDA(At, 1, 1); PG8_STAGE(PG8_SA(1, 0), a3, voffA);
            PG8_BAR; PG8_WAIT_L(0); PG8_MMA(1, 0, At, B0); PG8_BAR; PG8_SCHED;
            PG8_STAGE(PG8_SB(1, 1), b3 + hstep, voffB);
            PG8_WAIT_V(6); PG8_BAR; PG8_MMA(1, 1, At, B1); PG8_BAR;
            }
        }
        if constexpr (ALIGN_EPI) { if (wr == 0) PG8_BAR; }
        if constexpr (!Epi::AFTER_DRAIN) { E(acc, cur, wr, wc, fr, fq); S.done(cur); }
        if (!has_next) break;
#pragma unroll
        for (int a = 0; a < 2; ++a)
#pragma unroll
            for (int b = 0; b < 2; ++b)
#pragma unroll
                for (int m = 0; m < 4; ++m)
#pragma unroll
                    for (int n = 0; n < 2; ++n) acc[a][b][m][n] = (f32x4){0.f, 0.f, 0.f, 0.f};
        cur = nxt; cA = nA; cB = nB; ++ui;
        if constexpr (ALIGN_EPI) { if (wr == 1) PG8_BAR; }
    }
    PG8_WAIT_V(0);
    if constexpr (!ALIGN_EPI) { if (wr == 0) PG8_BAR; }
    PG8_BAR;
    if constexpr (Epi::AFTER_DRAIN) { E.fused(acc, cur, wr, wc, fr, fq, lds, wid, lane); S.done(cur); }
#undef PG8_SA
#undef PG8_SB
#undef PG8_STAGE
#undef PG8_LDA
#undef PG8_LDB
#undef PG8_MMA
#undef PG8_WAIT_V
#undef PG8_WAIT_L
#undef PG8_BAR
#undef PG8_SCHED
}
}

#define LAS __attribute__((address_space(3)))
typedef unsigned short bf16;
typedef short bf16x8 __attribute__((ext_vector_type(8)));
typedef float f32x4 __attribute__((ext_vector_type(4)));
typedef unsigned u32x4 __attribute__((ext_vector_type(4)));
typedef unsigned u32x2 __attribute__((ext_vector_type(2)));
constexpr int NWAVES = 8, NTHR = 512;
constexpr int D = 2048, M = 16384, DEPTH = 4, NMEM = 256, MMEM = 512;
constexpr int MIXW = 1536, XAW = 512, DFF = 5632;
constexpr int HG_IN = 6656, GL_IN_SRC = 5136, GL_IN = 5888;
constexpr float EPS = 1e-6f;
constexpr size_t MiB = 1u << 20;
constexpr size_t WS_WT = 0;
constexpr size_t WT_LAYER = 100 * MiB;
constexpr size_t WS_WTK = 400 * MiB, WS_WTV = 408 * MiB, WS_MEMN = 416 * MiB, WS_MEMK = 418 * MiB, WS_MEMVT = 420 * MiB;
constexpr size_t WS_BAR = 422 * MiB, WS_DEC = 423 * MiB, WS_H = 426 * MiB, WS_HB = 554 * MiB, WS_CAT = 618 * MiB, WS_PROJ = 682 * MiB, WS_US = 890 * MiB, WS_SSQ2 = 1034 * MiB, WS_VTG = 1054 * MiB, WS_END = 1102 * MiB;
constexpr int LDS_BYTES = 144 * 1024, LDS_CTL = 143 * 1024;

struct Args {
    const float *x, *mem, *norm_mix, *norm_ffn, *norm_mem, *norm_final, *hgrn_w_in, *hgrn_lb, *hgrn_onorm, *gla_w_in, *gla_w_gk, *gla_b_gk, *gla_onorm, *w_mem_kv, *w_out, *w_gate_up, *w_down;
    float* out; unsigned char* ws;
};

__device__ __forceinline__ float bf2f(unsigned b) { return __uint_as_float(b << 16); }
__device__ __forceinline__ float bflo(unsigned w) { return __uint_as_float(w << 16); }
__device__ __forceinline__ float bfhi(unsigned w) { return __uint_as_float(w & 0xffff0000u); }
__device__ __forceinline__ unsigned pk2(float lo, float hi) { return pg8::cvt_pk_bf16(lo, hi); }
__device__ __forceinline__ float fexp(float x) { return __builtin_amdgcn_exp2f(1.44269504f * x); }
__device__ __forceinline__ float flog(float x) { return 0.69314718f * __builtin_amdgcn_logf(x); }
__device__ __forceinline__ float fsigm(float x) { return __builtin_amdgcn_rcpf(1.0f + fexp(-x)); }
__device__ __forceinline__ float wave_sum(float v) {
#pragma unroll
    for (int o = 1; o < 64; o <<= 1) v += __shfl_xor(v, o);
    return v;
}
#define LDS_WAIT() asm volatile("s_waitcnt lgkmcnt(0)" ::: "memory")

__device__ __forceinline__ int map_col(int mt, int nd) {
    if (mt == 0) return nd;
    if (mt == 1) return nd < 4608 ? nd : (nd < 5120 ? nd + 16 : -1);
    const int pn = nd >> 8, bj = (nd >> 7) & 1, c = nd & 127; return bj * DFF + 128 * pn + c;
}
__device__ __forceinline__ void conv_item(const float* W, int Nsrc, int K, bf16* WT, const float* gain, int mt, const float* wgk, int item, int nblk, LAS float* scr, int lane) {
    const int kb = item / nblk, nb = item % nblk, k0 = 64 * kb, n0 = 32 * nb;
    const int sc = map_col(mt, n0 + (lane & 31));
    float v[32];
    if (mt == 1 && n0 >= 5120) {
        float wz[16];
#pragma unroll
        for (int r = 0; r < 16; ++r) wz[r] = wgk[r * 768 + (n0 - 5120) + (lane & 31)];
#pragma unroll 4
        for (int i = 0; i < 32; ++i) { const int kk = 2 * i + (lane >> 5); const f32x4* wr = (const f32x4*)(W + (size_t)(k0 + kk) * Nsrc + 4608); float z = 0.f;
#pragma unroll
            for (int q = 0; q < 4; ++q) { const f32x4 w4 = wr[q]; z += w4[0] * wz[4 * q] + w4[1] * wz[4 * q + 1] + w4[2] * wz[4 * q + 2] + w4[3] * wz[4 * q + 3]; }
            v[i] = z; }
    } else {
#pragma unroll
        for (int i = 0; i < 32; ++i) { const int kk = 2 * i + (lane >> 5); v[i] = sc >= 0 ? W[(size_t)(k0 + kk) * Nsrc + sc] : 0.f; }
    }
    if (gain) {
#pragma unroll
        for (int i = 0; i < 32; ++i) v[i] *= gain[k0 + 2 * i + (lane >> 5)];
    }
#pragma unroll
    for (int i = 0; i < 32; ++i) scr[(2 * i + (lane >> 5)) * 33 + (lane & 31)] = v[i];
    LDS_WAIT(); asm volatile("" ::: "memory");
    const int c = lane & 7;
#pragma unroll
    for (int j = 0; j < 4; ++j) { const int n = (lane >> 3) + 8 * j; const LAS float* s = scr + (8 * c) * 33 + n;
        u32x4 o; o.x = pk2(s[0 * 33], s[1 * 33]); o.y = pk2(s[2 * 33], s[3 * 33]); o.z = pk2(s[4 * 33], s[5 * 33]); o.w = pk2(s[6 * 33], s[7 * 33]);
        *(u32x4*)(WT + (size_t)(n0 + n) * K + k0 + 8 * c) = o; }
    LDS_WAIT(); asm volatile("" ::: "memory");
}
__device__ __forceinline__ void conv_matrix(const float* W, int Nsrc, int K, int Ndst, bf16* WT, const float* gain, int mt, LAS float* scr, int lane, int& gw, int NGW, const float* wgk = nullptr) {
    const int nblk = Ndst / 32, nitems = (K / 64) * nblk;
    for (int it = gw; it < nitems; it += NGW) conv_item(W, Nsrc, K, WT, gain, mt, wgk, it, nblk, scr, lane);
    gw -= nitems % NGW; if (gw < 0) gw += NGW;
}
__device__ __forceinline__ bf16* wt_in(unsigned char* ws, int l) { return (bf16*)(ws + WS_WT + (size_t)l * WT_LAYER); }
__device__ __forceinline__ int n_in(int l) { return (l & 1) ? GL_IN : HG_IN; }
__device__ __forceinline__ bf16* wt_out(unsigned char* ws, int l) { return wt_in(ws, l) + (size_t)n_in(l) * D; }
__device__ __forceinline__ bf16* wt_gu(unsigned char* ws, int l) { return wt_out(ws, l) + (size_t)D * D; }
__device__ __forceinline__ bf16* wt_down(unsigned char* ws, int l) { return wt_gu(ws, l) + (size_t)2 * DFF * D; }

__device__ __forceinline__ void p0_prologue(const Args& a, LAS unsigned char* lds, int tid, int lane, int wave) {
    LAS float* scr = (LAS float*)(lds + wave * 8704);
    const int G = gridDim.x, gw0 = blockIdx.x * NWAVES + wave, NGW = G * NWAVES; int gw = gw0;
    unsigned char* ws = a.ws;
    for (int m = gw0; m < MMEM; m += NGW) {
        const f32x4* xr = (const f32x4*)(a.mem + (size_t)m * D) + lane; const f32x4* gr = (const f32x4*)a.norm_mem + lane; u32x2* o = (u32x2*)((bf16*)(ws + WS_MEMN) + (size_t)m * D) + lane;
        f32x4 v[8]; float s = 0.f;
#pragma unroll
        for (int j = 0; j < 8; ++j) { v[j] = xr[64 * j]; s += (v[j].x * v[j].x + v[j].y * v[j].y) + (v[j].z * v[j].z + v[j].w * v[j].w); }
        const float r = rsqrtf(wave_sum(s) * (1.0f / D) + EPS);
#pragma unroll
        for (int j = 0; j < 8; ++j) { const f32x4 g = gr[64 * j]; u32x2 w; w.x = pk2(v[j].x * r * g.x, v[j].y * r * g.y); w.y = pk2(v[j].z * r * g.z, v[j].w * r * g.w); o[64 * j] = w; }
    }
    for (int l = DEPTH - 1; l >= 0; --l) {
        const int j = l >> 1;
        if (l & 1) conv_matrix(a.gla_w_in + (size_t)j * D * GL_IN_SRC, GL_IN_SRC, D, GL_IN, wt_in(ws, l), a.norm_mix + l * D, 1, scr, lane, gw, NGW, a.gla_w_gk + (size_t)j * 16 * 768);
        else       conv_matrix(a.hgrn_w_in + (size_t)j * D * HG_IN, HG_IN, D, HG_IN, wt_in(ws, l), a.norm_mix + l * D, 0, scr, lane, gw, NGW);
        conv_matrix(a.w_out + (size_t)l * D * D, D, D, D, wt_out(ws, l), nullptr, 0, scr, lane, gw, NGW);
        conv_matrix(a.w_gate_up + (size_t)l * D * 2 * DFF, 2 * DFF, D, 2 * DFF, wt_gu(ws, l), a.norm_ffn + l * D, 2, scr, lane, gw, NGW);
        conv_matrix(a.w_down + (size_t)l * DFF * D, D, DFF, D, wt_down(ws, l), nullptr, 0, scr, lane, gw, NGW);
        conv_matrix(a.w_mem_kv + (size_t)l * D * 2 * XAW, 2 * XAW, D, XAW, (bf16*)(ws + WS_WTK) + (size_t)l * XAW * D, nullptr, 0, scr, lane, gw, NGW);
        conv_matrix(a.w_mem_kv + (size_t)l * D * 2 * XAW + XAW, 2 * XAW, D, XAW, (bf16*)(ws + WS_WTV) + (size_t)l * XAW * D, nullptr, 0, scr, lane, gw, NGW);
    }
    for (int m = gw0; m < M; m += NGW) {
        const f32x4* xr = (const f32x4*)(a.x + (size_t)m * D) + lane; u32x2* hb = (u32x2*)((bf16*)(ws + WS_HB) + (size_t)m * D) + lane;
        f32x4 v[8]; float s = 0.f;
#pragma unroll
        for (int j = 0; j < 8; ++j) v[j] = xr[64 * j];
#pragma unroll
        for (int j = 0; j < 8; ++j) { s += (v[j].x * v[j].x + v[j].y * v[j].y) + (v[j].z * v[j].z + v[j].w * v[j].w); u32x2 w; w.x = pk2(v[j].x, v[j].y); w.y = pk2(v[j].z, v[j].w); hb[64 * j] = w; }
        s = wave_sum(s); if (lane < 32) ((float*)(ws + WS_SSQ2))[(size_t)m * 32 + lane] = lane == 0 ? s : 0.f;
    }
}
template <bool HG> struct MC {
    static constexpr int DK = HG ? 128 : 192, DV = HG ? 128 : 384, NH = HG ? 12 : 4, NS = DV / 128, LD = HG ? HG_IN : GL_IN;
    static constexpr int QOFF = 0, KOFF = HG ? 1536 : 768, VOFF = HG ? 3072 : 1536, GOFF = HG ? 4608 : 3072, XQOFF = HG ? 6144 : 4608, ZOFF = 5120;
    static constexpr int RS = DK * 2 + 16;
    static constexpr int TS = 144;
};
struct MixP { const bf16* proj; bf16* vtg; bf16* us; float* dec; bf16* cat; const float* lb; const float* wgk; const float* bgk; const float* onorm; int j; };

__device__ __forceinline__ float hgrn_lb(const MixP& p, int col) {
    if (p.j == 0) return 0.f;
    return fsigm(p.lb[MIXW + col] - p.lb[col]);
}
__device__ __forceinline__ float gla_la(const LAS float* g, const float (&w)[16], float bb) {
    float z = bb;
#pragma unroll
    for (int r = 0; r < 16; ++r) z += g[r] * w[r];
    return (fminf(z, 0.f) - flog(1.0f + fexp(-fabsf(z)))) * (1.0f / 16.0f);
}
__device__ __forceinline__ float gla_lz(float z) { return flog(1.0f + fexp(-fmaxf(z, -60.f))) * (-1.0f / 16.0f); }
__device__ __forceinline__ void hg_gate(float x, float lb, float omlb, bool haslb, float& la, float& k) {
    const float e = fexp(-fmaxf(x, -60.f)), s1 = 1.0f + e; la = -flog(s1); if (haslb) la += flog(1.0f + lb * e); k = omlb * e * __builtin_amdgcn_rcpf(s1);
}
template <bool HG> __device__ __forceinline__ void load_gkl(const MixP& p, LAS float* gkl, int row0, int tid) {
    if (!HG) { const int idx = tid * 2, t = idx >> 4, r = idx & 15; const unsigned w = *(const unsigned*)(p.proj + (size_t)(row0 + t) * MC<HG>::LD + MC<HG>::GKOFF + r); gkl[idx] = bflo(w); gkl[idx + 1] = bfhi(w); }
}


template <bool HG> __device__ __forceinline__ void gate8(const LAS bf16* src, int stride, float bb, float lb, float omlb, bool haslb, float (&la)[8], float (&k)[8]) {
    float x[8], e[8], s1[8], l1[8];
#pragma unroll
    for (int j = 0; j < 8; ++j) x[j] = bf2f(src[j * stride]);
#pragma unroll
    for (int j = 0; j < 8; ++j) x[j] = -1.44269504f * fmaxf(x[j] + bb, -60.f);
#pragma unroll
    for (int j = 0; j < 8; ++j) e[j] = __builtin_amdgcn_exp2f(x[j]);
#pragma unroll
    for (int j = 0; j < 8; ++j) s1[j] = 1.0f + e[j];
#pragma unroll
    for (int j = 0; j < 8; ++j) l1[j] = __builtin_amdgcn_logf(s1[j]);
    if (HG) {
        float r[8], l2[8];
#pragma unroll
        for (int j = 0; j < 8; ++j) r[j] = __builtin_amdgcn_rcpf(s1[j]);
        if (haslb) {
#pragma unroll
            for (int j = 0; j < 8; ++j) l2[j] = __builtin_amdgcn_logf(1.0f + lb * e[j]);
        } else {
#pragma unroll
            for (int j = 0; j < 8; ++j) l2[j] = 0.f;
        }
#pragma unroll
        for (int j = 0; j < 8; ++j) { la[j] = 0.69314718f * (l2[j] - l1[j]); k[j] = omlb * e[j] * r[j]; }
    } else {
#pragma unroll
        for (int j = 0; j < 8; ++j) { la[j] = (-0.69314718f / 16.0f) * l1[j]; k[j] = 0.f; }
    }
}
template <bool HG> struct MixPar { float w[2]; };
template <bool HG> __device__ __forceinline__ void par_load(const MixP& p, int h, int tid, MixPar<HG>& q) {
    if (HG) { const int col = h * 128 + (tid & 127); q.w[0] = p.lb[col]; q.w[1] = p.lb[MIXW + col]; }
    else { q.w[0] = p.bgk[h * 192 + (tid % 192)]; q.w[1] = 0.f; }
}
template <bool HG> struct M1Raw { u32x4 k[HG ? 2 : 3]; u32x4 z[HG ? 1 : 3]; u32x4 v[2]; MixPar<HG> par; };
template <bool HG> __device__ __forceinline__ void m1_load(const MixP& p, int item, int tid, M1Raw<HG>& r) {
    typedef MC<HG> C; constexpr int DK = C::DK, LD = C::LD, CK = DK / 8;
    const int c = item / 12, hs = item % 12, h = hs / C::NS, s = hs % C::NS, row0 = c * 64;
    par_load<HG>(p, h, tid, r.par);
#pragma unroll
    for (int i = 0; i < (HG ? 2 : 3); ++i) { const int ci = tid + NTHR * i, row = ci / CK, cj = ci % CK; r.k[i] = *(const u32x4*)(p.proj + (size_t)(row0 + row) * LD + C::KOFF + h * DK + cj * 8);
        if (!HG) r.z[i] = *(const u32x4*)(p.proj + (size_t)(row0 + row) * LD + C::ZOFF + h * DK + cj * 8); }
#pragma unroll
    for (int i = 0; i < 2; ++i) { const int ci = tid + NTHR * i, row = ci >> 4, cj = ci & 15; r.v[i] = *(const u32x4*)(p.proj + (size_t)(row0 + row) * LD + C::VOFF + h * C::DV + s * 128 + cj * 8); }
}
__device__ __forceinline__ void gkl_store(LAS float* gkl, int tid, const u32x4& g) {
    if (tid < 128) { LAS f32x4* o = (LAS f32x4*)(gkl + (tid >> 1) * 16 + (tid & 1) * 8);
        o[0] = (f32x4){bflo(g.x), bfhi(g.x), bflo(g.y), bfhi(g.y)}; o[1] = (f32x4){bflo(g.z), bfhi(g.z), bflo(g.w), bfhi(g.w)}; }
}
template <bool HG> __device__ __forceinline__ void m1_item(const MixP& p, LAS unsigned char* lds, int item, int nxt, M1Raw<HG>& r, int tid, int lane, int wave) {
    typedef MC<HG> C; constexpr int DK = C::DK, TS = C::TS, CK = DK / 8, RKS = DK * 2 + 16, RVS = 272, NSEG = HG ? 4 : 2, NT = 64 / NSEG;
    const int c = item / 12, hs = item % 12, h = hs / C::NS, s = hs % C::NS;
    constexpr int KDT_OFF = 0, VT_OFF = DK * TS, RAWK_OFF = VT_OFF + 128 * TS, RAWV_OFF = RAWK_OFF + 64 * RKS, RAWZ_OFF = RAWV_OFF + 64 * RVS, TOT_OFF = RAWZ_OFF + (HG ? 0 : 64 * RKS);
    static_assert(TOT_OFF + 4 * 4 * DK <= 140 * 1024 && 128 * RKS <= RAWZ_OFF - RAWK_OFF + (HG ? 0 : 64 * RKS), "M1 LDS");
    LAS unsigned char* KDT = lds + KDT_OFF; LAS unsigned char* VT = lds + VT_OFF; LAS float* tot = (LAS float*)(lds + TOT_OFF);
#pragma unroll
    for (int i = 0; i < (HG ? 2 : 3); ++i) { const int ci = tid + NTHR * i, row = ci / CK, cj = ci % CK; *(LAS u32x4*)(lds + RAWK_OFF + row * RKS + cj * 16) = r.k[i]; if (!HG) *(LAS u32x4*)(lds + RAWZ_OFF + row * RKS + cj * 16) = r.z[i]; }
#pragma unroll
    for (int i = 0; i < 2; ++i) { const int ci = tid + NTHR * i, row = ci >> 4, cj = ci & 15; *(LAS u32x4*)(lds + RAWV_OFF + row * RVS + cj * 16) = r.v[i]; }
    float lb = 0.f, omlb = 1.f, bb = 0.f;
    if (HG) { lb = p.j == 0 ? 0.f : fsigm(r.par.w[1] - r.par.w[0]); omlb = 1.0f - lb; } else bb = r.par.w[0];
    __syncthreads();
    if (nxt >= 0) m1_load<HG>(p, nxt, tid, r);
    const int d = HG ? (tid & 127) : (tid % 192), seg = HG ? (tid >> 7) : (tid / 192), t0 = seg * NT;
    const bool act = seg < NSEG;
    const LAS bf16* rk = (const LAS bf16*)(lds + RAWK_OFF) + d; const LAS bf16* rz = (const LAS bf16*)(lds + RAWZ_OFF) + d;
    float la_[NT / 8][8], k_[NT / 8][8]; const bool haslb = p.j != 0;
    if (act) { float tsum = 0.f;
#pragma unroll
        for (int i8 = 0; i8 < NT / 8; ++i8) { gate8<HG>((HG ? rk : rz) + (t0 + i8 * 8) * (RKS / 2), RKS / 2, bb, lb, omlb, haslb, la_[i8], k_[i8]);
#pragma unroll
            for (int j = 0; j < 8; ++j) tsum += la_[i8][j]; }
        tot[seg * DK + d] = tsum; }
    __syncthreads();
    if (act) { float rc = 0.f;
#pragma unroll
        for (int q = 0; q < NSEG; ++q) if (q > seg) rc += tot[q * DK + d];
#pragma unroll
        for (int i8 = NT / 8 - 1; i8 >= 0; --i8) { float kd[8], rcv[8], kk[8];
#pragma unroll
            for (int j = 0; j < 8; ++j) kk[j] = HG ? k_[i8][j] : bf2f(rk[(t0 + i8 * 8 + j) * (RKS / 2)]);
#pragma unroll
            for (int j = 7; j >= 0; --j) { rcv[j] = 1.44269504f * rc; rc += la_[i8][j]; }
#pragma unroll
            for (int j = 0; j < 8; ++j) rcv[j] = __builtin_amdgcn_exp2f(rcv[j]);
#pragma unroll
            for (int j = 0; j < 8; ++j) kd[j] = kk[j] * rcv[j];
            u32x4 w; w.x = pk2(kd[0], kd[1]); w.y = pk2(kd[2], kd[3]); w.z = pk2(kd[4], kd[5]); w.w = pk2(kd[6], kd[7]);
            *(LAS u32x4*)(KDT + d * TS + (t0 + i8 * 8) * 2) = w; }
        if (seg == 0 && s == 0) p.dec[((size_t)c * C::NH + h) * DK + d] = fexp(rc); }
    {
        const int e = tid & 127, tv = (tid >> 7) * 16; const LAS bf16* rv = (const LAS bf16*)(lds + RAWV_OFF) + e; unsigned xs[16];
#pragma unroll
        for (int i = 0; i < 16; ++i) xs[i] = rv[(tv + i) * (RVS / 2)];
#pragma unroll
        for (int q = 0; q < 2; ++q) { u32x4 w; w.x = xs[q * 8] | (xs[q * 8 + 1] << 16); w.y = xs[q * 8 + 2] | (xs[q * 8 + 3] << 16); w.z = xs[q * 8 + 4] | (xs[q * 8 + 5] << 16); w.w = xs[q * 8 + 6] | (xs[q * 8 + 7] << 16);
            *(LAS u32x4*)(VT + e * TS + (tv + q * 8) * 2) = w; }
    }
    __syncthreads();
    {
        const int fr = lane & 15, g = lane >> 4, eb = wave;
        f32x4 acc[DK / 16];
#pragma unroll
        for (int db = 0; db < DK / 16; ++db) acc[db] = (f32x4){0.f, 0.f, 0.f, 0.f};
#pragma unroll
        for (int ks = 0; ks < 2; ++ks) {
            const bf16x8 bfr = *(const LAS bf16x8*)(VT + (16 * eb + fr) * TS + ks * 64 + g * 16);
#pragma unroll
            for (int db = 0; db < DK / 16; ++db) { const bf16x8 afr = *(const LAS bf16x8*)(KDT + (16 * db + fr) * TS + ks * 64 + g * 16);
                acc[db] = __builtin_amdgcn_mfma_f32_16x16x32_bf16(afr, bfr, acc[db], 0, 0, 0); }
        }
        LAS unsigned char* ut = lds + RAWK_OFF + (16 * eb + fr) * RKS + 8 * g;
#pragma unroll
        for (int db = 0; db < DK / 16; ++db) { u32x2 w; w.x = pk2(acc[db][0], acc[db][1]); w.y = pk2(acc[db][2], acc[db][3]); *(LAS u32x2*)(ut + 32 * db) = w; }
        bf16* vt = p.vtg + ((size_t)c * 12 + hs) * 128 * 64;
#pragma unroll
        for (int i = 0; i < 2; ++i) { const int ci = tid + NTHR * i, e = ci >> 3, part = ci & 7; *(u32x4*)(vt + e * 64 + part * 8) = *(const LAS u32x4*)(VT + e * TS + part * 16); }
    }
    __syncthreads();
    { bf16* ug = p.us + ((size_t)c * 12 + hs) * 128 * DK;
#pragma unroll
        for (int i = 0; i < DK / 32; ++i) { const int ci = tid + NTHR * i, e = ci / CK, cj = ci % CK; *(u32x4*)(ug + (size_t)e * DK + cj * 8) = *(const LAS u32x4*)(lds + RAWK_OFF + e * RKS + cj * 16); } }
    __syncthreads();
}

template <bool HG> __device__ __forceinline__ void m2_scan(const MixP& p, int gtid, int gthreads) {
    typedef MC<HG> C; constexpr int DK = C::DK, D8 = DK / 8, NIT = 2 * 12 * 128 * D8;
    const int nblk = gthreads / NTHR, per = ((NIT + nblk - 1) / nblk + 63) & ~63, bidx = gtid / NTHR, lt = gtid % NTHR;
    for (int it = bidx * per + lt; lt < per && it < NIT; it += NIT) {
        const int d8 = it % D8, e = (it / D8) % 128, hs = (it / (D8 * 128)) % 12, b = it / (D8 * 128 * 12), h = hs / C::NS;
        bf16* up = p.us + (((size_t)(b * 128) * 12 + hs) * 128 + e) * DK + d8 * 8; const size_t ustr = (size_t)12 * 128 * DK;
        const float* dp = p.dec + ((size_t)(b * 128) * C::NH + h) * DK + d8 * 8; const size_t dstr = (size_t)C::NH * DK;
        float S[8];
#pragma unroll
        for (int i = 0; i < 8; ++i) S[i] = 0.f;
        for (int n0 = 0; n0 < 128; n0 += 8) {
            u32x4 u[8]; f32x4 d0[8], d1[8];
#pragma unroll
            for (int k = 0; k < 8; ++k) { u[k] = *(const u32x4*)(up + (size_t)(n0 + k) * ustr); d0[k] = *(const f32x4*)(dp + (size_t)(n0 + k) * dstr); d1[k] = *(const f32x4*)(dp + (size_t)(n0 + k) * dstr + 4); }
#pragma unroll
            for (int k = 0; k < 8; ++k) {
                u32x4 w; w.x = pk2(S[0], S[1]); w.y = pk2(S[2], S[3]); w.z = pk2(S[4], S[5]); w.w = pk2(S[6], S[7]);
                *(u32x4*)(up + (size_t)(n0 + k) * ustr) = w;
                S[0] = d0[k].x * S[0] + bflo(u[k].x); S[1] = d0[k].y * S[1] + bfhi(u[k].x); S[2] = d0[k].z * S[2] + bflo(u[k].y); S[3] = d0[k].w * S[3] + bfhi(u[k].y);
                S[4] = d1[k].x * S[4] + bflo(u[k].z); S[5] = d1[k].y * S[5] + bfhi(u[k].z); S[6] = d1[k].z * S[6] + bflo(u[k].w); S[7] = d1[k].w * S[7] + bfhi(u[k].w);
            }
        }
    }
}

template <bool HG> struct M3Raw { u32x4 q[HG ? 2 : 3]; u32x4 k[HG ? 2 : 3]; u32x4 z[HG ? 1 : 3]; u32x4 gt[HG ? 2 : 6]; MixPar<HG> par; };
template <bool HG> __device__ __forceinline__ void m3_load(const MixP& p, int item, int tid, M3Raw<HG>& r) {
    typedef MC<HG> C; constexpr int DK = C::DK, LD = C::LD, CK = DK / 8;
    const int c = item / C::NH, h = item % C::NH, row0 = c * 64;
    par_load<HG>(p, h, tid, r.par);
#pragma unroll
    for (int i = 0; i < (HG ? 2 : 3); ++i) { const int ci = tid + NTHR * i, row = ci / CK, cj = ci % CK; const bf16* b = p.proj + (size_t)(row0 + row) * LD + h * DK + cj * 8;
        r.q[i] = *(const u32x4*)(b + C::QOFF); r.k[i] = *(const u32x4*)(b + C::KOFF); if (!HG) r.z[i] = *(const u32x4*)(b + C::ZOFF); }
#pragma unroll
    for (int i = 0; i < (HG ? 2 : 6); ++i) { constexpr int CG = C::DV / 8; const int ci = tid + NTHR * i, row = ci / CG, cj = ci % CG; r.gt[i] = *(const u32x4*)(p.proj + (size_t)(row0 + row) * LD + C::GOFF + h * C::DV + cj * 8); }
}
template <bool HG> __device__ __forceinline__ void m3_item(const MixP& p, LAS unsigned char* lds, int item, int nxt, M3Raw<HG>& r, int tid, int lane, int wave) {
    typedef MC<HG> C; constexpr int DK = C::DK, DV = C::DV, LD = C::LD, TS = C::TS, RS = C::RS, NS = C::NS, CK = DK / 8, NSEG = HG ? 4 : 2, NT = 64 / NSEG;
    const int c = item / C::NH, h = item % C::NH, row0 = c * 64;
    constexpr int QI_OFF = 0, KP_OFF = 64 * RS, QP_OFF = HG ? 2 * 64 * RS : 0, P_OFF = (HG ? 3 : 2) * 64 * RS, RED_OFF = P_OFF + 64 * TS, ZR_OFF = RED_OFF + 2048, TOT_OFF = ZR_OFF + (HG ? 0 : 64 * RS), G_OFF = TOT_OFF + 4 * 4 * DK, GS = DV * 2 + 16, CG = DV / 8;
    static_assert(G_OFF + 64 * GS <= 142 * 1024, "M3 LDS");
    LAS float* tot = (LAS float*)(lds + TOT_OFF);
#pragma unroll
    for (int i = 0; i < (HG ? 2 : 3); ++i) { const int ci = tid + NTHR * i, row = ci / CK, cj = ci % CK; *(LAS u32x4*)(lds + QI_OFF + row * RS + cj * 16) = r.q[i]; *(LAS u32x4*)(lds + KP_OFF + row * RS + cj * 16) = r.k[i]; if (!HG) *(LAS u32x4*)(lds + ZR_OFF + row * RS + cj * 16) = r.z[i]; }
#pragma unroll
    for (int i = 0; i < (HG ? 2 : 6); ++i) { const int ci = tid + NTHR * i, row = ci / CG, cj = ci % CG; *(LAS u32x4*)(lds + G_OFF + row * GS + cj * 16) = r.gt[i]; }
    float lb = 0.f, omlb = 1.f, bb = 0.f;
    if (HG) { lb = p.j == 0 ? 0.f : fsigm(r.par.w[1] - r.par.w[0]); omlb = 1.0f - lb; } else bb = r.par.w[0];
    __syncthreads();
    const int fr = lane & 15, g = lane >> 4;
    bf16x8 sfr[NS][DK / 32], vfr[NS][2];
    if (HG)
#pragma unroll
    for (int x = 0; x < NS; ++x) { const int ea = 16 * (wave * NS + x) + fr, sl = ea >> 7, ei = ea & 127;
#pragma unroll
        for (int ks = 0; ks < DK / 32; ++ks) sfr[x][ks] = *(const bf16x8*)(p.us + (((size_t)c * 12 + h * NS + sl) * 128 + ei) * DK + ks * 32 + g * 8);
#pragma unroll
        for (int ks = 0; ks < 2; ++ks) vfr[x][ks] = *(const bf16x8*)(p.vtg + (((size_t)c * 12 + h * NS + sl) * 128 + ei) * 64 + ks * 32 + g * 8); }
    if (nxt >= 0) m3_load<HG>(p, nxt, tid, r);
    {
        const int d = HG ? (tid & 127) : (tid % 192), seg = HG ? (tid >> 7) : (tid / 192), t0 = seg * NT;
        const bool act = seg < NSEG;
        LAS bf16* qi = (LAS bf16*)(lds + QI_OFF) + d; LAS bf16* kp = (LAS bf16*)(lds + KP_OFF) + d; LAS bf16* qp = (LAS bf16*)(lds + QP_OFF) + d; const LAS bf16* zr = (const LAS bf16*)(lds + ZR_OFF) + d;
        float la_[NT / 8][8], k_[NT / 8][8]; const bool haslb = p.j != 0;
        if (act) { float tsum = 0.f;
#pragma unroll
            for (int i8 = 0; i8 < NT / 8; ++i8) { gate8<HG>((HG ? (const LAS bf16*)kp : zr) + (t0 + i8 * 8) * (RS / 2), RS / 2, bb, lb, omlb, haslb, la_[i8], k_[i8]);
#pragma unroll
                for (int j = 0; j < 8; ++j) tsum += la_[i8][j]; }
            tot[seg * DK + d] = tsum; }
        __syncthreads();
        if (act) { float cum = 0.f;
#pragma unroll
            for (int q = 0; q < NSEG; ++q) if (q < seg) cum += tot[q * DK + d];
            const float cm = HG ? tot[d] + tot[DK + d] : 0.f, ecm = HG ? fexp(cm) : 1.0f;
#pragma unroll
            for (int i8 = 0; i8 < NT / 8; ++i8) { const int tb0 = (t0 + i8 * 8) * (RS / 2);
                float qx[8], kx[8], cv[8], e1[8], e2[8];
#pragma unroll
                for (int j = 0; j < 8; ++j) qx[j] = bf2f(qi[tb0 + j * (RS / 2)]);
#pragma unroll
                for (int j = 0; j < 8; ++j) kx[j] = HG ? k_[i8][j] : bf2f(kp[tb0 + j * (RS / 2)]);
#pragma unroll
                for (int j = 0; j < 8; ++j) { cum += la_[i8][j]; cv[j] = 1.44269504f * (cum - cm); }
#pragma unroll
                for (int j = 0; j < 8; ++j) e1[j] = __builtin_amdgcn_exp2f(cv[j]);
#pragma unroll
                for (int j = 0; j < 8; ++j) e2[j] = __builtin_amdgcn_exp2f(-cv[j]);
                if (HG) { float sg[8];
#pragma unroll
                    for (int j = 0; j < 8; ++j) sg[j] = __builtin_amdgcn_exp2f(-1.44269504f * qx[j]);
#pragma unroll
                    for (int j = 0; j < 8; ++j) sg[j] = __builtin_amdgcn_rcpf(1.0f + sg[j]);
#pragma unroll
                    for (int j = 0; j < 8; ++j) { const float qpv = qx[j] * sg[j] * e1[j];
                        qi[tb0 + j * (RS / 2)] = (bf16)(pk2(qpv * ecm, 0.f) & 0xffffu); qp[tb0 + j * (RS / 2)] = (bf16)(pk2(qpv, 0.f) & 0xffffu); kp[tb0 + j * (RS / 2)] = (bf16)(pk2(kx[j] * e2[j], 0.f) & 0xffffu); }
                } else {
#pragma unroll
                    for (int j = 0; j < 8; ++j) { qi[tb0 + j * (RS / 2)] = (bf16)(pk2(qx[j] * 0.07216878364870322f * e1[j], 0.f) & 0xffffu); kp[tb0 + j * (RS / 2)] = (bf16)(pk2(kx[j] * e2[j], 0.f) & 0xffffu); }
                }
            }
        }
    }
    __syncthreads();
#pragma unroll
    for (int x = 0; x < 2; ++x) {
        const int ti = 2 * wave + x, tb = ti >> 2, sb = ti & 3;
        f32x4 acc = (f32x4){0.f, 0.f, 0.f, 0.f};
        if (sb <= tb) {
#pragma unroll
            for (int ks = 0; ks < DK / 32; ++ks) {
                const bf16x8 afr = *(const LAS bf16x8*)(lds + KP_OFF + (16 * sb + fr) * RS + ks * 64 + g * 16);
                const bf16x8 bfr = *(const LAS bf16x8*)(lds + QP_OFF + (16 * tb + fr) * RS + ks * 64 + g * 16);
                acc = __builtin_amdgcn_mfma_f32_16x16x32_bf16(afr, bfr, acc, 0, 0, 0);
            }
            const int tt = 16 * tb + fr, s0 = 16 * sb + 4 * g;
#pragma unroll
            for (int q = 0; q < 4; ++q) if (s0 + q > tt) acc[q] = 0.f;
        }
        u32x2 w; w.x = pk2(acc[0], acc[1]); w.y = pk2(acc[2], acc[3]);
        *(LAS u32x2*)(lds + P_OFF + (16 * tb + fr) * TS + (16 * sb + 4 * g) * 2) = w;
    }
    __syncthreads();
    f32x4 acc[NS][4];
#pragma unroll
    for (int x = 0; x < NS; ++x)
#pragma unroll
        for (int tb = 0; tb < 4; ++tb) acc[x][tb] = (f32x4){0.f, 0.f, 0.f, 0.f};
#pragma unroll
    for (int ks = 0; ks < DK / 32; ++ks) {
        bf16x8 bq[4];
#pragma unroll
        for (int tb = 0; tb < 4; ++tb) bq[tb] = *(const LAS bf16x8*)(lds + QI_OFF + (16 * tb + fr) * RS + ks * 64 + g * 16);
#pragma unroll
        for (int x = 0; x < NS; ++x) {
            const int ea = 16 * (wave * NS + x) + fr, sl = ea >> 7, ei = ea & 127;
            bf16x8 afr; if (HG) afr = sfr[x][ks]; else afr = *(const bf16x8*)(p.us + (((size_t)c * 12 + h * NS + sl) * 128 + ei) * DK + ks * 32 + g * 8);
#pragma unroll
            for (int tb = 0; tb < 4; ++tb) acc[x][tb] = __builtin_amdgcn_mfma_f32_16x16x32_bf16(afr, bq[tb], acc[x][tb], 0, 0, 0);
        }
    }
#pragma unroll
    for (int ks = 0; ks < 2; ++ks) {
        bf16x8 bp[4];
#pragma unroll
        for (int tb = 0; tb < 4; ++tb) bp[tb] = *(const LAS bf16x8*)(lds + P_OFF + (16 * tb + fr) * TS + ks * 64 + g * 16);
#pragma unroll
        for (int x = 0; x < NS; ++x) {
            const int ea = 16 * (wave * NS + x) + fr, sl = ea >> 7, ei = ea & 127;
            bf16x8 afr; if (HG) afr = vfr[x][ks]; else afr = *(const bf16x8*)(p.vtg + (((size_t)c * 12 + h * NS + sl) * 128 + ei) * 64 + ks * 32 + g * 8);
#pragma unroll
            for (int tb = 0; tb < 4; ++tb) acc[x][tb] = __builtin_amdgcn_mfma_f32_16x16x32_bf16(afr, bp[tb], acc[x][tb], 0, 0, 0);
        }
    }
    LAS float* red = (LAS float*)(lds + RED_OFF);
#pragma unroll
    for (int tb = 0; tb < 4; ++tb) { float ss = 0.f;
#pragma unroll
        for (int x = 0; x < NS; ++x) ss += (acc[x][tb][0] * acc[x][tb][0] + acc[x][tb][1] * acc[x][tb][1]) + (acc[x][tb][2] * acc[x][tb][2] + acc[x][tb][3] * acc[x][tb][3]);
        ss += __shfl_xor(ss, 16); ss += __shfl_xor(ss, 32);
        if (g == 0) red[wave * 64 + 16 * tb + fr] = ss; }
    __syncthreads();
#pragma unroll
    for (int tb = 0; tb < 4; ++tb) { float tsum = 0.f;
#pragma unroll
        for (int w = 0; w < 8; ++w) tsum += red[w * 64 + 16 * tb + fr];
        const float rstd = rsqrtf(tsum * (1.0f / DV) + EPS); const int row = row0 + 16 * tb + fr;
#pragma unroll
        for (int x = 0; x < NS; ++x) { const int e0 = 16 * (wave * NS + x) + 4 * g;
            LAS u32x2* gp = (LAS u32x2*)(lds + G_OFF + (16 * tb + fr) * GS + e0 * 2); const u32x2 gw2 = *gp; const f32x4 gn = *(const f32x4*)(p.onorm + e0);
            const float g0 = bflo(gw2.x), g1 = bfhi(gw2.x), g2 = bflo(gw2.y), g3 = bfhi(gw2.y);
            const float y0 = acc[x][tb][0] * rstd * gn.x * pg8::fsilu(g0), y1 = acc[x][tb][1] * rstd * gn.y * pg8::fsilu(g1), y2 = acc[x][tb][2] * rstd * gn.z * pg8::fsilu(g2), y3 = acc[x][tb][3] * rstd * gn.w * pg8::fsilu(g3);
            u32x2 w; w.x = pk2(y0, y1); w.y = pk2(y2, y3); *gp = w; }
    }
    __syncthreads();
#pragma unroll
    for (int i = 0; i < (HG ? 2 : 6); ++i) { const int ci = tid + NTHR * i, row = ci / CG, cj = ci % CG; *(u32x4*)(p.cat + (size_t)(row0 + row) * D + h * DV + cj * 8) = *(const LAS u32x4*)(lds + G_OFF + row * GS + cj * 16); }
    __syncthreads();
}
template <bool HG> __device__ __forceinline__ void xa_item(const bf16* proj, const bf16* memk, const bf16* memvt, bf16* cat, int l, int wi, int lane) {
    typedef MC<HG> C; constexpr int LD = C::LD;
    const int tblk = wi >> 2, hd = wi & 3, fr = lane & 15, g = lane >> 4, b = tblk >> 9;
    bf16x8 qf[4];
#pragma unroll
    for (int ks = 0; ks < 4; ++ks) qf[ks] = *(const bf16x8*)(proj + (size_t)(16 * tblk + fr) * LD + C::XQOFF + hd * 128 + ks * 32 + g * 8);
    f32x4 st[16];
    const bf16* kb = memk + (size_t)(b * 256 + fr) * 2048 + l * 512 + hd * 128 + g * 8;
#pragma unroll
    for (int mb = 0; mb < 16; ++mb) { f32x4 a = (f32x4){0.f, 0.f, 0.f, 0.f};
#pragma unroll
        for (int ks = 0; ks < 4; ++ks) { const bf16x8 kf = *(const bf16x8*)(kb + (size_t)(16 * mb) * 2048 + ks * 32); a = __builtin_amdgcn_mfma_f32_16x16x32_bf16(kf, qf[ks], a, 0, 0, 0); }
        st[mb] = a; }
    float mx = -3.0e38f;
#pragma unroll
    for (int mb = 0; mb < 16; ++mb) mx = fmaxf(fmaxf(fmaxf(st[mb][0], st[mb][1]), fmaxf(st[mb][2], st[mb][3])), mx);
    mx = fmaxf(mx, __shfl_xor(mx, 16)); mx = fmaxf(mx, __shfl_xor(mx, 32));
    constexpr float SC = 0.08838834764831845f * 1.44269504f; float sum = 0.f;
#pragma unroll
    for (int mb = 0; mb < 16; ++mb)
#pragma unroll
        for (int r = 0; r < 4; ++r) { const float pz = __builtin_amdgcn_exp2f((st[mb][r] - mx) * SC); st[mb][r] = pz; sum += pz; }
    sum += __shfl_xor(sum, 16); sum += __shfl_xor(sum, 32);
    const float inv = __builtin_amdgcn_rcpf(sum);
    bf16x8 pf[8];
#pragma unroll
    for (int kk = 0; kk < 8; ++kk) { u32x4 w; w.x = pk2(st[2 * kk][0], st[2 * kk][1]); w.y = pk2(st[2 * kk][2], st[2 * kk][3]); w.z = pk2(st[2 * kk + 1][0], st[2 * kk + 1][1]); w.w = pk2(st[2 * kk + 1][2], st[2 * kk + 1][3]);
        pf[kk] = __builtin_bit_cast(bf16x8, w); }
    const bf16* vb = memvt + (size_t)(l * 512 + hd * 128 + fr) * 512 + b * 256 + 4 * g;
#pragma unroll
    for (int eb = 0; eb < 8; ++eb) { f32x4 o = (f32x4){0.f, 0.f, 0.f, 0.f};
#pragma unroll
        for (int kk = 0; kk < 8; ++kk) { const u32x2 v0 = *(const u32x2*)(vb + (size_t)(16 * eb) * 512 + 32 * kk), v1 = *(const u32x2*)(vb + (size_t)(16 * eb) * 512 + 32 * kk + 16);
            u32x4 w; w.x = v0.x; w.y = v0.y; w.z = v1.x; w.w = v1.y;
            o = __builtin_amdgcn_mfma_f32_16x16x32_bf16(__builtin_bit_cast(bf16x8, w), pf[kk], o, 0, 0, 0); }
        u32x2 w; w.x = pk2(o[0] * inv, o[1] * inv); w.y = pk2(o[2] * inv, o[3] * inv);
        *(u32x2*)(cat + (size_t)(16 * tblk + fr) * D + MIXW + hd * 128 + 16 * eb + 4 * g) = w; }
}

template <bool HG> __device__ __forceinline__ void xa_phase(const bf16* proj, const bf16* memk, const bf16* memvt, bf16* cat, int l, LAS unsigned char* lds, int tid, int lane, int wave) {
    typedef MC<HG> C; constexpr int LD = C::LD, KS = 272, VS = 528, K_OFF = 0, V_OFF = 256 * KS;
    static_assert(V_OFF + 128 * VS <= 140 * 1024, "XA LDS");
    const int bx = blockIdx.x, bh = bx & 7, b = bh >> 2, hd = bh & 3, part = bx >> 3;
#pragma unroll
    for (int i = 0; i < 8; ++i) { const int ci = tid + NTHR * i, m = ci >> 4, cj = ci & 15;
        *(LAS u32x4*)(lds + K_OFF + m * KS + cj * 16) = *(const u32x4*)(memk + (size_t)(b * 256 + m) * 2048 + l * 512 + hd * 128 + cj * 8); }
#pragma unroll
    for (int i = 0; i < 8; ++i) { const int ci = tid + NTHR * i, e = ci >> 5, cj = ci & 31;
        *(LAS u32x4*)(lds + V_OFF + e * VS + cj * 16) = *(const u32x4*)(memvt + (size_t)(l * 512 + hd * 128 + e) * 512 + b * 256 + cj * 8); }
    __syncthreads();
    const int fr = lane & 15, g = lane >> 4;
    for (int j = wave; j < 16; j += NWAVES) {
        const int tblk = b * 512 + part * 16 + j;
        bf16x8 qf[4];
#pragma unroll
        for (int ks = 0; ks < 4; ++ks) qf[ks] = *(const bf16x8*)(proj + (size_t)(16 * tblk + fr) * LD + C::XQOFF + hd * 128 + ks * 32 + g * 8);
        f32x4 st[16];
#pragma unroll
        for (int mb = 0; mb < 16; ++mb) { f32x4 a = (f32x4){0.f, 0.f, 0.f, 0.f};
#pragma unroll
            for (int ks = 0; ks < 4; ++ks) { const bf16x8 kf = *(const LAS bf16x8*)(lds + K_OFF + (16 * mb + fr) * KS + ks * 64 + g * 16); a = __builtin_amdgcn_mfma_f32_16x16x32_bf16(kf, qf[ks], a, 0, 0, 0); }
            st[mb] = a; }
        float mx = -3.0e38f;
#pragma unroll
        for (int mb = 0; mb < 16; ++mb) mx = fmaxf(fmaxf(fmaxf(st[mb][0], st[mb][1]), fmaxf(st[mb][2], st[mb][3])), mx);
        mx = fmaxf(mx, __shfl_xor(mx, 16)); mx = fmaxf(mx, __shfl_xor(mx, 32));
        constexpr float SC = 0.08838834764831845f * 1.44269504f; float sum = 0.f;
#pragma unroll
        for (int mb = 0; mb < 16; ++mb)
#pragma unroll
            for (int q = 0; q < 4; ++q) { const float pz = __builtin_amdgcn_exp2f((st[mb][q] - mx) * SC); st[mb][q] = pz; sum += pz; }
        sum += __shfl_xor(sum, 16); sum += __shfl_xor(sum, 32);
        const float inv = __builtin_amdgcn_rcpf(sum);
        bf16x8 pf[8];
#pragma unroll
        for (int kk = 0; kk < 8; ++kk) { u32x4 w; w.x = pk2(st[2 * kk][0], st[2 * kk][1]); w.y = pk2(st[2 * kk][2], st[2 * kk][3]); w.z = pk2(st[2 * kk + 1][0], st[2 * kk + 1][1]); w.w = pk2(st[2 * kk + 1][2], st[2 * kk + 1][3]);
            pf[kk] = __builtin_bit_cast(bf16x8, w); }
#pragma unroll
        for (int eb = 0; eb < 8; ++eb) { f32x4 o = (f32x4){0.f, 0.f, 0.f, 0.f};
#pragma unroll
            for (int kk = 0; kk < 8; ++kk) { const LAS unsigned char* vp = lds + V_OFF + (16 * eb + fr) * VS + (32 * kk + 4 * g) * 2;
                const u32x2 v0 = *(const LAS u32x2*)vp, v1 = *(const LAS u32x2*)(vp + 32);
                u32x4 w; w.x = v0.x; w.y = v0.y; w.z = v1.x; w.w = v1.y;
                o = __builtin_amdgcn_mfma_f32_16x16x32_bf16(__builtin_bit_cast(bf16x8, w), pf[kk], o, 0, 0, 0); }
            u32x2 w; w.x = pk2(o[0] * inv, o[1] * inv); w.y = pk2(o[2] * inv, o[3] * inv);
            *(u32x2*)(cat + (size_t)(16 * tblk + fr) * D + MIXW + hd * 128 + 16 * eb + 4 * g) = w; }
    }
    __syncthreads();
}
#define RLX_AGENT __ATOMIC_RELAXED, __HIP_MEMORY_SCOPE_AGENT
#define XB_TMO      128
#define XB_XCNT(j)  (256  + 64 * (j))
#define XB_XSUB(j)  (1280 + 64 * (j))
#define XB_XGEN(j)  (2304 + 64 * (j))
#define XB_TOP      3328
#define XB_TOPGEN   3392
#define XCD_BAR_WORDS 3456
#define XB_SPIN_CAP (1u << 18)

__device__ __forceinline__ unsigned xb_ld(unsigned* p)              { return __hip_atomic_load(p, __ATOMIC_RELAXED, __HIP_MEMORY_SCOPE_AGENT); }
__device__ __forceinline__ unsigned xb_add(unsigned* p, unsigned v) { return __hip_atomic_fetch_add(p, v, __ATOMIC_RELAXED, __HIP_MEMORY_SCOPE_AGENT); }
__device__ __forceinline__ unsigned xb_xcc_id() { return (unsigned)__builtin_amdgcn_s_getreg((3 << 11) | 20) & 0xFu; }
#define XB_SPIN(cond, bar) do { unsigned _sp = 0; while (cond) { __builtin_amdgcn_s_sleep(1); \
    if ((++_sp & 255u) == 0u) { if (xb_ld(&(bar)[XB_TMO])) break; if (_sp > XB_SPIN_CAP) { atomicAdd(&(bar)[XB_TMO], 1u); break; } } } } while (0)

struct XcdBarrier {
    unsigned* bar; unsigned x;
    volatile LAS unsigned* st;
};

__device__ __forceinline__ XcdBarrier xcd_barrier_post(unsigned* bar, volatile LAS unsigned* st) {
    XcdBarrier b; b.bar = bar; b.x = xb_xcc_id(); b.st = st;
    if (threadIdx.x == 0) (void)xb_add(&bar[XB_XCNT(b.x)], 1u);
    return b;
}
__device__ __forceinline__ void xcd_barrier_complete(unsigned* bar, unsigned x, unsigned& nloc, unsigned& nx) {
    const unsigned G = gridDim.x * gridDim.y * gridDim.z;
    unsigned sum, cnt, mine, sp = 0u;
    for (;;) {
        sum = 0u; cnt = 0u; mine = 0u;
#pragma unroll
        for (unsigned j = 0; j < 16; ++j) { const unsigned c = xb_ld(&bar[XB_XCNT(j)]); sum += c; cnt += (c > 0u) ? 1u : 0u; mine = (j == x) ? c : mine; }
        if (sum == G) break;
        __builtin_amdgcn_s_sleep(1);
        if ((++sp & 255u) == 0u) { if (xb_ld(&bar[XB_TMO])) break; if (sp > XB_SPIN_CAP) { atomicAdd(&bar[XB_TMO], 1u); break; } }
    }
    nloc = mine > 0u ? mine : 1u; nx = cnt > 0u ? cnt : 1u;
}

__device__ __forceinline__ void xcd_barrier(const XcdBarrier& b) {
    asm volatile("s_waitcnt vmcnt(0)" ::: "memory");
    __syncthreads();
    if (threadIdx.x == 0) {
        unsigned* bar = b.bar;
        __builtin_amdgcn_s_waitcnt(0);
        unsigned nloc = b.st[0], nx = b.st[1];
        if (nloc == 0u) { xcd_barrier_complete(bar, b.x, nloc, nx); b.st[0] = nloc; b.st[1] = nx; }
        const unsigned old = xb_add(&bar[XB_XSUB(b.x)], 1u);
        const unsigned gen = old / nloc;
        if (old + 1u == (gen + 1u) * nloc) {
            __builtin_amdgcn_fence(__ATOMIC_RELEASE, "agent");
            asm volatile("s_waitcnt vmcnt(0)" ::: "memory");
            const unsigned og = xb_add(&bar[XB_TOP], 1u);
            const unsigned tg = og / nx;
            if (og + 1u == (tg + 1u) * nx) xb_add(&bar[XB_TOPGEN], 1u);
            else XB_SPIN(xb_ld(&bar[XB_TOPGEN]) == tg, bar);
            __builtin_amdgcn_fence(__ATOMIC_ACQUIRE, "agent");
            xb_add(&bar[XB_XGEN(b.x)], 1u);
            asm volatile("s_waitcnt vmcnt(0)" ::: "memory");
        } else {
            XB_SPIN(xb_ld(&bar[XB_XGEN(b.x)]) == gen, bar);
            __builtin_amdgcn_fence(__ATOMIC_ACQUIRE, "agent");
            asm volatile("s_waitcnt vmcnt(0)" ::: "memory");
        }
    }
    __syncthreads();
}

#ifndef REP_P0
#define REP_P0 1
#endif
#ifndef REP_SYNC
#define REP_SYNC 0
#endif
#ifndef H_BF16
#define H_BF16 1
#endif
#ifndef REP_M2
#define REP_M2 1
#endif
#ifndef REP_M1
#define REP_M1 1
#endif
#ifndef REP_XA
#define REP_XA 1
#endif
#ifndef REP_M3
#define REP_M3 1
#endif
#ifndef REP_G13
#define REP_G13 1
#endif
#ifndef MK_SKELETON
#define MK_SKELETON 0
#endif
template <class Epi> __device__ __forceinline__ void run_gemm(LAS unsigned char* lds, const bf16* A, const bf16* Bt, int Mr, int N, int K, int G, int c, const Epi& E, int wgm = 4) {
    pg8::Gemm g{A, Bt, Mr, N, K}; pg8::StaticOrder S; S.init(Mr, N, G, c, wgm);
    pg8::gemm_phase<Epi, pg8::StaticOrder, true, true>(lds, g, S, E);
}
template <bool HG> __device__ __forceinline__ void mixer_phases(const Args& a, const XcdBarrier& xbar, LAS unsigned char* lds, int l, int tid_, int lane_, int wave_) {
#define OPAQUE_TID() int tid = threadIdx.x; asm volatile("" : "+v"(tid)); const int lane = tid & 63, wave = __builtin_amdgcn_readfirstlane(tid >> 6);
    unsigned char* ws = a.ws; const int j = l >> 1, G = gridDim.x;
    MixP p; p.proj = (const bf16*)(ws + WS_PROJ); p.us = (bf16*)(ws + WS_US); p.vtg = (bf16*)(ws + WS_VTG); p.dec = (float*)(ws + WS_DEC); p.cat = (bf16*)(ws + WS_CAT);
    p.lb = a.hgrn_lb; p.wgk = a.gla_w_gk + (size_t)j * 16 * 768; p.bgk = a.gla_b_gk + j * 768; p.onorm = HG ? a.hgrn_onorm + j * 128 : a.gla_onorm + j * 384; p.j = j;
    const bool split = HG && G == 256;
#ifndef NO_M1
    if (split && blockIdx.x < 128) { pg8::EpiScaleBf16<true> E{(bf16*)(ws + WS_PROJ) + 6144, HG_IN, (const float*)(ws + WS_SSQ2) + (size_t)(2 * l) * M * 32};
        run_gemm(lds, (const bf16*)(ws + WS_HB), wt_in(ws, l) + (size_t)6144 * D, M, 512, D, 128, (int)blockIdx.x, E); }
    for (int rep = 0; rep < REP_M1; ++rep) { OPAQUE_TID(); M1Raw<HG> r;
        int it, step, end;
        if (split) { step = 1; if (blockIdx.x < 128) { it = blockIdx.x * 8; end = it + 8; } else { it = 1024 + (blockIdx.x - 128) * 16; end = it + 16; } }
        else { it = blockIdx.x; step = G; end = 256 * 12; }
        if (it < end) m1_load<HG>(p, it, tid, r);
        for (; it < end; it += step) m1_item<HG>(p, lds, it, it + step < end ? it + step : -1, r, tid, lane, wave);
        __syncthreads(); }
#endif
#ifndef NO_XA
    if (!split)
    for (int rep = 0; rep < REP_XA; ++rep) { OPAQUE_TID();
        if (G == 256) xa_phase<HG>(p.proj, (const bf16*)(ws + WS_MEMK), (const bf16*)(ws + WS_MEMVT), p.cat, l, lds, tid, lane, wave);
        else for (int wi = blockIdx.x * NWAVES + wave; wi < 4096; wi += G * NWAVES) xa_item<HG>(p.proj, (const bf16*)(ws + WS_MEMK), (const bf16*)(ws + WS_MEMVT), p.cat, l, wi, lane); }
#endif
    xcd_barrier(xbar);
#ifndef NO_M2
    { OPAQUE_TID(); m2_scan<HG>(p, blockIdx.x * NTHR + tid, G * NTHR); }
    if (split) { OPAQUE_TID(); xa_phase<HG>(p.proj, (const bf16*)(ws + WS_MEMK), (const bf16*)(ws + WS_MEMVT), p.cat, l, lds, tid, lane, wave); }
#if REP_M2 > 1
    { OPAQUE_TID(); MixP p2 = p; p2.us = (bf16*)(ws + WS_END); m2_scan<HG>(p2, blockIdx.x * NTHR + tid, G * NTHR); }
#endif
#endif
    xcd_barrier(xbar);
#ifndef NO_M3
    for (int rep = 0; rep < REP_M3; ++rep) { OPAQUE_TID(); constexpr int N3 = 256 * MC<HG>::NH; M3Raw<HG> r; int it = blockIdx.x; if (it < N3) m3_load<HG>(p, it, tid, r);
        for (; it < N3; it += G) m3_item<HG>(p, lds, it, it + G < N3 ? it + G : -1, r, tid, lane, wave);
        __syncthreads(); }
#endif
    xcd_barrier(xbar);
}

__global__ void __launch_bounds__(NTHR, 2) trunk_fwd(Args a) {
    extern __shared__ __attribute__((aligned(16))) unsigned char lds_raw[];
    LAS unsigned char* lds = (LAS unsigned char*)lds_raw;
    cg::grid_group grid = cg::this_grid();
    const int tid = threadIdx.x, lane = tid & 63, wave = __builtin_amdgcn_readfirstlane(tid >> 6), G = gridDim.x, bx = blockIdx.x;
    unsigned char* ws = a.ws;
    float* ssq = (float*)(ws + WS_SSQ2); float* H = (float*)(ws + WS_H); bf16* HB = (bf16*)(ws + WS_HB); bf16* CAT = (bf16*)(ws + WS_CAT); bf16* PROJ = (bf16*)(ws + WS_PROJ); bf16* ACT = PROJ;
#ifndef NO_P0
    for (int rep = 0; rep < REP_P0; ++rep) p0_prologue(a, lds, tid, lane, wave);
#endif
    { unsigned* bw = (unsigned*)(ws + WS_BAR); if (bx == 0) for (int i = tid; i < XCD_BAR_WORDS; i += NTHR) bw[i] = 0u; if (tid < 2) ((volatile LAS unsigned*)(lds + LDS_CTL))[tid] = 0u; }
    grid.sync();
    const XcdBarrier xbar = xcd_barrier_post((unsigned*)(ws + WS_BAR), (volatile LAS unsigned*)(lds + LDS_CTL));
#ifndef NO_PKV
    if (bx >= G - 32 && bx < G - 16) { pg8::EpiScaleBf16<false> E{(bf16*)(ws + WS_MEMK), 2048, nullptr}; run_gemm(lds, (const bf16*)(ws + WS_MEMN), (const bf16*)(ws + WS_WTK), MMEM, 2048, D, 16, bx - (G - 32), E); }
    else if (bx >= G - 16) { pg8::EpiScaleBf16<false> E{(bf16*)(ws + WS_MEMVT), 512, nullptr}; run_gemm(lds, (const bf16*)(ws + WS_WTV), (const bf16*)(ws + WS_MEMN), 2048, MMEM, D, 16, bx - (G - 16), E); }
#endif
#pragma unroll 1
    for (int l = 0; l < DEPTH; ++l) {
#ifndef NO_G1
        for (int rep = 0; rep < REP_G13; ++rep) { pg8::EpiScaleBf16<true> E{PROJ, n_in(l), ssq + (size_t)(2 * l) * M * 32}; run_gemm(lds, HB, wt_in(ws, l), M, (!(l & 1) && G == 256) ? 6144 : n_in(l), D, G, bx, E); }
#endif
        xcd_barrier(xbar);
        if (l & 1) mixer_phases<false>(a, xbar, lds, l, tid, lane, wave); else mixer_phases<true>(a, xbar, lds, l, tid, lane, wave);
#ifndef NO_G2
#if H_BF16
        { pg8::EpiResidBf E{HB, ssq + (size_t)(2 * l + 1) * M * 32}; run_gemm(lds, CAT, wt_out(ws, l), M, D, D, G, bx, E, WGM_G2); }
#else
        { pg8::EpiResid E{l == 0 ? a.x : H, H, HB, ssq + (size_t)(2 * l + 1) * M * 32}; run_gemm(lds, CAT, wt_out(ws, l), M, D, D, G, bx, E); }
#endif
#endif
        xcd_barrier(xbar);
        for (int rep = 0; rep < REP_SYNC; ++rep) xcd_barrier(xbar);
#ifndef NO_G3
        for (int rep = 0; rep < REP_G13; ++rep) { pg8::EpiSwiglu E{ACT, DFF, ssq + (size_t)(2 * l + 1) * M * 32}; run_gemm(lds, HB, wt_gu(ws, l), M, 2 * DFF, D, G, bx, E); }
#endif
        xcd_barrier(xbar);
#ifndef NO_G4
#if H_BF16
        { pg8::EpiResidBf E{HB, ssq + (size_t)(2 * l + 2) * M * 32}; run_gemm(lds, ACT, wt_down(ws, l), M, D, DFF, G, bx, E, WGM_G4); }
#else
        { pg8::EpiResid E{H, H, HB, ssq + (size_t)(2 * l + 2) * M * 32}; run_gemm(lds, ACT, wt_down(ws, l), M, D, DFF, G, bx, E); }
#endif
#endif
        xcd_barrier(xbar);
    }
    for (int m = bx * NWAVES + wave; m < M; m += G * NWAVES) {
        const float r = rsqrtf(wave_sum(lane < 32 ? ssq[((size_t)8 * M + m) * 32 + lane] : 0.f) * (1.0f / D) + EPS);
        const f32x4* hr = (const f32x4*)(H + (size_t)m * D) + lane; const u32x2* hb = (const u32x2*)(HB + (size_t)m * D) + lane; const f32x4* gr = (const f32x4*)a.norm_final + lane; f32x4* o = (f32x4*)(a.out + (size_t)m * D) + lane;
#pragma unroll
        for (int jj = 0; jj < 8; ++jj) { f32x4 v; if (H_BF16) { const u32x2 w = hb[64 * jj]; v = (f32x4){bflo(w.x), bfhi(w.x), bflo(w.y), bfhi(w.y)}; } else v = hr[64 * jj]; const f32x4 gg = gr[64 * jj]; o[64 * jj] = (f32x4){v.x * r * gg.x, v.y * r * gg.y, v.z * r * gg.z, v.w * r * gg.w}; }
    }
}

extern "C" void kernel_launch(void* const* d_in, const int* in_sizes, int n_in_, void* d_out, int out_size, void* d_ws, size_t ws_size, hipStream_t stream) {
    static int grid = 0;
    if (grid == 0) {
        if (n_in_ != 17 || in_sizes[0] != M * D || out_size != M * D || ws_size < WS_END) { fprintf(stderr, "kernel_launch: unexpected shapes (n_in %d, in0 %d, out %d, ws %zu < %zu)\n", n_in_, n_in_ > 0 ? in_sizes[0] : -1, out_size, ws_size, (size_t)WS_END); grid = -1; return; }
        int dev = 0, cus = 0, per_cu = 0;
        hipGetDevice(&dev); hipDeviceGetAttribute(&cus, hipDeviceAttributeMultiprocessorCount, dev);
        if (hipFuncSetAttribute((const void*)trunk_fwd, hipFuncAttributeMaxDynamicSharedMemorySize, LDS_BYTES) != hipSuccess) { fprintf(stderr, "kernel_launch: hipFuncSetAttribute failed\n"); grid = -1; return; }
        if (hipOccupancyMaxActiveBlocksPerMultiprocessor(&per_cu, (const void*)trunk_fwd, NTHR, LDS_BYTES) != hipSuccess || per_cu < 1) { fprintf(stderr, "kernel_launch: occupancy query says %d blocks per CU\n", per_cu); per_cu = 1; }
        (void)hipGetLastError();
        grid = cus;
    }
    if (grid < 0) return;
    Args a{};
    a.x = (const float*)d_in[0]; a.mem = (const float*)d_in[1]; a.norm_mix = (const float*)d_in[2]; a.norm_ffn = (const float*)d_in[3]; a.norm_mem = (const float*)d_in[4]; a.norm_final = (const float*)d_in[5];
    a.hgrn_w_in = (const float*)d_in[6]; a.hgrn_lb = (const float*)d_in[7]; a.hgrn_onorm = (const float*)d_in[8]; a.gla_w_in = (const float*)d_in[9]; a.gla_w_gk = (const float*)d_in[10]; a.gla_b_gk = (const float*)d_in[11];
    a.gla_onorm = (const float*)d_in[12]; a.w_mem_kv = (const float*)d_in[13]; a.w_out = (const float*)d_in[14]; a.w_gate_up = (const float*)d_in[15]; a.w_down = (const float*)d_in[16];
    a.out = (float*)d_out; a.ws = (unsigned char*)d_ws;
    void* args[] = {&a};
    hipError_t e = hipLaunchCooperativeKernel((const void*)trunk_fwd, dim3(grid), dim3(NTHR), args, LDS_BYTES, stream);
    if (e != hipSuccess) fprintf(stderr, "kernel_launch: cooperative launch failed: %s (grid %d)\n", hipGetErrorString(e), grid);
}
```

```cpp
#include <hip/hip_runtime.h>
#ifndef WGM_G4
#define WGM_G4 4
#endif
#ifndef WGM_G2
#define WGM_G2 4
#endif
#include <hip/hip_cooperative_groups.h>
#include <cstdio>
#include <cstdint>
namespace cg = cooperative_groups;
namespace pg8 {
#define PG8_LAS __attribute__((address_space(3)))
typedef unsigned short bf16_t;
typedef short bf16x8 __attribute__((ext_vector_type(8)));
typedef float f32x4 __attribute__((ext_vector_type(4)));
typedef unsigned u32x4 __attribute__((ext_vector_type(4)));
typedef unsigned u32x2 __attribute__((ext_vector_type(2)));
constexpr int BM = 256, BK = 64, HALF = 128, HTB = HALF * BK * 2  , STAGE_BYTES = 8 * HTB, NXCD = 8, WGM = 8;

__host__ __device__ __forceinline__ int lds_byte(int r, int c) { const int st = (r >> 4) * 2 + (c >> 5), rr = r & 15, cc = c & 31, ob = rr * 64 + cc * 2; return st * 1024 + (ob ^ (((ob >> 9) & 1) << 5)); }
__host__ __device__ __forceinline__ void stage_rc(int b, int& R, int& C) { const int st = b / 1024, sb = b % 1024, swz = sb ^ (((sb >> 9) & 1) << 5); R = (st >> 1) * 16 + swz / 64; C = (st & 1) * 32 + (swz % 64) / 2; }
__host__ __device__ __forceinline__ int perm32(int rho) { const int n = rho >> 4, i = rho & 15; return 8 * (i >> 2) + 4 * n + (i & 3); }

struct Unit { int pm, pn; };
struct Gemm { const bf16_t* A; const bf16_t* Bt; int M, N, K; };

struct StaticOrder {
    int nM, nN, nwg, G, c, wgm;
    __host__ __device__ void init(int M, int N, int G_, int c_, int wgm_ = 4) { nM = M / BM; nN = N / BM; nwg = nM * nN; G = G_; c = c_; wgm = wgm_; }
    __host__ __device__ bool next(int i, Unit& u) const {
        const long L = (long)i * G + c; if (L >= nwg) return false;
        int wgid = (int)L; { const int q = nwg / NXCD, r = nwg % NXCD, xcd = wgid % NXCD, off = wgid / NXCD; wgid = (xcd < r ? xcd * (q + 1) : r * (q + 1) + (xcd - r) * q) + off; }
        const int nig = wgm * nN, gid = wgid / nig, fm = gid * wgm, gsz = (nM - fm) < wgm ? (nM - fm) : wgm;
        u.pm = fm + ((wgid % nig) % gsz); u.pn = (wgid % nig) / gsz; return true;
    }
    __device__ __forceinline__ void a_ready(const Unit&) const {}
    __device__ __forceinline__ void done(const Unit&) const {}
};
__device__ __forceinline__ unsigned cvt_pk_bf16(float lo, float hi) { unsigned r; asm volatile("v_cvt_pk_bf16_f32 %0, %1, %2" : "=v"(r) : "v"(lo), "v"(hi)); return r; }
constexpr float RMS_EPS = 1e-6f;
__device__ __forceinline__ float row_rstd(const float* ssqp, int row, int fq) {
    const float* pr = ssqp + (size_t)row * 32 + 8 * fq; const f32x4 a = *(const f32x4*)pr, b = *(const f32x4*)(pr + 4);
    float s = ((a[0] + a[1]) + (a[2] + a[3])) + ((b[0] + b[1]) + (b[2] + b[3]));
    s += __shfl_xor(s, 16); s += __shfl_xor(s, 32);
    return rsqrtf(s * (1.0f / 2048.0f) + RMS_EPS);
}
__device__ __forceinline__ float fsilu(float g) { return g * __builtin_amdgcn_rcpf(1.0f + __builtin_amdgcn_exp2f(-1.44269504f * g)); }
template <bool SCALE> struct EpiScaleBf16 {
    static constexpr bool PERM = true, AFTER_DRAIN = false;
    bf16_t* O; int ldc; const float* ssq;
    __device__ __forceinline__ void operator()(const f32x4 (&acc)[2][2][4][2], const Unit& u, int wr, int wc, int fr, int fq) const {
        const int row0 = u.pm * BM + wr * 64 + fr, col0 = u.pn * BM + wc * 32 + 8 * fq;
#pragma unroll
        for (int ai = 0; ai < 2; ++ai)
#pragma unroll
            for (int m = 0; m < 4; ++m) {
                const int row = row0 + ai * HALF + m * 16;
                float r = 1.0f; if (SCALE) r = row_rstd(ssq, row, fq);
                bf16_t* rowp = O + (size_t)row * ldc + col0;
#pragma unroll
                for (int bj = 0; bj < 2; ++bj) { const f32x4 v0 = acc[ai][bj][m][0] * r, v1 = acc[ai][bj][m][1] * r;
                    u32x4 w; w.x = cvt_pk_bf16(v0[0], v0[1]); w.y = cvt_pk_bf16(v0[2], v0[3]); w.z = cvt_pk_bf16(v1[0], v1[1]); w.w = cvt_pk_bf16(v1[2], v1[3]);
                    *(u32x4*)(rowp + bj * HALF) = w; }
            }
    }
};
struct EpiSwiglu {
    static constexpr bool PERM = true, AFTER_DRAIN = false;
    bf16_t* O; int ldo; const float* ssq;
    __device__ __forceinline__ void operator()(const f32x4 (&acc)[2][2][4][2], const Unit& u, int wr, int wc, int fr, int fq) const {
        const int row0 = u.pm * BM + wr * 64 + fr, col0 = u.pn * HALF + wc * 32 + 8 * fq;
#pragma unroll
        for (int ai = 0; ai < 2; ++ai)
#pragma unroll
            for (int m = 0; m < 4; ++m) {
                const int row = row0 + ai * HALF + m * 16;
                const float r = row_rstd(ssq, row, fq);
                float y[8];
#pragma unroll
                for (int n = 0; n < 2; ++n)
#pragma unroll
                    for (int j = 0; j < 4; ++j) { const float g = acc[ai][0][m][n][j] * r, up = acc[ai][1][m][n][j] * r; y[n * 4 + j] = fsilu(g) * up; }
                u32x4 w; w.x = cvt_pk_bf16(y[0], y[1]); w.y = cvt_pk_bf16(y[2], y[3]); w.z = cvt_pk_bf16(y[4], y[5]); w.w = cvt_pk_bf16(y[6], y[7]);
                *(u32x4*)(O + (size_t)row * ldo + col0) = w;
            }
    }
};
struct EpiResid {
    static constexpr bool PERM = false, AFTER_DRAIN = false;
    const float* Hin; float* Hout; bf16_t* HB; float* ssq;
    __device__ __forceinline__ void operator()(const f32x4 (&acc)[2][2][4][2], const Unit& u, int wr, int wc, int fr, int fq) const {
        const int row0 = u.pm * BM + wr * 64 + fr, col0 = u.pn * BM + wc * 32 + 4 * fq;
#pragma unroll
        for (int ai = 0; ai < 2; ++ai)
#pragma unroll
            for (int m = 0; m < 4; ++m) {
                const int row = row0 + ai * HALF + m * 16; const size_t off = (size_t)row * 2048 + col0; float ss = 0.f;
#pragma unroll
                for (int bj = 0; bj < 2; ++bj)
#pragma unroll
                    for (int n = 0; n < 2; ++n) { const size_t o = off + bj * HALF + n * 16;
                        const f32x4 h = *(const f32x4*)(Hin + o) + acc[ai][bj][m][n];
                        *(f32x4*)(Hout + o) = h;
                        u32x2 w; w.x = cvt_pk_bf16(h[0], h[1]); w.y = cvt_pk_bf16(h[2], h[3]); *(u32x2*)(HB + o) = w;
                        ss += (h[0] * h[0] + h[1] * h[1]) + (h[2] * h[2] + h[3] * h[3]); }
                ss += __shfl_xor(ss, 16); ss += __shfl_xor(ss, 32);
                if (fq == 0) ssq[(size_t)row * 32 + u.pn * 4 + wc] = ss;
                if ((m & 3) == 3) asm volatile("" ::: "memory");
            }
    }
};
struct EpiResidBf {
    static constexpr bool PERM = true, AFTER_DRAIN = false;
    bf16_t* HB; float* ssq;
    __device__ __forceinline__ void operator()(const f32x4 (&acc)[2][2][4][2], const Unit& u, int wr, int wc, int fr, int fq) const {
        const int row0 = u.pm * BM + wr * 64 + fr, col0 = u.pn * BM + wc * 32 + 8 * fq;
#pragma unroll
        for (int ai = 0; ai < 2; ++ai)
#pragma unroll
            for (int m = 0; m < 4; ++m) {
                const int row = row0 + ai * HALF + m * 16; const size_t off = (size_t)row * 2048 + col0; float ss = 0.f;
#pragma unroll
                for (int bj = 0; bj < 2; ++bj) { const size_t o = off + bj * HALF;
                    const u32x4 hw = *(const u32x4*)(HB + o); u32x4 w;
#pragma unroll
                    for (int n = 0; n < 2; ++n) { const unsigned h01 = n ? hw.z : hw.x, h23 = n ? hw.w : hw.y;
                        const float h0 = __uint_as_float(h01 << 16) + acc[ai][bj][m][n][0], h1 = __uint_as_float(h01 & 0xffff0000u) + acc[ai][bj][m][n][1];
                        const float h2 = __uint_as_float(h23 << 16) + acc[ai][bj][m][n][2], h3 = __uint_as_float(h23 & 0xffff0000u) + acc[ai][bj][m][n][3];
                        const unsigned w01 = cvt_pk_bf16(h0, h1), w23 = cvt_pk_bf16(h2, h3);
                        if (n) { w.z = w01; w.w = w23; } else { w.x = w01; w.y = w23; }
                        const float r0 = __uint_as_float(w01 << 16), r1 = __uint_as_float(w01 & 0xffff0000u), r2 = __uint_as_float(w23 << 16), r3 = __uint_as_float(w23 & 0xffff0000u);
                        ss += (r0 * r0 + r1 * r1) + (r2 * r2 + r3 * r3); }
                    *(u32x4*)(HB + o) = w; }
                ss += __shfl_xor(ss, 16); ss += __shfl_xor(ss, 32);
                if (fq == 0) ssq[(size_t)row * 32 + u.pn * 4 + wc] = ss;
            }
    }
};
template <class Epi, class Sched, bool ALIGN_EPI = false, bool SP2 = false>
__device__ __forceinline__ void gemm_phase(PG8_LAS unsigned char* lds, const Gemm g, const Sched& S, const Epi& E) {
    int tid_raw = threadIdx.x; asm volatile("" : "+v"(tid_raw));
    const int tid = tid_raw, wid = __builtin_amdgcn_readfirstlane(tid >> 6), lane = tid & 63, wr = wid >> 2, wc = wid & 3, fr = lane & 15, fq = lane >> 4;
    const int K = g.K, nt = K / BK;
    unsigned voffA[2], voffB[2];
#pragma unroll
    for (int i = 0; i < 2; ++i) { int R, C; stage_rc(tid * 16 + i * 8192, R, C); const int Rb = Epi::PERM ? ((R & ~31) + perm32(R & 31)) : R;
        voffA[i] = (unsigned)(R * K + C) * 2u; voffB[i] = (unsigned)(Rb * K + C) * 2u; }
    const size_t kstep = (size_t)(BK * 2);
    const size_t hstep = (size_t)HALF * K * 2;
    const size_t tstep = 2 * hstep;
    const unsigned ldsw = (unsigned)wid * 1024u;
    const int aoff = lds_byte(wr * 64 + fr, fq * 8), boff = lds_byte(wc * 32 + fr, fq * 8);
#define PG8_SA(b, h) (((b) * 2 + (h)) * HTB)
#define PG8_SB(b, h) ((4 + (b) * 2 + (h)) * HTB)
#define PG8_STAGE(bufoff, gbase, voff) do { _Pragma("unroll") for (int _i = 0; _i < 2; ++_i) \
        __builtin_amdgcn_global_load_lds((const unsigned*)((const char*)(gbase) + (voff)[_i]), (PG8_LAS unsigned*)(lds + (bufoff) + ldsw + _i * 8192), 16, 0, 0); } while (0)
#define PG8_LDA(dst, b, h) do { _Pragma("unroll") for (int m = 0; m < 4; ++m) _Pragma("unroll") for (int k = 0; k < 2; ++k) dst[m][k] = *(const PG8_LAS bf16x8*)(lds + PG8_SA(b, h) + aoff + m * 2048 + k * 1024); } while (0)
#define PG8_LDB(dst, b, h) do { _Pragma("unroll") for (int n = 0; n < 2; ++n) _Pragma("unroll") for (int k = 0; k < 2; ++k) dst[n][k] = *(const PG8_LAS bf16x8*)(lds + PG8_SB(b, h) + boff + n * 2048 + k * 1024); } while (0)
#define PG8_MMA(ai, bj, At, Bt) do { __builtin_amdgcn_s_setprio(1); _Pragma("unroll") for (int m = 0; m < 4; ++m) _Pragma("unroll") for (int n = 0; n < 2; ++n) _Pragma("unroll") for (int k = 0; k < 2; ++k) \
        acc[ai][bj][m][n] = __builtin_amdgcn_mfma_f32_16x16x32_bf16(Bt[n][k], At[m][k], acc[ai][bj][m][n], 0, 0, 0); __builtin_amdgcn_s_setprio(0); } while (0)
#define PG8_WAIT_V(n) asm volatile("s_waitcnt vmcnt(" #n ")" ::: "memory")
#define PG8_WAIT_L(n) asm volatile("s_waitcnt lgkmcnt(" #n ")" ::: "memory")
#define PG8_BAR __builtin_amdgcn_s_barrier()
#define PG8_SCHED __builtin_amdgcn_sched_barrier(0)
    Unit cur, nxt; int ui = 0;
    if (!S.next(0, cur)) return;
    f32x4 acc[2][2][4][2];
#pragma unroll
    for (int a = 0; a < 2; ++a)
#pragma unroll
        for (int b = 0; b < 2; ++b)
#pragma unroll
            for (int m = 0; m < 4; ++m)
#pragma unroll
                for (int n = 0; n < 2; ++n) acc[a][b][m][n] = (f32x4){0.f, 0.f, 0.f, 0.f};
    bf16x8 At[4][2], B0[2][2], B1[2][2];
    const char* cA = (const char*)g.A + (size_t)cur.pm * tstep; const char* cB = (const char*)g.Bt + (size_t)cur.pn * tstep;
    S.a_ready(cur);
    if constexpr (SP2) {
        PG8_STAGE(PG8_SB(0, 0), cB, voffB); PG8_STAGE(PG8_SB(0, 1), cB + hstep, voffB); PG8_STAGE(PG8_SA(0, 0), cA, voffA); PG8_STAGE(PG8_SA(0, 1), cA + hstep, voffA);
        if (wr == 1) PG8_BAR;
        PG8_WAIT_V(2); PG8_BAR;
        PG8_STAGE(PG8_SB(1, 0), cB + kstep, voffB); PG8_STAGE(PG8_SA(1, 0), cA + kstep, voffA); PG8_STAGE(PG8_SB(1, 1), cB + hstep + kstep, voffB);
        PG8_WAIT_V(6); PG8_BAR;
    } else {
        PG8_STAGE(PG8_SB(0, 0), cB, voffB); PG8_STAGE(PG8_SA(0, 0), cA, voffA); PG8_STAGE(PG8_SB(0, 1), cB + hstep, voffB); PG8_STAGE(PG8_SA(0, 1), cA + hstep, voffA);
        if (wr == 1) PG8_BAR;
        PG8_WAIT_V(4); PG8_BAR;
        PG8_STAGE(PG8_SB(1, 0), cB + kstep, voffB); PG8_STAGE(PG8_SA(1, 0), cA + kstep, voffA); PG8_STAGE(PG8_SB(1, 1), cB + hstep + kstep, voffB);
        PG8_WAIT_V(6); PG8_BAR;
    }
    for (;;) {
        const bool has_next = S.next(ui + 1, nxt);
        const char* nA = has_next ? (const char*)g.A + (size_t)nxt.pm * tstep : cA; const char* nB = has_next ? (const char*)g.Bt + (size_t)nxt.pn * tstep : cB;
        for (int t = 0; t < nt; t += 2) {
            const bool last = (t == nt - 2);
            const char* a1 = cA + (size_t)(t + 1) * kstep;
            const char* a2 = last ? nA : cA + (size_t)(t + 2) * kstep; const char* b2 = last ? nB : cB + (size_t)(t + 2) * kstep;
            const char* a3 = a2 + kstep; const char* b3 = b2 + kstep;
            if (last && has_next) S.a_ready(nxt);
            if constexpr (SP2) {
            PG8_LDB(B0, 0, 0); PG8_LDB(B1, 0, 1); PG8_SCHED; PG8_LDA(At, 0, 0); PG8_STAGE(PG8_SA(1, 1), a1 + hstep, voffA);
            PG8_WAIT_V(8); PG8_WAIT_L(0); PG8_BAR; PG8_MMA(0, 0, At, B0); PG8_MMA(0, 1, At, B1); PG8_BAR; PG8_SCHED;
            PG8_LDA(At, 0, 1); PG8_STAGE(PG8_SB(0, 0), b2, voffB); PG8_STAGE(PG8_SB(0, 1), b2 + hstep, voffB); PG8_STAGE(PG8_SA(0, 0), a2, voffA);
            PG8_WAIT_V(8); PG8_WAIT_L(0); PG8_BAR; PG8_MMA(1, 0, At, B0); PG8_MMA(1, 1, At, B1); PG8_BAR; PG8_SCHED;
            PG8_LDB(B0, 1, 0); PG8_LDB(B1, 1, 1); PG8_SCHED; PG8_LDA(At, 1, 0); PG8_STAGE(PG8_SA(0, 1), a2 + hstep, voffA);
            PG8_WAIT_V(8); PG8_WAIT_L(0); PG8_BAR; PG8_MMA(0, 0, At, B0); PG8_MMA(0, 1, At, B1); PG8_BAR; PG8_SCHED;
            PG8_LDA(At, 1, 1); PG8_STAGE(PG8_SB(1, 0), b3, voffB); PG8_STAGE(PG8_SB(1, 1), b3 + hstep, voffB); PG8_STAGE(PG8_SA(1, 0), a3, voffA);
            PG8_WAIT_V(8); PG8_WAIT_L(0); PG8_BAR; PG8_MMA(1, 0, At, B0); PG8_MMA(1, 1, At, B1); PG8_BAR; PG8_SCHED;
            } else {
            PG8_LDB(B0, 0, 0); PG8_SCHED; PG8_LDA(At, 0, 0); PG8_STAGE(PG8_SA(1, 1), a1 + hstep, voffA);
            PG8_WAIT_L(8); PG8_BAR; PG8_WAIT_L(0); PG8_MMA(0, 0, At, B0); PG8_BAR; PG8_SCHED;
            PG8_LDB(B1, 0, 1); PG8_STAGE(PG8_SB(0, 0), b2, voffB);
            PG8_BAR; PG8_WAIT_L(0); PG8_MMA(0, 1, At, B1); PG8_BAR;
            PG8_LDA(At, 0, 1); PG8_STAGE(PG8_SA(0, 0), a2, voffA);
            PG8_BAR; PG8_WAIT_L(0); PG8_MMA(1, 0, At, B0); PG8_BAR; PG8_SCHED;
            PG8_STAGE(PG8_SB(0, 1), b2 + hstep, voffB);
            PG8_WAIT_V(6); PG8_BAR; PG8_MMA(1, 1, At, B1); PG8_BAR;
            PG8_LDB(B0, 1, 0); PG8_SCHED; PG8_LDA(At, 1, 0); PG8_STAGE(PG8_SA(0, 1), a2 + hstep, voffA);
            PG8_WAIT_L(8); PG8_BAR; PG8_WAIT_L(0); PG8_MMA(0, 0, At, B0); PG8_BAR; PG8_SCHED;
            PG8_LDB(B1, 1, 1); PG8_STAGE(PG8_SB(1, 0), b3, voffB);
            PG8_BAR; PG8_WAIT_L(0); PG8_MMA(0, 1, At, B1); PG8_BAR;
            PG8_LDA(At, 1, 1); PG8_STAGE(PG8_SA(1, 0), a3, voffA);
            PG8_BAR; PG8_WAIT_L(0); PG8_MMA(1, 0, At, B0); PG8_BAR; PG8_SCHED;
            PG8_STAGE(PG8_SB(1, 1), b3 + hstep, voffB);
            PG8_WAIT_V(6); PG8_BAR; PG8_MMA(1, 1, At, B1); PG8_BAR;
            }
        }
        if constexpr (ALIGN_EPI) { if (wr == 0) PG8_BAR; }
        if constexpr (!Epi::AFTER_DRAIN) { E(acc, cur, wr, wc, fr, fq); S.done(cur); }
        if (!has_next) break;
#pragma unroll
        for (int a = 0; a < 2; ++a)
#pragma unroll
            for (int b = 0; b < 2; ++b)
#pragma unroll
                for (int m = 0; m < 4; ++m)
#pragma unroll
                    for (int n = 0; n < 2; ++n) acc[a][b][m][n] = (f32x4){0.f, 0.f, 0.f, 0.f};
        cur = nxt; cA = nA; cB = nB; ++ui;
        if constexpr (ALIGN_EPI) { if (wr == 1) PG8_BAR; }
    }
    PG8_WAIT_V(0);
    if constexpr (!ALIGN_EPI) { if (wr == 0) PG8_BAR; }
    PG8_BAR;
    if constexpr (Epi::AFTER_DRAIN) { E.fused(acc, cur, wr, wc, fr, fq, lds, wid, lane); S.done(cur); }
#undef PG8_SA
#undef PG8_SB
#undef PG8_STAGE
#undef PG8_LDA
#undef PG8_LDB
#undef PG8_MMA
#undef PG8_WAIT_V
#undef PG8_WAIT_L
#undef PG8_BAR
#undef PG8_SCHED
}
}

#define LAS __attribute__((address_space(3)))
typedef unsigned short bf16;
typedef short bf16x8 __attribute__((ext_vector_type(8)));
typedef float f32x4 __attribute__((ext_vector_type(4)));
typedef unsigned u32x4 __attribute__((ext_vector_type(4)));
typedef unsigned u32x2 __attribute__((ext_vector_type(2)));
constexpr int NWAVES = 8, NTHR = 512;
constexpr int D = 2048, M = 16384, DEPTH = 4, NMEM = 256, MMEM = 512;
constexpr int MIXW = 1536, XAW = 512, DFF = 5632;
constexpr int HG_IN = 6656, GL_IN_SRC = 5136, GL_IN = 5888;
constexpr float EPS = 1e-6f;
constexpr size_t MiB = 1u << 20;
constexpr size_t WS_WT = 0;
constexpr size_t WT_LAYER = 100 * MiB;
constexpr size_t WS_WTK = 400 * MiB, WS_WTV = 408 * MiB, WS_MEMN = 416 * MiB, WS_MEMK = 418 * MiB, WS_MEMVT = 420 * MiB;
constexpr size_t WS_BAR = 422 * MiB, WS_DEC = 423 * MiB, WS_H = 426 * MiB, WS_HB = 554 * MiB, WS_CAT = 618 * MiB, WS_PROJ = 682 * MiB, WS_US = 890 * MiB, WS_SSQ2 = 1034 * MiB, WS_VTG = 1054 * MiB, WS_END = 1102 * MiB;
constexpr int LDS_BYTES = 144 * 1024, LDS_CTL = 143 * 1024;

struct Args {
    const float *x, *mem, *norm_mix, *norm_ffn, *norm_mem, *norm_final, *hgrn_w_in, *hgrn_lb, *hgrn_onorm, *gla_w_in, *gla_w_gk, *gla_b_gk, *gla_onorm, *w_mem_kv, *w_out, *w_gate_up, *w_down;
    float* out; unsigned char* ws;
};

__device__ __forceinline__ float bf2f(unsigned b) { return __uint_as_float(b << 16); }
__device__ __forceinline__ float bflo(unsigned w) { return __uint_as_float(w << 16); }
__device__ __forceinline__ float bfhi(unsigned w) { return __uint_as_float(w & 0xffff0000u); }
__device__ __forceinline__ unsigned pk2(float lo, float hi) { return pg8::cvt_pk_bf16(lo, hi); }
__device__ __forceinline__ float fexp(float x) { return __builtin_amdgcn_exp2f(1.44269504f * x); }
__device__ __forceinline__ float flog(float x) { return 0.69314718f * __builtin_amdgcn_logf(x); }
__device__ __forceinline__ float fsigm(float x) { return __builtin_amdgcn_rcpf(1.0f + fexp(-x)); }
__device__ __forceinline__ float wave_sum(float v) {
#pragma unroll
    for (int o = 1; o < 64; o <<= 1) v += __shfl_xor(v, o);
    return v;
}
#define LDS_WAIT() asm volatile("s_waitcnt lgkmcnt(0)" ::: "memory")

__device__ __forceinline__ int map_col(int mt, int nd) {
    if (mt == 0) return nd;
    if (mt == 1) return nd < 4608 ? nd : (nd < 5120 ? nd + 16 : -1);
    const int pn = nd >> 8, bj = (nd >> 7) & 1, c = nd & 127; return bj * DFF + 128 * pn + c;
}
__device__ __forceinline__ void conv_item(const float* W, int Nsrc, int K, bf16* WT, const float* gain, int mt, const float* wgk, int item, int nblk, LAS float* scr, int lane) {
    const int kb = item / nblk, nb = item % nblk, k0 = 64 * kb, n0 = 32 * nb;
    const int sc = map_col(mt, n0 + (lane & 31));
    float v[32];
    if (mt == 1 && n0 >= 5120) {
        float wz[16];
#pragma unroll
        for (int r = 0; r < 16; ++r) wz[r] = wgk[r * 768 + (n0 - 5120) + (lane & 31)];
#pragma unroll 4
        for (int i = 0; i < 32; ++i) { const int kk = 2 * i + (lane >> 5); const f32x4* wr = (const f32x4*)(W + (size_t)(k0 + kk) * Nsrc + 4608); float z = 0.f;
#pragma unroll
            for (int q = 0; q < 4; ++q) { const f32x4 w4 = wr[q]; z += w4[0] * wz[4 * q] + w4[1] * wz[4 * q + 1] + w4[2] * wz[4 * q + 2] + w4[3] * wz[4 * q + 3]; }
            v[i] = z; }
    } else {
        const int scb = map_col(mt, n0), r8 = lane >> 3, c4 = lane & 7;
        f32x4 v4[8];
#pragma unroll
        for (int i = 0; i < 8; ++i) v4[i] = *(const f32x4*)(W + (size_t)(k0 + 8 * i + r8) * Nsrc + scb + 4 * c4);
        if (gain) {
#pragma unroll
            for (int i = 0; i < 8; ++i) v4[i] = v4[i] * gain[k0 + 8 * i + r8];
        }
#pragma unroll
        for (int i = 0; i < 8; ++i)
#pragma unroll
            for (int j = 0; j < 4; ++j) scr[(8 * i + r8) * 33 + 4 * c4 + j] = v4[i][j];
        goto transposed;
    }
    if (gain) {
#pragma unroll
        for (int i = 0; i < 32; ++i) v[i] *= gain[k0 + 2 * i + (lane >> 5)];
    }
#pragma unroll
    for (int i = 0; i < 32; ++i) scr[(2 * i + (lane >> 5)) * 33 + (lane & 31)] = v[i];
transposed:
    LDS_WAIT(); asm volatile("" ::: "memory");
    const int c = lane & 7;
#pragma unroll
    for (int j = 0; j < 4; ++j) { const int n = (lane >> 3) + 8 * j; const LAS float* s = scr + (8 * c) * 33 + n;
        u32x4 o; o.x = pk2(s[0 * 33], s[1 * 33]); o.y = pk2(s[2 * 33], s[3 * 33]); o.z = pk2(s[4 * 33], s[5 * 33]); o.w = pk2(s[6 * 33], s[7 * 33]);
        *(u32x4*)(WT + (size_t)(n0 + n) * K + k0 + 8 * c) = o; }
    LDS_WAIT(); asm volatile("" ::: "memory");
}
__device__ __forceinline__ void conv_matrix(const float* W, int Nsrc, int K, int Ndst, bf16* WT, const float* gain, int mt, LAS float* scr, int lane, int& gw, int NGW, const float* wgk = nullptr) {
    const int nblk = Ndst / 32, nitems = (K / 64) * nblk;
    for (int it = gw; it < nitems; it += NGW) conv_item(W, Nsrc, K, WT, gain, mt, wgk, it, nblk, scr, lane);
    gw -= nitems % NGW; if (gw < 0) gw += NGW;
}
__device__ __forceinline__ bf16* wt_in(unsigned char* ws, int l) { return (bf16*)(ws + WS_WT + (size_t)l * WT_LAYER); }
__device__ __forceinline__ int n_in(int l) { return (l & 1) ? GL_IN : HG_IN; }
__device__ __forceinline__ bf16* wt_out(unsigned char* ws, int l) { return wt_in(ws, l) + (size_t)n_in(l) * D; }
__device__ __forceinline__ bf16* wt_gu(unsigned char* ws, int l) { return wt_out(ws, l) + (size_t)D * D; }
__device__ __forceinline__ bf16* wt_down(unsigned char* ws, int l) { return wt_gu(ws, l) + (size_t)2 * DFF * D; }

__device__ __forceinline__ void p0_prologue(const Args& a, LAS unsigned char* lds, int tid, int lane, int wave) {
    LAS float* scr = (LAS float*)(lds + wave * 8704);
    const int G = gridDim.x, gw0 = blockIdx.x * NWAVES + wave, NGW = G * NWAVES; int gw = gw0;
    unsigned char* ws = a.ws;
    for (int m = gw0; m < MMEM; m += NGW) {
        const f32x4* xr = (const f32x4*)(a.mem + (size_t)m * D) + lane; const f32x4* gr = (const f32x4*)a.norm_mem + lane; u32x2* o = (u32x2*)((bf16*)(ws + WS_MEMN) + (size_t)m * D) + lane;
        f32x4 v[8]; float s = 0.f;
#pragma unroll
        for (int j = 0; j < 8; ++j) { v[j] = xr[64 * j]; s += (v[j].x * v[j].x + v[j].y * v[j].y) + (v[j].z * v[j].z + v[j].w * v[j].w); }
        const float r = rsqrtf(wave_sum(s) * (1.0f / D) + EPS);
#pragma unroll
        for (int j = 0; j < 8; ++j) { const f32x4 g = gr[64 * j]; u32x2 w; w.x = pk2(v[j].x * r * g.x, v[j].y * r * g.y); w.y = pk2(v[j].z * r * g.z, v[j].w * r * g.w); o[64 * j] = w; }
    }
    for (int l = DEPTH - 1; l >= 0; --l) {
        const int j = l >> 1;
        if (l & 1) conv_matrix(a.gla_w_in + (size_t)j * D * GL_IN_SRC, GL_IN_SRC, D, GL_IN, wt_in(ws, l), a.norm_mix + l * D, 1, scr, lane, gw, NGW, a.gla_w_gk + (size_t)j * 16 * 768);
        else       conv_matrix(a.hgrn_w_in + (size_t)j * D * HG_IN, HG_IN, D, HG_IN, wt_in(ws, l), a.norm_mix + l * D, 0, scr, lane, gw, NGW);
        conv_matrix(a.w_out + (size_t)l * D * D, D, D, D, wt_out(ws, l), nullptr, 0, scr, lane, gw, NGW);
        conv_matrix(a.w_gate_up + (size_t)l * D * 2 * DFF, 2 * DFF, D, 2 * DFF, wt_gu(ws, l), a.norm_ffn + l * D, 2, scr, lane, gw, NGW);
        conv_matrix(a.w_down + (size_t)l * DFF * D, D, DFF, D, wt_down(ws, l), nullptr, 0, scr, lane, gw, NGW);
        conv_matrix(a.w_mem_kv + (size_t)l * D * 2 * XAW, 2 * XAW, D, XAW, (bf16*)(ws + WS_WTK) + (size_t)l * XAW * D, nullptr, 0, scr, lane, gw, NGW);
        conv_matrix(a.w_mem_kv + (size_t)l * D * 2 * XAW + XAW, 2 * XAW, D, XAW, (bf16*)(ws + WS_WTV) + (size_t)l * XAW * D, nullptr, 0, scr, lane, gw, NGW);
    }
    for (int m = gw0; m < M; m += NGW) {
        const f32x4* xr = (const f32x4*)(a.x + (size_t)m * D) + lane; u32x2* hb = (u32x2*)((bf16*)(ws + WS_HB) + (size_t)m * D) + lane;
        f32x4 v[8]; float s = 0.f;
#pragma unroll
        for (int j = 0; j < 8; ++j) v[j] = xr[64 * j];
#pragma unroll
        for (int j = 0; j < 8; ++j) { s += (v[j].x * v[j].x + v[j].y * v[j].y) + (v[j].z * v[j].z + v[j].w * v[j].w); u32x2 w; w.x = pk2(v[j].x, v[j].y); w.y = pk2(v[j].z, v[j].w); hb[64 * j] = w; }
        s = wave_sum(s); if (lane < 32) ((float*)(ws + WS_SSQ2))[(size_t)m * 32 + lane] = lane == 0 ? s : 0.f;
    }
}
template <bool HG> struct MC {
    static constexpr int DK = HG ? 128 : 192, DV = HG ? 128 : 384, NH = HG ? 12 : 4, NS = DV / 128, LD = HG ? HG_IN : GL_IN;
    static constexpr int QOFF = 0, KOFF = HG ? 1536 : 768, VOFF = HG ? 3072 : 1536, GOFF = HG ? 4608 : 3072, XQOFF = HG ? 6144 : 4608, ZOFF = 5120;
    static constexpr int RS = DK * 2 + 16;
    static constexpr int TS = 144;
};
struct MixP { const bf16* proj; bf16* vtg; bf16* us; float* dec; bf16* cat; const float* lb; const float* wgk; const float* bgk; const float* onorm; int j; };

__device__ __forceinline__ float hgrn_lb(const MixP& p, int col) {
    if (p.j == 0) return 0.f;
    return fsigm(p.lb[MIXW + col] - p.lb[col]);
}
__device__ __forceinline__ float gla_la(const LAS float* g, const float (&w)[16], float bb) {
    float z = bb;
#pragma unroll
    for (int r = 0; r < 16; ++r) z += g[r] * w[r];
    return (fminf(z, 0.f) - flog(1.0f + fexp(-fabsf(z)))) * (1.0f / 16.0f);
}
__device__ __forceinline__ float gla_lz(float z) { return flog(1.0f + fexp(-fmaxf(z, -60.f))) * (-1.0f / 16.0f); }
__device__ __forceinline__ void hg_gate(float x, float lb, float omlb, bool haslb, float& la, float& k) {
    const float e = fexp(-fmaxf(x, -60.f)), s1 = 1.0f + e; la = -flog(s1); if (haslb) la += flog(1.0f + lb * e); k = omlb * e * __builtin_amdgcn_rcpf(s1);
}
template <bool HG> __device__ __forceinline__ void load_gkl(const MixP& p, LAS float* gkl, int row0, int tid) {
    if (!HG) { const int idx = tid * 2, t = idx >> 4, r = idx & 15; const unsigned w = *(const unsigned*)(p.proj + (size_t)(row0 + t) * MC<HG>::LD + MC<HG>::GKOFF + r); gkl[idx] = bflo(w); gkl[idx + 1] = bfhi(w); }
}


template <bool HG> __device__ __forceinline__ void gate8(const LAS bf16* src, int stride, float bb, float lb, float omlb, bool haslb, float (&la)[8], float (&k)[8]) {
    float x[8], e[8], s1[8], l1[8];
#pragma unroll
    for (int j = 0; j < 8; ++j) x[j] = bf2f(src[j * stride]);
#pragma unroll
    for (int j = 0; j < 8; ++j) x[j] = -1.44269504f * fmaxf(x[j] + bb, -60.f);
#pragma unroll
    for (int j = 0; j < 8; ++j) e[j] = __builtin_amdgcn_exp2f(x[j]);
#pragma unroll
    for (int j = 0; j < 8; ++j) s1[j] = 1.0f + e[j];
#pragma unroll
    for (int j = 0; j < 8; ++j) l1[j] = __builtin_amdgcn_logf(s1[j]);
    if (HG) {
        float r[8], l2[8];
#pragma unroll
        for (int j = 0; j < 8; ++j) r[j] = __builtin_amdgcn_rcpf(s1[j]);
        if (haslb) {
#pragma unroll
            for (int j = 0; j < 8; ++j) l2[j] = __builtin_amdgcn_logf(1.0f + lb * e[j]);
        } else {
#pragma unroll
            for (int j = 0; j < 8; ++j) l2[j] = 0.f;
        }
#pragma unroll
        for (int j = 0; j < 8; ++j) { la[j] = 0.69314718f * (l2[j] - l1[j]); k[j] = omlb * e[j] * r[j]; }
    } else {
#pragma unroll
        for (int j = 0; j < 8; ++j) { la[j] = (-0.69314718f / 16.0f) * l1[j]; k[j] = 0.f; }
    }
}
template <bool HG> struct MixPar { float w[2]; };
template <bool HG> __device__ __forceinline__ void par_load(const MixP& p, int h, int tid, MixPar<HG>& q) {
    if (HG) { const int col = h * 128 + (tid & 127); q.w[0] = p.lb[col]; q.w[1] = p.lb[MIXW + col]; }
    else { q.w[0] = p.bgk[h * 192 + (tid % 192)]; q.w[1] = 0.f; }
}
template <bool HG> struct M1Raw { u32x4 k[HG ? 2 : 3]; u32x4 z[HG ? 1 : 3]; u32x4 v[2]; MixPar<HG> par; };
template <bool HG> __device__ __forceinline__ void m1_load(const MixP& p, int item, int tid, M1Raw<HG>& r) {
    typedef MC<HG> C; constexpr int DK = C::DK, LD = C::LD, CK = DK / 8;
    const int c = item / 12, hs = item % 12, h = hs / C::NS, s = hs % C::NS, row0 = c * 64;
    par_load<HG>(p, h, tid, r.par);
#pragma unroll
    for (int i = 0; i < (HG ? 2 : 3); ++i) { const int ci = tid + NTHR * i, row = ci / CK, cj = ci % CK; r.k[i] = *(const u32x4*)(p.proj + (size_t)(row0 + row) * LD + C::KOFF + h * DK + cj * 8);
        if (!HG) r.z[i] = *(const u32x4*)(p.proj + (size_t)(row0 + row) * LD + C::ZOFF + h * DK + cj * 8); }
#pragma unroll
    for (int i = 0; i < 2; ++i) { const int ci = tid + NTHR * i, row = ci >> 4, cj = ci & 15; r.v[i] = *(const u32x4*)(p.proj + (size_t)(row0 + row) * LD + C::VOFF + h * C::DV + s * 128 + cj * 8); }
}
__device__ __forceinline__ void gkl_store(LAS float* gkl, int tid, const u32x4& g) {
    if (tid < 128) { LAS f32x4* o = (LAS f32x4*)(gkl + (tid >> 1) * 16 + (tid & 1) * 8);
        o[0] = (f32x4){bflo(g.x), bfhi(g.x), bflo(g.y), bfhi(g.y)}; o[1] = (f32x4){bflo(g.z), bfhi(g.z), bflo(g.w), bfhi(g.w)}; }
}
template <bool HG> __device__ __forceinline__ void m1_item(const MixP& p, LAS unsigned char* lds, int item, int nxt, M1Raw<HG>& r, int tid, int lane, int wave) {
    typedef MC<HG> C; constexpr int DK = C::DK, TS = C::TS, CK = DK / 8, RKS = DK * 2 + 16, RVS = 272, NSEG = HG ? 4 : 2, NT = 64 / NSEG;
    const int c = item / 12, hs = item % 12, h = hs / C::NS, s = hs % C::NS;
    constexpr int KDT_OFF = 0, VT_OFF = DK * TS, RAWK_OFF = VT_OFF + 128 * TS, RAWV_OFF = RAWK_OFF + 64 * RKS, RAWZ_OFF = RAWV_OFF + 64 * RVS, TOT_OFF = RAWZ_OFF + (HG ? 0 : 64 * RKS);
    static_assert(TOT_OFF + 4 * 4 * DK <= 140 * 1024 && 128 * RKS <= RAWZ_OFF - RAWK_OFF + (HG ? 0 : 64 * RKS), "M1 LDS");
    LAS unsigned char* KDT = lds + KDT_OFF; LAS unsigned char* VT = lds + VT_OFF; LAS float* tot = (LAS float*)(lds + TOT_OFF);
#pragma unroll
    for (int i = 0; i < (HG ? 2 : 3); ++i) { const int ci = tid + NTHR * i, row = ci / CK, cj = ci % CK; *(LAS u32x4*)(lds + RAWK_OFF + row * RKS + cj * 16) = r.k[i]; if (!HG) *(LAS u32x4*)(lds + RAWZ_OFF + row * RKS + cj * 16) = r.z[i]; }
#pragma unroll
    for (int i = 0; i < 2; ++i) { const int ci = tid + NTHR * i, row = ci >> 4, cj = ci & 15; *(LAS u32x4*)(lds + RAWV_OFF + row * RVS + cj * 16) = r.v[i]; }
    float lb = 0.f, omlb = 1.f, bb = 0.f;
    if (HG) { lb = p.j == 0 ? 0.f : fsigm(r.par.w[1] - r.par.w[0]); omlb = 1.0f - lb; } else bb = r.par.w[0];
    __syncthreads();
    if (nxt >= 0) m1_load<HG>(p, nxt, tid, r);
    const int d = HG ? (tid & 127) : (tid % 192), seg = HG ? (tid >> 7) : (tid / 192), t0 = seg * NT;
    const bool act = seg < NSEG;
    const LAS bf16* rk = (const LAS bf16*)(lds + RAWK_OFF) + d; const LAS bf16* rz = (const LAS bf16*)(lds + RAWZ_OFF) + d;
    float la_[NT / 8][8], k_[NT / 8][8]; const bool haslb = p.j != 0;
    if (act) { float tsum = 0.f;
#pragma unroll
        for (int i8 = 0; i8 < NT / 8; ++i8) { gate8<HG>((HG ? rk : rz) + (t0 + i8 * 8) * (RKS / 2), RKS / 2, bb, lb, omlb, haslb, la_[i8], k_[i8]);
#pragma unroll
            for (int j = 0; j < 8; ++j) tsum += la_[i8][j]; }
        tot[seg * DK + d] = tsum; }
    __syncthreads();
    if (act) { float rc = 0.f;
#pragma unroll
        for (int q = 0; q < NSEG; ++q) if (q > seg) rc += tot[q * DK + d];
#pragma unroll
        for (int i8 = NT / 8 - 1; i8 >= 0; --i8) { float kd[8], rcv[8], kk[8];
#pragma unroll
            for (int j = 0; j < 8; ++j) kk[j] = HG ? k_[i8][j] : bf2f(rk[(t0 + i8 * 8 + j) * (RKS / 2)]);
#pragma unroll
            for (int j = 7; j >= 0; --j) { rcv[j] = 1.44269504f * rc; rc += la_[i8][j]; }
#pragma unroll
            for (int j = 0; j < 8; ++j) rcv[j] = __builtin_amdgcn_exp2f(rcv[j]);
#pragma unroll
            for (int j = 0; j < 8; ++j) kd[j] = kk[j] * rcv[j];
            u32x4 w; w.x = pk2(kd[0], kd[1]); w.y = pk2(kd[2], kd[3]); w.z = pk2(kd[4], kd[5]); w.w = pk2(kd[6], kd[7]);
            *(LAS u32x4*)(KDT + d * TS + (t0 + i8 * 8) * 2) = w; }
        if (seg == 0 && s == 0) p.dec[((size_t)c * C::NH + h) * DK + d] = fexp(rc); }
    {
        const int e = tid & 127, tv = (tid >> 7) * 16; const LAS bf16* rv = (const LAS bf16*)(lds + RAWV_OFF) + e; unsigned xs[16];
#pragma unroll
        for (int i = 0; i < 16; ++i) xs[i] = rv[(tv + i) * (RVS / 2)];
#pragma unroll
        for (int q = 0; q < 2; ++q) { u32x4 w; w.x = xs[q * 8] | (xs[q * 8 + 1] << 16); w.y = xs[q * 8 + 2] | (xs[q * 8 + 3] << 16); w.z = xs[q * 8 + 4] | (xs[q * 8 + 5] << 16); w.w = xs[q * 8 + 6] | (xs[q * 8 + 7] << 16);
            *(LAS u32x4*)(VT + e * TS + (tv + q * 8) * 2) = w; }
    }
    __syncthreads();
    {
        const int fr = lane & 15, g = lane >> 4, eb = wave;
        f32x4 acc[DK / 16];
#pragma unroll
        for (int db = 0; db < DK / 16; ++db) acc[db] = (f32x4){0.f, 0.f, 0.f, 0.f};
#pragma unroll
        for (int ks = 0; ks < 2; ++ks) {
            const bf16x8 bfr = *(const LAS bf16x8*)(VT + (16 * eb + fr) * TS + ks * 64 + g * 16);
#pragma unroll
            for (int db = 0; db < DK / 16; ++db) { const bf16x8 afr = *(const LAS bf16x8*)(KDT + (16 * db + fr) * TS + ks * 64 + g * 16);
                acc[db] = __builtin_amdgcn_mfma_f32_16x16x32_bf16(afr, bfr, acc[db], 0, 0, 0); }
        }
        LAS unsigned char* ut = lds + RAWK_OFF + (16 * eb + fr) * RKS + 8 * g;
#pragma unroll
        for (int db = 0; db < DK / 16; ++db) { u32x2 w; w.x = pk2(acc[db][0], acc[db][1]); w.y = pk2(acc[db][2], acc[db][3]); *(LAS u32x2*)(ut + 32 * db) = w; }
        bf16* vt = p.vtg + ((size_t)c * 12 + hs) * 128 * 64;
#pragma unroll
        for (int i = 0; i < 2; ++i) { const int ci = tid + NTHR * i, e = ci >> 3, part = ci & 7; *(u32x4*)(vt + e * 64 + part * 8) = *(const LAS u32x4*)(VT + e * TS + part * 16); }
    }
    __syncthreads();
    { bf16* ug = p.us + ((size_t)c * 12 + hs) * 128 * DK;
#pragma unroll
        for (int i = 0; i < DK / 32; ++i) { const int ci = tid + NTHR * i, e = ci / CK, cj = ci % CK; *(u32x4*)(ug + (size_t)e * DK + cj * 8) = *(const LAS u32x4*)(lds + RAWK_OFF + e * RKS + cj * 16); } }
    __syncthreads();
}

template <bool HG> __device__ __forceinline__ void m2_scan(const MixP& p, int gtid, int gthreads) {
    typedef MC<HG> C; constexpr int DK = C::DK, D8 = DK / 8, NIT = 2 * 12 * 128 * D8;
    const int nblk = gthreads / NTHR, per = ((NIT + nblk - 1) / nblk + 63) & ~63, bidx = gtid / NTHR, lt = gtid % NTHR;
    for (int it = bidx * per + lt; lt < per && it < NIT; it += NIT) {
        const int d8 = it % D8, e = (it / D8) % 128, hs = (it / (D8 * 128)) % 12, b = it / (D8 * 128 * 12), h = hs / C::NS;
        bf16* up = p.us + (((size_t)(b * 128) * 12 + hs) * 128 + e) * DK + d8 * 8; const size_t ustr = (size_t)12 * 128 * DK;
        const float* dp = p.dec + ((size_t)(b * 128) * C::NH + h) * DK + d8 * 8; const size_t dstr = (size_t)C::NH * DK;
        float S[8];
#pragma unroll
        for (int i = 0; i < 8; ++i) S[i] = 0.f;
        for (int n0 = 0; n0 < 128; n0 += 8) {
            u32x4 u[8]; f32x4 d0[8], d1[8];
#pragma unroll
            for (int k = 0; k < 8; ++k) { u[k] = *(const u32x4*)(up + (size_t)(n0 + k) * ustr); d0[k] = *(const f32x4*)(dp + (size_t)(n0 + k) * dstr); d1[k] = *(const f32x4*)(dp + (size_t)(n0 + k) * dstr + 4); }
#pragma unroll
            for (int k = 0; k < 8; ++k) {
                u32x4 w; w.x = pk2(S[0], S[1]); w.y = pk2(S[2], S[3]); w.z = pk2(S[4], S[5]); w.w = pk2(S[6], S[7]);
                *(u32x4*)(up + (size_t)(n0 + k) * ustr) = w;
                S[0] = d0[k].x * S[0] + bflo(u[k].x); S[1] = d0[k].y * S[1] + bfhi(u[k].x); S[2] = d0[k].z * S[2] + bflo(u[k].y); S[3] = d0[k].w * S[3] + bfhi(u[k].y);
                S[4] = d1[k].x * S[4] + bflo(u[k].z); S[5] = d1[k].y * S[5] + bfhi(u[k].z); S[6] = d1[k].z * S[6] + bflo(u[k].w); S[7] = d1[k].w * S[7] + bfhi(u[k].w);
            }
        }
    }
}

template <bool HG> struct M3Raw { u32x4 q[HG ? 2 : 3]; u32x4 k[HG ? 2 : 3]; u32x4 z[HG ? 1 : 3]; u32x4 gt[HG ? 2 : 6]; MixPar<HG> par; };
template <bool HG> __device__ __forceinline__ void m3_load(const MixP& p, int item, int tid, M3Raw<HG>& r) {
    typedef MC<HG> C; constexpr int DK = C::DK, LD = C::LD, CK = DK / 8;
    const int c = item / C::NH, h = item % C::NH, row0 = c * 64;
    par_load<HG>(p, h, tid, r.par);
#pragma unroll
    for (int i = 0; i < (HG ? 2 : 3); ++i) { const int ci = tid + NTHR * i, row = ci / CK, cj = ci % CK; const bf16* b = p.proj + (size_t)(row0 + row) * LD + h * DK + cj * 8;
        r.q[i] = *(const u32x4*)(b + C::QOFF); r.k[i] = *(const u32x4*)(b + C::KOFF); if (!HG) r.z[i] = *(const u32x4*)(b + C::ZOFF); }
#pragma unroll
    for (int i = 0; i < (HG ? 2 : 6); ++i) { constexpr int CG = C::DV / 8; const int ci = tid + NTHR * i, row = ci / CG, cj = ci % CG; r.gt[i] = *(const u32x4*)(p.proj + (size_t)(row0 + row) * LD + C::GOFF + h * C::DV + cj * 8); }
}
template <bool HG> __device__ __forceinline__ void m3_item(const MixP& p, LAS unsigned char* lds, int item, int nxt, M3Raw<HG>& r, int tid, int lane, int wave) {
    typedef MC<HG> C; constexpr int DK = C::DK, DV = C::DV, LD = C::LD, TS = C::TS, RS = C::RS, NS = C::NS, CK = DK / 8, NSEG = HG ? 4 : 2, NT = 64 / NSEG;
    const int c = item / C::NH, h = item % C::NH, row0 = c * 64;
    constexpr int QI_OFF = 0, KP_OFF = 64 * RS, QP_OFF = HG ? 2 * 64 * RS : 0, P_OFF = (HG ? 3 : 2) * 64 * RS, RED_OFF = P_OFF + 64 * TS, ZR_OFF = RED_OFF + 2048, TOT_OFF = ZR_OFF + (HG ? 0 : 64 * RS), G_OFF = TOT_OFF + 4 * 4 * DK, GS = DV * 2 + 16, CG = DV / 8;
    static_assert(G_OFF + 64 * GS <= 142 * 1024, "M3 LDS");
    LAS float* tot = (LAS float*)(lds + TOT_OFF);
#pragma unroll
    for (int i = 0; i < (HG ? 2 : 3); ++i) { const int ci = tid + NTHR * i, row = ci / CK, cj = ci % CK; *(LAS u32x4*)(lds + QI_OFF + row * RS + cj * 16) = r.q[i]; *(LAS u32x4*)(lds + KP_OFF + row * RS + cj * 16) = r.k[i]; if (!HG) *(LAS u32x4*)(lds + ZR_OFF + row * RS + cj * 16) = r.z[i]; }
#pragma unroll
    for (int i = 0; i < (HG ? 2 : 6); ++i) { const int ci = tid + NTHR * i, row = ci / CG, cj = ci % CG; *(LAS u32x4*)(lds + G_OFF + row * GS + cj * 16) = r.gt[i]; }
    float lb = 0.f, omlb = 1.f, bb = 0.f;
    if (HG) { lb = p.j == 0 ? 0.f : fsigm(r.par.w[1] - r.par.w[0]); omlb = 1.0f - lb; } else bb = r.par.w[0];
    __syncthreads();
    const int fr = lane & 15, g = lane >> 4;
    bf16x8 sfr[NS][DK / 32], vfr[NS][2];
    if (HG)
#pragma unroll
    for (int x = 0; x < NS; ++x) { const int ea = 16 * (wave * NS + x) + fr, sl = ea >> 7, ei = ea & 127;
#pragma unroll
        for (int ks = 0; ks < DK / 32; ++ks) sfr[x][ks] = *(const bf16x8*)(p.us + (((size_t)c * 12 + h * NS + sl) * 128 + ei) * DK + ks * 32 + g * 8);
#pragma unroll
        for (int ks = 0; ks < 2; ++ks) vfr[x][ks] = *(const bf16x8*)(p.vtg + (((size_t)c * 12 + h * NS + sl) * 128 + ei) * 64 + ks * 32 + g * 8); }
    if (nxt >= 0) m3_load<HG>(p, nxt, tid, r);
    {
        const int d = HG ? (tid & 127) : (tid % 192), seg = HG ? (tid >> 7) : (tid / 192), t0 = seg * NT;
        const bool act = seg < NSEG;
        LAS bf16* qi = (LAS bf16*)(lds + QI_OFF) + d; LAS bf16* kp = (LAS bf16*)(lds + KP_OFF) + d; LAS bf16* qp = (LAS bf16*)(lds + QP_OFF) + d; const LAS bf16* zr = (const LAS bf16*)(lds + ZR_OFF) + d;
        float la_[NT / 8][8], k_[NT / 8][8]; const bool haslb = p.j != 0;
        if (act) { float tsum = 0.f;
#pragma unroll
            for (int i8 = 0; i8 < NT / 8; ++i8) { gate8<HG>((HG ? (const LAS bf16*)kp : zr) + (t0 + i8 * 8) * (RS / 2), RS / 2, bb, lb, omlb, haslb, la_[i8], k_[i8]);
#pragma unroll
                for (int j = 0; j < 8; ++j) tsum += la_[i8][j]; }
            tot[seg * DK + d] = tsum; }
        __syncthreads();
        if (act) { float cum = 0.f;
#pragma unroll
            for (int q = 0; q < NSEG; ++q) if (q < seg) cum += tot[q * DK + d];
            const float cm = HG ? tot[d] + tot[DK + d] : 0.f, ecm = HG ? fexp(cm) : 1.0f;
#pragma unroll
            for (int i8 = 0; i8 < NT / 8; ++i8) { const int tb0 = (t0 + i8 * 8) * (RS / 2);
                float qx[8], kx[8], cv[8], e1[8], e2[8];
#pragma unroll
                for (int j = 0; j < 8; ++j) qx[j] = bf2f(qi[tb0 + j * (RS / 2)]);
#pragma unroll
                for (int j = 0; j < 8; ++j) kx[j] = HG ? k_[i8][j] : bf2f(kp[tb0 + j * (RS / 2)]);
#pragma unroll
                for (int j = 0; j < 8; ++j) { cum += la_[i8][j]; cv[j] = 1.44269504f * (cum - cm); }
#pragma unroll
                for (int j = 0; j < 8; ++j) e1[j] = __builtin_amdgcn_exp2f(cv[j]);
#pragma unroll
                for (int j = 0; j < 8; ++j) e2[j] = __builtin_amdgcn_exp2f(-cv[j]);
                if (HG) { float sg[8];
#pragma unroll
                    for (int j = 0; j < 8; ++j) sg[j] = __builtin_amdgcn_exp2f(-1.44269504f * qx[j]);
#pragma unroll
                    for (int j = 0; j < 8; ++j) sg[j] = __builtin_amdgcn_rcpf(1.0f + sg[j]);
#pragma unroll
                    for (int j = 0; j < 8; ++j) { const float qpv = qx[j] * sg[j] * e1[j];
                        qi[tb0 + j * (RS / 2)] = (bf16)(pk2(qpv * ecm, 0.f) & 0xffffu); qp[tb0 + j * (RS / 2)] = (bf16)(pk2(qpv, 0.f) & 0xffffu); kp[tb0 + j * (RS / 2)] = (bf16)(pk2(kx[j] * e2[j], 0.f) & 0xffffu); }
                } else {
#pragma unroll
                    for (int j = 0; j < 8; ++j) { qi[tb0 + j * (RS / 2)] = (bf16)(pk2(qx[j] * 0.07216878364870322f * e1[j], 0.f) & 0xffffu); kp[tb0 + j * (RS / 2)] = (bf16)(pk2(kx[j] * e2[j], 0.f) & 0xffffu); }
                }
            }
        }
    }
    __syncthreads();
#pragma unroll
    for (int x = 0; x < 2; ++x) {
        const int ti = 2 * wave + x, tb = ti >> 2, sb = ti & 3;
        f32x4 acc = (f32x4){0.f, 0.f, 0.f, 0.f};
        if (sb <= tb) {
#pragma unroll
            for (int ks = 0; ks < DK / 32; ++ks) {
                const bf16x8 afr = *(const LAS bf16x8*)(lds + KP_OFF + (16 * sb + fr) * RS + ks * 64 + g * 16);
                const bf16x8 bfr = *(const LAS bf16x8*)(lds + QP_OFF + (16 * tb + fr) * RS + ks * 64 + g * 16);
                acc = __builtin_amdgcn_mfma_f32_16x16x32_bf16(afr, bfr, acc, 0, 0, 0);
            }
            const int tt = 16 * tb + fr, s0 = 16 * sb + 4 * g;
#pragma unroll
            for (int q = 0; q < 4; ++q) if (s0 + q > tt) acc[q] = 0.f;
        }
        u32x2 w; w.x = pk2(acc[0], acc[1]); w.y = pk2(acc[2], acc[3]);
        *(LAS u32x2*)(lds + P_OFF + (16 * tb + fr) * TS + (16 * sb + 4 * g) * 2) = w;
    }
    __syncthreads();
    f32x4 acc[NS][4];
#pragma unroll
    for (int x = 0; x < NS; ++x)
#pragma unroll
        for (int tb = 0; tb < 4; ++tb) acc[x][tb] = (f32x4){0.f, 0.f, 0.f, 0.f};
#pragma unroll
    for (int ks = 0; ks < DK / 32; ++ks) {
        bf16x8 bq[4];
#pragma unroll
        for (int tb = 0; tb < 4; ++tb) bq[tb] = *(const LAS bf16x8*)(lds + QI_OFF + (16 * tb + fr) * RS + ks * 64 + g * 16);
#pragma unroll
        for (int x = 0; x < NS; ++x) {
            const int ea = 16 * (wave * NS + x) + fr, sl = ea >> 7, ei = ea & 127;
            bf16x8 afr; if (HG) afr = sfr[x][ks]; else afr = *(const bf16x8*)(p.us + (((size_t)c * 12 + h * NS + sl) * 128 + ei) * DK + ks * 32 + g * 8);
#pragma unroll
            for (int tb = 0; tb < 4; ++tb) acc[x][tb] = __builtin_amdgcn_mfma_f32_16x16x32_bf16(afr, bq[tb], acc[x][tb], 0, 0, 0);
        }
    }
#pragma unroll
    for (int ks = 0; ks < 2; ++ks) {
        bf16x8 bp[4];
#pragma unroll
        for (int tb = 0; tb < 4; ++tb) bp[tb] = *(const LAS bf16x8*)(lds + P_OFF + (16 * tb + fr) * TS + ks * 64 + g * 16);
#pragma unroll
        for (int x = 0; x < NS; ++x) {
            const int ea = 16 * (wave * NS + x) + fr, sl = ea >> 7, ei = ea & 127;
            bf16x8 afr; if (HG) afr = vfr[x][ks]; else afr = *(const bf16x8*)(p.vtg + (((size_t)c * 12 + h * NS + sl) * 128 + ei) * 64 + ks * 32 + g * 8);
#pragma unroll
            for (int tb = 0; tb < 4; ++tb) acc[x][tb] = __builtin_amdgcn_mfma_f32_16x16x32_bf16(afr, bp[tb], acc[x][tb], 0, 0, 0);
        }
    }
    LAS float* red = (LAS float*)(lds + RED_OFF);
#pragma unroll
    for (int tb = 0; tb < 4; ++tb) { float ss = 0.f;
#pragma unroll
        for (int x = 0; x < NS; ++x) ss += (acc[x][tb][0] * acc[x][tb][0] + acc[x][tb][1] * acc[x][tb][1]) + (acc[x][tb][2] * acc[x][tb][2] + acc[x][tb][3] * acc[x][tb][3]);
        ss += __shfl_xor(ss, 16); ss += __shfl_xor(ss, 32);
        if (g == 0) red[wave * 64 + 16 * tb + fr] = ss; }
    __syncthreads();
#pragma unroll
    for (int tb = 0; tb < 4; ++tb) { float tsum = 0.f;
#pragma unroll
        for (int w = 0; w < 8; ++w) tsum += red[w * 64 + 16 * tb + fr];
        const float rstd = rsqrtf(tsum * (1.0f / DV) + EPS); const int row = row0 + 16 * tb + fr;
#pragma unroll
        for (int x = 0; x < NS; ++x) { const int e0 = 16 * (wave * NS + x) + 4 * g;
            LAS u32x2* gp = (LAS u32x2*)(lds + G_OFF + (16 * tb + fr) * GS + e0 * 2); const u32x2 gw2 = *gp; const f32x4 gn = *(const f32x4*)(p.onorm + e0);
            const float g0 = bflo(gw2.x), g1 = bfhi(gw2.x), g2 = bflo(gw2.y), g3 = bfhi(gw2.y);
            const float y0 = acc[x][tb][0] * rstd * gn.x * pg8::fsilu(g0), y1 = acc[x][tb][1] * rstd * gn.y * pg8::fsilu(g1), y2 = acc[x][tb][2] * rstd * gn.z * pg8::fsilu(g2), y3 = acc[x][tb][3] * rstd * gn.w * pg8::fsilu(g3);
            u32x2 w; w.x = pk2(y0, y1); w.y = pk2(y2, y3); *gp = w; }
    }
    __syncthreads();
#pragma unroll
    for (int i = 0; i < (HG ? 2 : 6); ++i) { const int ci = tid + NTHR * i, row = ci / CG, cj = ci % CG; *(u32x4*)(p.cat + (size_t)(row0 + row) * D + h * DV + cj * 8) = *(const LAS u32x4*)(lds + G_OFF + row * GS + cj * 16); }
    __syncthreads();
}
template <bool HG> __device__ __forceinline__ void xa_item(const bf16* proj, const bf16* memk, const bf16* memvt, bf16* cat, int l, int wi, int lane) {
    typedef MC<HG> C; constexpr int LD = C::LD;
    const int tblk = wi >> 2, hd = wi & 3, fr = lane & 15, g = lane >> 4, b = tblk >> 9;
    bf16x8 qf[4];
#pragma unroll
    for (int ks = 0; ks < 4; ++ks) qf[ks] = *(const bf16x8*)(proj + (size_t)(16 * tblk + fr) * LD + C::XQOFF + hd * 128 + ks * 32 + g * 8);
    f32x4 st[16];
    const bf16* kb = memk + (size_t)(b * 256 + fr) * 2048 + l * 512 + hd * 128 + g * 8;
#pragma unroll
    for (int mb = 0; mb < 16; ++mb) { f32x4 a = (f32x4){0.f, 0.f, 0.f, 0.f};
#pragma unroll
        for (int ks = 0; ks < 4; ++ks) { const bf16x8 kf = *(const bf16x8*)(kb + (size_t)(16 * mb) * 2048 + ks * 32); a = __builtin_amdgcn_mfma_f32_16x16x32_bf16(kf, qf[ks], a, 0, 0, 0); }
        st[mb] = a; }
    float mx = -3.0e38f;
#pragma unroll
    for (int mb = 0; mb < 16; ++mb) mx = fmaxf(fmaxf(fmaxf(st[mb][0], st[mb][1]), fmaxf(st[mb][2], st[mb][3])), mx);
    mx = fmaxf(mx, __shfl_xor(mx, 16)); mx = fmaxf(mx, __shfl_xor(mx, 32));
    constexpr float SC = 0.08838834764831845f * 1.44269504f; float sum = 0.f;
#pragma unroll
    for (int mb = 0; mb < 16; ++mb)
#pragma unroll
        for (int r = 0; r < 4; ++r) { const float pz = __builtin_amdgcn_exp2f((st[mb][r] - mx) * SC); st[mb][r] = pz; sum += pz; }
    sum += __shfl_xor(sum, 16); sum += __shfl_xor(sum, 32);
    const float inv = __builtin_amdgcn_rcpf(sum);
    bf16x8 pf[8];
#pragma unroll
    for (int kk = 0; kk < 8; ++kk) { u32x4 w; w.x = pk2(st[2 * kk][0], st[2 * kk][1]); w.y = pk2(st[2 * kk][2], st[2 * kk][3]); w.z = pk2(st[2 * kk + 1][0], st[2 * kk + 1][1]); w.w = pk2(st[2 * kk + 1][2], st[2 * kk + 1][3]);
        pf[kk] = __builtin_bit_cast(bf16x8, w); }
    const bf16* vb = memvt + (size_t)(l * 512 + hd * 128 + fr) * 512 + b * 256 + 4 * g;
#pragma unroll
    for (int eb = 0; eb < 8; ++eb) { f32x4 o = (f32x4){0.f, 0.f, 0.f, 0.f};
#pragma unroll
        for (int kk = 0; kk < 8; ++kk) { const u32x2 v0 = *(const u32x2*)(vb + (size_t)(16 * eb) * 512 + 32 * kk), v1 = *(const u32x2*)(vb + (size_t)(16 * eb) * 512 + 32 * kk + 16);
            u32x4 w; w.x = v0.x; w.y = v0.y; w.z = v1.x; w.w = v1.y;
            o = __builtin_amdgcn_mfma_f32_16x16x32_bf16(__builtin_bit_cast(bf16x8, w), pf[kk], o, 0, 0, 0); }
        u32x2 w; w.x = pk2(o[0] * inv, o[1] * inv); w.y = pk2(o[2] * inv, o[3] * inv);
        *(u32x2*)(cat + (size_t)(16 * tblk + fr) * D + MIXW + hd * 128 + 16 * eb + 4 * g) = w; }
}

template <bool HG> __device__ __forceinline__ void xa_phase(const bf16* proj, const bf16* memk, const bf16* memvt, bf16* cat, int l, LAS unsigned char* lds, int tid, int lane, int wave) {
    typedef MC<HG> C; constexpr int LD = C::LD, KS = 272, VS = 528, K_OFF = 0, V_OFF = 256 * KS;
    static_assert(V_OFF + 128 * VS <= 140 * 1024, "XA LDS");
    const int bx = blockIdx.x, bh = bx & 7, b = bh >> 2, hd = bh & 3, part = bx >> 3;
#pragma unroll
    for (int i = 0; i < 8; ++i) { const int ci = tid + NTHR * i, m = ci >> 4, cj = ci & 15;
        *(LAS u32x4*)(lds + K_OFF + m * KS + cj * 16) = *(const u32x4*)(memk + (size_t)(b * 256 + m) * 2048 + l * 512 + hd * 128 + cj * 8); }
#pragma unroll
    for (int i = 0; i < 8; ++i) { const int ci = tid + NTHR * i, e = ci >> 5, cj = ci & 31;
        *(LAS u32x4*)(lds + V_OFF + e * VS + cj * 16) = *(const u32x4*)(memvt + (size_t)(l * 512 + hd * 128 + e) * 512 + b * 256 + cj * 8); }
    __syncthreads();
    const int fr = lane & 15, g = lane >> 4;
    for (int j = wave; j < 16; j += NWAVES) {
        const int tblk = b * 512 + part * 16 + j;
        bf16x8 qf[4];
#pragma unroll
        for (int ks = 0; ks < 4; ++ks) qf[ks] = *(const bf16x8*)(proj + (size_t)(16 * tblk + fr) * LD + C::XQOFF + hd * 128 + ks * 32 + g * 8);
        f32x4 st[16];
#pragma unroll
        for (int mb = 0; mb < 16; ++mb) { f32x4 a = (f32x4){0.f, 0.f, 0.f, 0.f};
#pragma unroll
            for (int ks = 0; ks < 4; ++ks) { const bf16x8 kf = *(const LAS bf16x8*)(lds + K_OFF + (16 * mb + fr) * KS + ks * 64 + g * 16); a = __builtin_amdgcn_mfma_f32_16x16x32_bf16(kf, qf[ks], a, 0, 0, 0); }
            st[mb] = a; }
        float mx = -3.0e38f;
#pragma unroll
        for (int mb = 0; mb < 16; ++mb) mx = fmaxf(fmaxf(fmaxf(st[mb][0], st[mb][1]), fmaxf(st[mb][2], st[mb][3])), mx);
        mx = fmaxf(mx, __shfl_xor(mx, 16)); mx = fmaxf(mx, __shfl_xor(mx, 32));
        constexpr float SC = 0.08838834764831845f * 1.44269504f; float sum = 0.f;
#pragma unroll
        for (int mb = 0; mb < 16; ++mb)
#pragma unroll
            for (int q = 0; q < 4; ++q) { const float pz = __builtin_amdgcn_exp2f((st[mb][q] - mx) * SC); st[mb][q] = pz; sum += pz; }
        sum += __shfl_xor(sum, 16); sum += __shfl_xor(sum, 32);
        const float inv = __builtin_amdgcn_rcpf(sum);
        bf16x8 pf[8];
#pragma unroll
        for (int kk = 0; kk < 8; ++kk) { u32x4 w; w.x = pk2(st[2 * kk][0], st[2 * kk][1]); w.y = pk2(st[2 * kk][2], st[2 * kk][3]); w.z = pk2(st[2 * kk + 1][0], st[2 * kk + 1][1]); w.w = pk2(st[2 * kk + 1][2], st[2 * kk + 1][3]);
            pf[kk] = __builtin_bit_cast(bf16x8, w); }
#pragma unroll
        for (int eb = 0; eb < 8; ++eb) { f32x4 o = (f32x4){0.f, 0.f, 0.f, 0.f};
#pragma unroll
            for (int kk = 0; kk < 8; ++kk) { const LAS unsigned char* vp = lds + V_OFF + (16 * eb + fr) * VS + (32 * kk + 4 * g) * 2;
                const u32x2 v0 = *(const LAS u32x2*)vp, v1 = *(const LAS u32x2*)(vp + 32);
                u32x4 w; w.x = v0.x; w.y = v0.y; w.z = v1.x; w.w = v1.y;
                o = __builtin_amdgcn_mfma_f32_16x16x32_bf16(__builtin_bit_cast(bf16x8, w), pf[kk], o, 0, 0, 0); }
            u32x2 w; w.x = pk2(o[0] * inv, o[1] * inv); w.y = pk2(o[2] * inv, o[3] * inv);
            *(u32x2*)(cat + (size_t)(16 * tblk + fr) * D + MIXW + hd * 128 + 16 * eb + 4 * g) = w; }
    }
    __syncthreads();
}
#define RLX_AGENT __ATOMIC_RELAXED, __HIP_MEMORY_SCOPE_AGENT
#define XB_TMO      128
#define XB_XCNT(j)  (256  + 64 * (j))
#define XB_XSUB(j)  (1280 + 64 * (j))
#define XB_XGEN(j)  (2304 + 64 * (j))
#define XB_TOP      3328
#define XB_TOPGEN   3392
#define XCD_BAR_WORDS 3456
#define XB_SPIN_CAP (1u << 18)

__device__ __forceinline__ unsigned xb_ld(unsigned* p)              { return __hip_atomic_load(p, __ATOMIC_RELAXED, __HIP_MEMORY_SCOPE_AGENT); }
__device__ __forceinline__ unsigned xb_add(unsigned* p, unsigned v) { return __hip_atomic_fetch_add(p, v, __ATOMIC_RELAXED, __HIP_MEMORY_SCOPE_AGENT); }
__device__ __forceinline__ unsigned xb_xcc_id() { return (unsigned)__builtin_amdgcn_s_getreg((3 << 11) | 20) & 0xFu; }
#define XB_SPIN(cond, bar) do { unsigned _sp = 0; while (cond) { __builtin_amdgcn_s_sleep(1); \
    if ((++_sp & 255u) == 0u) { if (xb_ld(&(bar)[XB_TMO])) break; if (_sp > XB_SPIN_CAP) { atomicAdd(&(bar)[XB_TMO], 1u); break; } } } } while (0)

struct XcdBarrier {
    unsigned* bar; unsigned x;
    volatile LAS unsigned* st;
};

__device__ __forceinline__ XcdBarrier xcd_barrier_post(unsigned* bar, volatile LAS unsigned* st) {
    XcdBarrier b; b.bar = bar; b.x = xb_xcc_id(); b.st = st;
    if (threadIdx.x == 0) (void)xb_add(&bar[XB_XCNT(b.x)], 1u);
    return b;
}
__device__ __forceinline__ void xcd_barrier_complete(unsigned* bar, unsigned x, unsigned& nloc, unsigned& nx) {
    const unsigned G = gridDim.x * gridDim.y * gridDim.z;
    unsigned sum, cnt, mine, sp = 0u;
    for (;;) {
        sum = 0u; cnt = 0u; mine = 0u;
#pragma unroll
        for (unsigned j = 0; j < 16; ++j) { const unsigned c = xb_ld(&bar[XB_XCNT(j)]); sum += c; cnt += (c > 0u) ? 1u : 0u; mine = (j == x) ? c : mine; }
        if (sum == G) break;
        __builtin_amdgcn_s_sleep(1);
        if ((++sp & 255u) == 0u) { if (xb_ld(&bar[XB_TMO])) break; if (sp > XB_SPIN_CAP) { atomicAdd(&bar[XB_TMO], 1u); break; } }
    }
    nloc = mine > 0u ? mine : 1u; nx = cnt > 0u ? cnt : 1u;
}

__device__ __forceinline__ void xcd_barrier(const XcdBarrier& b) {
    asm volatile("s_waitcnt vmcnt(0)" ::: "memory");
    __syncthreads();
    if (threadIdx.x == 0) {
        unsigned* bar = b.bar;
        __builtin_amdgcn_s_waitcnt(0);
        unsigned nloc = b.st[0], nx = b.st[1];
        if (nloc == 0u) { xcd_barrier_complete(bar, b.x, nloc, nx); b.st[0] = nloc; b.st[1] = nx; }
        const unsigned old = xb_add(&bar[XB_XSUB(b.x)], 1u);
        const unsigned gen = old / nloc;
        if (old + 1u == (gen + 1u) * nloc) {
            __builtin_amdgcn_fence(__ATOMIC_RELEASE, "agent");
            asm volatile("s_waitcnt vmcnt(0)" ::: "memory");
            const unsigned og = xb_add(&bar[XB_TOP], 1u);
            const unsigned tg = og / nx;
            if (og + 1u == (tg + 1u) * nx) xb_add(&bar[XB_TOPGEN], 1u);
            else XB_SPIN(xb_ld(&bar[XB_TOPGEN]) == tg, bar);
            __builtin_amdgcn_fence(__ATOMIC_ACQUIRE, "agent");
            xb_add(&bar[XB_XGEN(b.x)], 1u);
            asm volatile("s_waitcnt vmcnt(0)" ::: "memory");
        } else {
            XB_SPIN(xb_ld(&bar[XB_XGEN(b.x)]) == gen, bar);
            __builtin_amdgcn_fence(__ATOMIC_ACQUIRE, "agent");
            asm volatile("s_waitcnt vmcnt(0)" ::: "memory");
        }
    }
    __syncthreads();
}

#ifndef REP_P0
#define REP_P0 1
#endif
#ifndef REP_SYNC
#define REP_SYNC 0
#endif
#ifndef H_BF16
#define H_BF16 1
#endif
#ifndef REP_M2
#define REP_M2 1
#endif
#ifndef REP_M1
#define REP_M1 1
#endif
#ifndef REP_XA
#define REP_XA 1
#endif
#ifndef REP_M3
#define REP_M3 1
#endif
#ifndef REP_G13
#define REP_G13 1
#endif
#ifndef MK_SKELETON
#define MK_SKELETON 0
#endif
template <class Epi> __device__ __forceinline__ void run_gemm(LAS unsigned char* lds, const bf16* A, const bf16* Bt, int Mr, int N, int K, int G, int c, const Epi& E, int wgm = 4) {
    pg8::Gemm g{A, Bt, Mr, N, K}; pg8::StaticOrder S; S.init(Mr, N, G, c, wgm);
    pg8::gemm_phase<Epi, pg8::StaticOrder, true, true>(lds, g, S, E);
}
template <bool HG> __device__ __forceinline__ void mixer_phases(const Args& a, const XcdBarrier& xbar, LAS unsigned char* lds, int l, int tid_, int lane_, int wave_) {
#define OPAQUE_TID() int tid = threadIdx.x; asm volatile("" : "+v"(tid)); const int lane = tid & 63, wave = __builtin_amdgcn_readfirstlane(tid >> 6);
    unsigned char* ws = a.ws; const int j = l >> 1, G = gridDim.x;
    MixP p; p.proj = (const bf16*)(ws + WS_PROJ); p.us = (bf16*)(ws + WS_US); p.vtg = (bf16*)(ws + WS_VTG); p.dec = (float*)(ws + WS_DEC); p.cat = (bf16*)(ws + WS_CAT);
    p.lb = a.hgrn_lb; p.wgk = a.gla_w_gk + (size_t)j * 16 * 768; p.bgk = a.gla_b_gk + j * 768; p.onorm = HG ? a.hgrn_onorm + j * 128 : a.gla_onorm + j * 384; p.j = j;
    const bool split = HG && G == 256;
#ifndef NO_M1
    if (split && blockIdx.x < 128) { pg8::EpiScaleBf16<true> E{(bf16*)(ws + WS_PROJ) + 6144, HG_IN, (const float*)(ws + WS_SSQ2) + (size_t)(2 * l) * M * 32};
        run_gemm(lds, (const bf16*)(ws + WS_HB), wt_in(ws, l) + (size_t)6144 * D, M, 512, D, 128, (int)blockIdx.x, E); }
    for (int rep = 0; rep < REP_M1; ++rep) { OPAQUE_TID(); M1Raw<HG> r;
        int it, step, end;
        if (split) { step = 1; if (blockIdx.x < 128) { it = blockIdx.x * 8; end = it + 8; } else { it = 1024 + (blockIdx.x - 128) * 16; end = it + 16; } }
        else { it = blockIdx.x; step = G; end = 256 * 12; }
        if (it < end) m1_load<HG>(p, it, tid, r);
        for (; it < end; it += step) m1_item<HG>(p, lds, it, it + step < end ? it + step : -1, r, tid, lane, wave);
        __syncthreads(); }
#endif
#ifndef NO_XA
    if (!split)
    for (int rep = 0; rep < REP_XA; ++rep) { OPAQUE_TID();
        if (G == 256) xa_phase<HG>(p.proj, (const bf16*)(ws + WS_MEMK), (const bf16*)(ws + WS_MEMVT), p.cat, l, lds, tid, lane, wave);
        else for (int wi = blockIdx.x * NWAVES + wave; wi < 4096; wi += G * NWAVES) xa_item<HG>(p.proj, (const bf16*)(ws + WS_MEMK), (const bf16*)(ws + WS_MEMVT), p.cat, l, wi, lane); }
#endif
    xcd_barrier(xbar);
#ifndef NO_M2
    { OPAQUE_TID(); m2_scan<HG>(p, blockIdx.x * NTHR + tid, G * NTHR); }
    if (split) { OPAQUE_TID(); xa_phase<HG>(p.proj, (const bf16*)(ws + WS_MEMK), (const bf16*)(ws + WS_MEMVT), p.cat, l, lds, tid, lane, wave); }
#if REP_M2 > 1
    { OPAQUE_TID(); MixP p2 = p; p2.us = (bf16*)(ws + WS_END); m2_scan<HG>(p2, blockIdx.x * NTHR + tid, G * NTHR); }
#endif
#endif
    xcd_barrier(xbar);
#ifndef NO_M3
    for (int rep = 0; rep < REP_M3; ++rep) { OPAQUE_TID(); constexpr int N3 = 256 * MC<HG>::NH; M3Raw<HG> r; int it = blockIdx.x; if (it < N3) m3_load<HG>(p, it, tid, r);
        for (; it < N3; it += G) m3_item<HG>(p, lds, it, it + G < N3 ? it + G : -1, r, tid, lane, wave);
        __syncthreads(); }
#endif
    xcd_barrier(xbar);
}

__global__ void __launch_bounds__(NTHR, 2) trunk_fwd(Args a) {
    extern __shared__ __attribute__((aligned(16))) unsigned char lds_raw[];
    LAS unsigned char* lds = (LAS unsigned char*)lds_raw;
    cg::grid_group grid = cg::this_grid();
    const int tid = threadIdx.x, lane = tid & 63, wave = __builtin_amdgcn_readfirstlane(tid >> 6), G = gridDim.x, bx = blockIdx.x;
    unsigned char* ws = a.ws;
    float* ssq = (float*)(ws + WS_SSQ2); float* H = (float*)(ws + WS_H); bf16* HB = (bf16*)(ws + WS_HB); bf16* CAT = (bf16*)(ws + WS_CAT); bf16* PROJ = (bf16*)(ws + WS_PROJ); bf16* ACT = PROJ;
#ifndef NO_P0
    for (int rep = 0; rep < REP_P0; ++rep) p0_prologue(a, lds, tid, lane, wave);
#endif
    { unsigned* bw = (unsigned*)(ws + WS_BAR); if (bx == 0) for (int i = tid; i < XCD_BAR_WORDS; i += NTHR) bw[i] = 0u; if (tid < 2) ((volatile LAS unsigned*)(lds + LDS_CTL))[tid] = 0u; }
    grid.sync();
    const XcdBarrier xbar = xcd_barrier_post((unsigned*)(ws + WS_BAR), (volatile LAS unsigned*)(lds + LDS_CTL));
#ifndef NO_PKV
    if (bx >= G - 32 && bx < G - 16) { pg8::EpiScaleBf16<false> E{(bf16*)(ws + WS_MEMK), 2048, nullptr}; run_gemm(lds, (const bf16*)(ws + WS_MEMN), (const bf16*)(ws + WS_WTK), MMEM, 2048, D, 16, bx - (G - 32), E); }
    else if (bx >= G - 16) { pg8::EpiScaleBf16<false> E{(bf16*)(ws + WS_MEMVT), 512, nullptr}; run_gemm(lds, (const bf16*)(ws + WS_WTV), (const bf16*)(ws + WS_MEMN), 2048, MMEM, D, 16, bx - (G - 16), E); }
#endif
#pragma unroll 1
    for (int l = 0; l < DEPTH; ++l) {
#ifndef NO_G1
        for (int rep = 0; rep < REP_G13; ++rep) { pg8::EpiScaleBf16<true> E{PROJ, n_in(l), ssq + (size_t)(2 * l) * M * 32}; run_gemm(lds, HB, wt_in(ws, l), M, (!(l & 1) && G == 256) ? 6144 : n_in(l), D, G, bx, E); }
#endif
        xcd_barrier(xbar);
        if (l & 1) mixer_phases<false>(a, xbar, lds, l, tid, lane, wave); else mixer_phases<true>(a, xbar, lds, l, tid, lane, wave);
#ifndef NO_G2
#if H_BF16
        { pg8::EpiResidBf E{HB, ssq + (size_t)(2 * l + 1) * M * 32}; run_gemm(lds, CAT, wt_out(ws, l), M, D, D, G, bx, E, WGM_G2); }
#else
        { pg8::EpiResid E{l == 0 ? a.x : H, H, HB, ssq + (size_t)(2 * l + 1) * M * 32}; run_gemm(lds, CAT, wt_out(ws, l), M, D, D, G, bx, E); }
#endif
#endif
        xcd_barrier(xbar);
        for (int rep = 0; rep < REP_SYNC; ++rep) xcd_barrier(xbar);
#ifndef NO_G3
        for (int rep = 0; rep < REP_G13; ++rep) { pg8::EpiSwiglu E{ACT, DFF, ssq + (size_t)(2 * l + 1) * M * 32}; run_gemm(lds, HB, wt_gu(ws, l), M, 2 * DFF, D, G, bx, E); }
#endif
        xcd_barrier(xbar);
#ifndef NO_G4
#if H_BF16
        { pg8::EpiResidBf E{HB, ssq + (size_t)(2 * l + 2) * M * 32}; run_gemm(lds, ACT, wt_down(ws, l), M, D, DFF, G, bx, E, WGM_G4); }
#else
        { pg8::EpiResid E{H, H, HB, ssq + (size_t)(2 * l + 2) * M * 32}; run_gemm(lds, ACT, wt_down(ws, l), M, D, DFF, G, bx, E); }
#endif
#endif
        xcd_barrier(xbar);
    }
    for (int m = bx * NWAVES + wave; m < M; m += G * NWAVES) {
        const float r = rsqrtf(wave_sum(lane < 32 ? ssq[((size_t)8 * M + m) * 32 + lane] : 0.f) * (1.0f / D) + EPS);
        const f32x4* hr = (const f32x4*)(H + (size_t)m * D) + lane; const u32x2* hb = (const u32x2*)(HB + (size_t)m * D) + lane; const f32x4* gr = (const f32x4*)a.norm_final + lane; f32x4* o = (f32x4*)(a.out + (size_t)m * D) + lane;
#pragma unroll
        for (int jj = 0; jj < 8; ++jj) { f32x4 v; if (H_BF16) { const u32x2 w = hb[64 * jj]; v = (f32x4){bflo(w.x), bfhi(w.x), bflo(w.y), bfhi(w.y)}; } else v = hr[64 * jj]; const f32x4 gg = gr[64 * jj]; o[64 * jj] = (f32x4){v.x * r * gg.x, v.y * r * gg.y, v.z * r * gg.z, v.w * r * gg.w}; }
    }
}

extern "C" void kernel_launch(void* const* d_in, const int* in_sizes, int n_in_, void* d_out, int out_size, void* d_ws, size_t ws_size, hipStream_t stream) {
    static int grid = 0;
    if (grid == 0) {
        if (n_in_ != 17 || in_sizes[0] != M * D || out_size != M * D || ws_size < WS_END) { fprintf(stderr, "kernel_launch: unexpected shapes (n_in %d, in0 %d, out %d, ws %zu < %zu)\n", n_in_, n_in_ > 0 ? in_sizes[0] : -1, out_size, ws_size, (size_t)WS_END); grid = -1; return; }
        int dev = 0, cus = 0, per_cu = 0;
        hipGetDevice(&dev); hipDeviceGetAttribute(&cus, hipDeviceAttributeMultiprocessorCount, dev);
        if (hipFuncSetAttribute((const void*)trunk_fwd, hipFuncAttributeMaxDynamicSharedMemorySize, LDS_BYTES) != hipSuccess) { fprintf(stderr, "kernel_launch: hipFuncSetAttribute failed\n"); grid = -1; return; }
        if (hipOccupancyMaxActiveBlocksPerMultiprocessor(&per_cu, (const void*)trunk_fwd, NTHR, LDS_BYTES) != hipSuccess || per_cu < 1) { fprintf(stderr, "kernel_launch: occupancy query says %d blocks per CU\n", per_cu); per_cu = 1; }
        (void)hipGetLastError();
        grid = cus;
    }
    if (grid < 0) return;
    Args a{};
    a.x = (const float*)d_in[0]; a.mem = (const float*)d_in[1]; a.norm_mix = (const float*)d_in[2]; a.norm_ffn = (const float*)d_in[3]; a.norm_mem = (const float*)d_in[4]; a.norm_final = (const float*)d_in[5];
    a.hgrn_w_in = (const float*)d_in[6]; a.hgrn_lb = (const float*)d_in[7]; a.hgrn_onorm = (const float*)d_in[8]; a.gla_w_in = (const float*)d_in[9]; a.gla_w_gk = (const float*)d_in[10]; a.gla_b_gk = (const float*)d_in[11];
    a.gla_onorm = (const float*)d_in[12]; a.w_mem_kv = (const float*)d_in[13]; a.w_out = (const float*)d_in[14]; a.w_gate_up = (const float*)d_in[15]; a.w_down = (const float*)d_in[16];
    a.out = (float*)d_out; a.ws = (unsigned char*)d_ws;
    void* args[] = {&a};
    hipError_t e = hipLaunchCooperativeKernel((const void*)trunk_fwd, dim3(grid), dim3(NTHR), args, LDS_BYTES, stream);
    if (e != hipSuccess) fprintf(stderr, "kernel_launch: cooperative launch failed: %s (grid %d)\n", hipGetErrorString(e), grid);
}
```
